# Optimizing an MI355X kernel written in HIP

```python
import math
import jax
import jax.numpy as jnp
from jax import lax
import numpy as np

D_MODEL = 1024
BATCH = 4
SEQ = 8192
DEPTH = 2

GRID_W = 64
CTX_LEN = 256
HEAD_DIM = 64
ROPE_THETA = 10000.0
NORM_EPS = 1e-6
Q_BLOCK = 128
ATTN_SCALE = HEAD_DIM ** -0.5

GDN_HEADS = 4
GDN_DK = 64
GDN_DV = 64
GDN_CONV = 5
GDN_CHUNK = 64
GDN_CONV_CH = 2 * GDN_HEADS * GDN_DK + GDN_HEADS * GDN_DV

MLA_HEADS = 4
MLA_Q_RANK = 256
MLA_KV_RANK = 128
MLA_NOPE = 64
MLA_ROPE = 32
MLA_V = 64
MLA_SCALE = (MLA_NOPE + MLA_ROPE) ** -0.5

SWA_HEADS = 4
SWA_KV_HEADS = 2
WINDOW = 128

GQA_HEADS = 4
GQA_KV_HEADS = 2

D_MIX = GDN_HEADS * GDN_DV + MLA_HEADS * MLA_V + SWA_HEADS * HEAD_DIM + GQA_HEADS * HEAD_DIM

IN_SPLITS = (
    GDN_HEADS * GDN_DK, GDN_HEADS * GDN_DK, GDN_HEADS * GDN_DV, GDN_HEADS * GDN_DV,
    2 * GDN_HEADS, 2 * GDN_HEADS,
    MLA_Q_RANK, MLA_KV_RANK, MLA_ROPE,
    SWA_HEADS * HEAD_DIM, SWA_KV_HEADS * HEAD_DIM, SWA_KV_HEADS * HEAD_DIM,
    GQA_HEADS * HEAD_DIM, GQA_KV_HEADS * HEAD_DIM, GQA_KV_HEADS * HEAD_DIM,
)
D_IN = sum(IN_SPLITS)

N_EXPERTS = 64
TOP_K = 6
D_EXPERT = 384
ROUTED_SCALE = 2.5
MOE_BLOCK = 128

kernel_name = 'hybrid_dit_prefix_block'


def rms_norm(x, g):
    xf = x.astype(jnp.float32)
    y = xf * lax.rsqrt(jnp.mean(xf * xf, axis=-1, keepdims=True) + NORM_EPS)
    return (y * g.astype(jnp.float32)).astype(x.dtype)


def l2_normalize(x):
    return x * lax.rsqrt(jnp.sum(x * x, axis=-1, keepdims=True) + NORM_EPS)


def modulate(h, shift, scale):
    return h * (1 + scale) + shift


def swiglu(x, w_gu, w_down):
    g, u = jnp.split(x @ w_gu, 2, axis=-1)
    return (jax.nn.silu(g) * u) @ w_down


def split_columns(p):
    idx = [int(i) for i in np.cumsum(IN_SPLITS)[:-1]]
    return jnp.split(p, idx, axis=-1)


def axial_rope_tables(n_rows, rot_dim):
    rows = jnp.repeat(jnp.arange(n_rows), GRID_W).astype(jnp.float32)
    cols = jnp.tile(jnp.arange(GRID_W), n_rows).astype(jnp.float32)
    axis_dim = rot_dim // 2
    inv_freq = ROPE_THETA ** (-jnp.arange(0, axis_dim, 2, dtype=jnp.float32) / axis_dim)
    ang_r = rows[:, None] * inv_freq
    ang_c = cols[:, None] * inv_freq
    ang = jnp.concatenate([ang_r, ang_r, ang_c, ang_c], axis=-1)
    return jnp.cos(ang), jnp.sin(ang)


def rotate_half(x):
    x1, x2 = jnp.split(x, 2, axis=-1)
    return jnp.concatenate([-x2, x1], axis=-1)


def apply_axial_rope(x, rope):
    cos, sin = rope
    xr, xc = jnp.split(x, 2, axis=-1)
    rot = jnp.concatenate([rotate_half(xr), rotate_half(xc)], axis=-1)
    out = x.astype(jnp.float32) * cos[None, :, None, :] + rot.astype(jnp.float32) * sin[None, :, None, :]
    return out.astype(x.dtype)


def depthwise_conv_centred(x, w):
    k = w.shape[0]
    return lax.conv_general_dilated(
        x, w[:, None, :].astype(x.dtype), window_strides=(1,), padding=[((k - 1) // 2, k // 2)],
        dimension_numbers=('NWC', 'WIO', 'NWC'), feature_group_count=x.shape[-1])


def gated_delta_chunked(q, k, v, log_a, beta, s0):
    bsz, nh, t_len, dk = q.shape
    dv = v.shape[-1]
    c = GDN_CHUNK
    n = t_len // c
    q = q.reshape(bsz, nh, n, c, dk)
    k = k.reshape(bsz, nh, n, c, dk)
    v = v.reshape(bsz, nh, n, c, dv)
    beta = beta.reshape(bsz, nh, n, c)
    g = jnp.cumsum(log_a.reshape(bsz, nh, n, c), axis=-1)
    incl = jnp.tril(jnp.ones((c, c), bool))
    strict = jnp.tril(jnp.ones((c, c), bool), -1)
    decay_ij = jnp.exp(jnp.where(incl, g[..., :, None] - g[..., None, :], -jnp.inf))
    kb = k * beta[..., None]
    a_mat = jnp.where(strict, jnp.einsum('bhncd,bhnsd->bhncs', kb, k) * decay_ij, 0.0)
    eye = jnp.eye(c, dtype=jnp.float32)
    t_inv = lax.linalg.triangular_solve(eye + a_mat, jnp.broadcast_to(eye, a_mat.shape),
                                        left_side=True, lower=True, unit_diagonal=True)
    u = t_inv @ (v * beta[..., None])
    w = t_inv @ (kb * jnp.exp(g)[..., None])
    qk = jnp.einsum('bhncd,bhnsd->bhncs', q, k) * decay_ij

    def step(s, xs):
        q_i, k_i, u_i, w_i, g_i, qk_i = xs
        v_new = u_i - jnp.einsum('bhcd,bhde->bhce', w_i, s)
        o_i = (jnp.einsum('bhcd,bhde->bhce', q_i * jnp.exp(g_i)[..., None], s)
               + jnp.einsum('bhcs,bhse->bhce', qk_i, v_new))
        g_last = g_i[..., -1:]
        s = (s * jnp.exp(g_last)[..., None]
             + jnp.einsum('bhcd,bhce->bhde', k_i * jnp.exp(g_last - g_i)[..., None], v_new))
        return s, o_i

    xs = tuple(jnp.moveaxis(a, 2, 0) for a in (q, k, u, w, g, qk))
    s_fin, o = lax.scan(step, s0, xs)
    return jnp.moveaxis(o, 0, 2).reshape(bsz, nh, t_len, dv), s_fin


def gdn_prepare(q, k, v, a, b, conv_w, a_log, dt_bias):
    bsz, t_len, _ = q.shape
    qkv = jax.nn.silu(depthwise_conv_centred(jnp.concatenate([q, k, v], axis=-1), conv_w)).astype(jnp.float32)
    q, k, v = jnp.split(qkv, [GDN_HEADS * GDN_DK, 2 * GDN_HEADS * GDN_DK], axis=-1)
    q = l2_normalize(q.reshape(bsz, t_len, GDN_HEADS, GDN_DK)) * GDN_DK ** -0.5
    k = l2_normalize(k.reshape(bsz, t_len, GDN_HEADS, GDN_DK))
    v = v.reshape(bsz, t_len, GDN_HEADS, GDN_DV)
    a = a.astype(jnp.float32).reshape(bsz, t_len, 2, GDN_HEADS)
    b = b.astype(jnp.float32).reshape(bsz, t_len, 2, GDN_HEADS)
    log_a = -jnp.exp(a_log.astype(jnp.float32)) * jax.nn.softplus(a + dt_bias.astype(jnp.float32))
    beta = jax.nn.sigmoid(b)
    to_bhtd = lambda t: t.transpose(0, 2, 1, 3)
    return (to_bhtd(q), to_bhtd(k), to_bhtd(v),
            log_a.transpose(2, 0, 3, 1), beta.transpose(2, 0, 3, 1))


def gdn_bidirectional(ctx_in, lat_in):
    qc, kc, vc, lac, bc = ctx_in
    ql, kl, vl, lal, bl = lat_in
    bsz, nh, _, dk = qc.shape
    s0 = jnp.zeros((bsz, nh, dk, vc.shape[-1]), jnp.float32)
    oc_f, sc_f = gated_delta_chunked(qc, kc, vc, lac[0], bc[0], s0)
    ol_f, _ = gated_delta_chunked(ql, kl, vl, lal[0], bl[0], sc_f)
    r = lambda t: jnp.flip(t, axis=2)
    oc_b, sc_b = gated_delta_chunked(r(qc), r(kc), r(vc), r(lac[1]), r(bc[1]), s0)
    ol_b, _ = gated_delta_chunked(r(ql), r(kl), r(vl), r(lal[1]), r(bl[1]), sc_b)
    return oc_f + r(oc_b), ol_f + r(ol_b)


def gdn_output(o, z, norm_g):
    bsz, nh, t_len, dv = o.shape
    y = rms_norm(o.transpose(0, 2, 1, 3), norm_g) * jax.nn.silu(z.astype(jnp.float32).reshape(bsz, t_len, nh, dv))
    return y.reshape(bsz, t_len, nh * dv).astype(z.dtype)


def mla_heads(cq, ckv, kr, qn_g, kvn_g, w_uq, w_ukv, qk_g, rope):
    bsz, t_len, _ = cq.shape
    q = (rms_norm(cq, qn_g) @ w_uq).reshape(bsz, t_len, MLA_HEADS, MLA_NOPE + MLA_ROPE)
    kv = (rms_norm(ckv, kvn_g) @ w_ukv).reshape(bsz, t_len, MLA_HEADS, MLA_NOPE + MLA_V)
    k_nope, v = jnp.split(kv, [MLA_NOPE], axis=-1)
    q_nope = rms_norm(q[..., :MLA_NOPE], qk_g[0, :MLA_NOPE])
    q_pe = rms_norm(q[..., MLA_NOPE:], qk_g[0, MLA_NOPE:])
    k_nope = rms_norm(k_nope, qk_g[1, :MLA_NOPE])
    k_pe = rms_norm(kr[:, :, None, :], qk_g[1, MLA_NOPE:])
    if rope is not None:
        q_pe = apply_axial_rope(q_pe, rope)
        k_pe = apply_axial_rope(k_pe, rope)
    q = jnp.concatenate([q_nope, q_pe], axis=-1)
    k = jnp.concatenate([k_nope, jnp.broadcast_to(k_pe, (bsz, t_len, MLA_HEADS, MLA_ROPE))], axis=-1)
    return q, k, v


def gqa_heads(q, k, v, qk_g, rope):
    bsz, t_len, _ = q.shape
    q = rms_norm(q.reshape(bsz, t_len, -1, HEAD_DIM), qk_g[0])
    k = rms_norm(k.reshape(bsz, t_len, -1, HEAD_DIM), qk_g[1])
    v = v.reshape(bsz, t_len, -1, HEAD_DIM)
    if rope is not None:
        q = apply_axial_rope(q, rope)
        k = apply_axial_rope(k, rope)
    return q, k, v


def softmax_attend(q, k, v, scale, sink=None):
    bsz, tq, hq, d = q.shape
    hkv = k.shape[2]
    grp = hq // hkv
    dv = v.shape[-1]
    nb = tq // Q_BLOCK
    qb = q.reshape(bsz, nb, Q_BLOCK, hkv, grp, d).transpose(1, 0, 2, 3, 4, 5)

    def block(q_blk):
        s = jnp.einsum('bqhgd,bshd->bhgqs', q_blk, k, preferred_element_type=jnp.float32) * scale
        if sink is not None:
            s_sink = jnp.broadcast_to(sink.astype(jnp.float32).reshape(1, hkv, grp, 1, 1), s.shape[:-1] + (1,))
            p = jax.nn.softmax(jnp.concatenate([s, s_sink], axis=-1), axis=-1)[..., :-1]
        else:
            p = jax.nn.softmax(s, axis=-1)
        return jnp.einsum('bhgqs,bshd->bqhgd', p.astype(v.dtype), v)

    o = lax.map(block, qb)
    return o.transpose(1, 0, 2, 3, 4, 5).reshape(bsz, tq, hq, dv)


def banded_window_attention(q, k, v, k_ctx, v_ctx, sink, scale):
    bsz, t_len, hq, d = q.shape
    hkv = k.shape[2]
    grp = hq // hkv
    dv = v.shape[-1]
    w = WINDOW
    nb = t_len // w
    pad = ((0, 0), (w, w), (0, 0), (0, 0))
    kp = jnp.pad(k, pad)
    vp = jnp.pad(v, pad)
    kb = jnp.concatenate([kp[:, j * w:j * w + t_len].reshape(bsz, nb, w, hkv, d) for j in range(3)], axis=2)
    vb = jnp.concatenate([vp[:, j * w:j * w + t_len].reshape(bsz, nb, w, hkv, dv) for j in range(3)], axis=2)
    q_pos = jnp.arange(t_len).reshape(nb, w)
    k_pos = jnp.arange(nb)[:, None] * w + jnp.arange(3 * w)[None, :] - w
    valid = ((jnp.abs(q_pos[:, :, None] - k_pos[:, None, :]) <= w)
             & (k_pos >= 0)[:, None, :] & (k_pos < t_len)[:, None, :])
    qb = q.reshape(bsz, nb, w, hkv, grp, d)
    s_loc = jnp.einsum('bnqhgd,bnkhd->bnhgqk', qb, kb, preferred_element_type=jnp.float32) * scale
    s_loc = jnp.where(valid[None, :, None, None], s_loc, -jnp.inf)
    s_ctx = jnp.einsum('bnqhgd,bchd->bnhgqc', qb, k_ctx, preferred_element_type=jnp.float32) * scale
    s_sink = jnp.broadcast_to(sink.astype(jnp.float32).reshape(1, 1, hkv, grp, 1, 1), s_loc.shape[:-1] + (1,))
    p = jax.nn.softmax(jnp.concatenate([s_loc, s_ctx, s_sink], axis=-1), axis=-1)
    n_loc = 3 * w
    n_ctx = k_ctx.shape[1]
    o = (jnp.einsum('bnhgqk,bnkhd->bnqhgd', p[..., :n_loc].astype(v.dtype), vb)
         + jnp.einsum('bnhgqc,bchd->bnqhgd', p[..., n_loc:n_loc + n_ctx].astype(v.dtype), v_ctx))
    return o.reshape(bsz, t_len, hq, dv)


def token_mixers(pc, pl, conv_w, a_log, dt_bias, gdn_g, mla_qn_g, mla_kvn_g, w_uq, w_ukv, mla_qk_g,
                 swa_qk_g, swa_sink, gqa_qk_g, rope_hd, rope_mla, need_ctx):
    (aq_c, ak_c, av_c, az_c, aa_c, ab_c, mq_c, mkv_c, mkr_c, sq_c, sk_c, sv_c, gq_c, gk_c, gv_c) = pc
    (aq_l, ak_l, av_l, az_l, aa_l, ab_l, mq_l, mkv_l, mkr_l, sq_l, sk_l, sv_l, gq_l, gk_l, gv_l) = pl
    bsz, t_len, _ = aq_l.shape
    cat = lambda a, b: jnp.concatenate([a, b], axis=1)
    oa_c, oa_l = gdn_bidirectional(gdn_prepare(aq_c, ak_c, av_c, aa_c, ab_c, conv_w, a_log, dt_bias),
                                   gdn_prepare(aq_l, ak_l, av_l, aa_l, ab_l, conv_w, a_log, dt_bias))
    ya_l = gdn_output(oa_l, az_l, gdn_g)
    bq_c, bk_c, bv_c = mla_heads(mq_c, mkv_c, mkr_c, mla_qn_g, mla_kvn_g, w_uq, w_ukv, mla_qk_g, None)
    bq_l, bk_l, bv_l = mla_heads(mq_l, mkv_l, mkr_l, mla_qn_g, mla_kvn_g, w_uq, w_ukv, mla_qk_g, rope_mla)
    yb_l = softmax_attend(bq_l, cat(bk_c, bk_l), cat(bv_c, bv_l), MLA_SCALE)
    cq_c, ck_c, cv_c = gqa_heads(sq_c, sk_c, sv_c, swa_qk_g, None)
    cq_l, ck_l, cv_l = gqa_heads(sq_l, sk_l, sv_l, swa_qk_g, rope_hd)
    yc_l = banded_window_attention(cq_l, ck_l, cv_l, ck_c, cv_c, swa_sink, ATTN_SCALE)
    dq_c, dk_c, dv_c = gqa_heads(gq_c, gk_c, gv_c, gqa_qk_g, None)
    dq_l, dk_l, dv_l = gqa_heads(gq_l, gk_l, gv_l, gqa_qk_g, rope_hd)
    yd_l = softmax_attend(dq_l, cat(dk_c, dk_l), cat(dv_c, dv_l), ATTN_SCALE)
    mix_l = jnp.concatenate([ya_l, yb_l.reshape(bsz, t_len, -1), yc_l.reshape(bsz, t_len, -1),
                             yd_l.reshape(bsz, t_len, -1)], axis=-1)
    if not need_ctx:
        return None, mix_l
    n_ctx = aq_c.shape[1]
    ya_c = gdn_output(oa_c, az_c, gdn_g)
    yb_c = softmax_attend(bq_c, bk_c, bv_c, MLA_SCALE)
    yc_c = softmax_attend(cq_c, ck_c, cv_c, ATTN_SCALE, sink=swa_sink)
    yd_c = softmax_attend(dq_c, dk_c, dv_c, ATTN_SCALE)
    mix_c = jnp.concatenate([ya_c, yb_c.reshape(bsz, n_ctx, -1), yc_c.reshape(bsz, n_ctx, -1),
                             yd_c.reshape(bsz, n_ctx, -1)], axis=-1)
    return mix_c, mix_l


def moe_ffn(h, router_w, router_bias, w_gu, w_down, shared_gu, shared_down):
    n_tok, d = h.shape
    n_assign = n_tok * TOP_K
    scores = jax.nn.sigmoid(jnp.dot(h, router_w, preferred_element_type=jnp.float32))
    _, idx = lax.top_k(scores + router_bias.astype(jnp.float32), TOP_K)
    gates = jnp.take_along_axis(scores, idx, axis=-1)
    gates = gates / jnp.sum(gates, axis=-1, keepdims=True) * ROUTED_SCALE
    flat_e = idx.reshape(-1)
    order = jnp.argsort(flat_e)
    sorted_e = flat_e[order]
    counts = jnp.bincount(flat_e, length=N_EXPERTS)
    padded = (counts + MOE_BLOCK - 1) // MOE_BLOCK * MOE_BLOCK
    pad_end = jnp.cumsum(padded)
    run_start = jnp.cumsum(counts) - counts
    row = (pad_end - padded)[sorted_e] + jnp.arange(n_assign) - run_start[sorted_e]
    n_rows = -(-n_assign // MOE_BLOCK) * MOE_BLOCK + N_EXPERTS * MOE_BLOCK
    n_blk = n_rows // MOE_BLOCK
    src = jnp.full((n_rows,), n_tok, jnp.int32).at[row].set((order // TOP_K).astype(jnp.int32))
    row_gate = jnp.zeros((n_rows,), jnp.float32).at[row].set(gates.reshape(-1)[order])
    blk_expert = jnp.minimum(jnp.searchsorted(pad_end, jnp.arange(n_blk) * MOE_BLOCK, side='right'), N_EXPERTS - 1)
    h_pad = jnp.concatenate([h, jnp.zeros((1, d), h.dtype)], axis=0)

    def expert_block(args):
        src_b, gate_b, e = args
        y = swiglu(h_pad[src_b], w_gu[e], w_down[e])
        return y * gate_b[:, None].astype(y.dtype)

    y_rows = lax.map(expert_block, (src.reshape(n_blk, MOE_BLOCK), row_gate.reshape(n_blk, MOE_BLOCK), blk_expert))
    routed = jax.ops.segment_sum(y_rows.reshape(n_rows, d), src, num_segments=n_tok + 1)[:n_tok]
    return routed + swiglu(h, shared_gu, shared_down)


def setup_inputs(seed: int = 0) -> dict:
    key = jax.random.key(seed)
    keys = iter(jax.random.split(key, 40))
    f32 = jnp.float32
    L, D = DEPTH, D_MODEL

    def normal(shape, scale):
        return jax.random.normal(next(keys), shape, f32) * scale

    def gain(shape):
        return 1.0 + normal(shape, 0.05)

    a_log = jnp.log(jax.random.uniform(next(keys), (L, 2, GDN_HEADS), f32, 1.0, 16.0))
    dt = jnp.exp(jax.random.uniform(next(keys), (L, 2, GDN_HEADS), f32, math.log(1e-3), math.log(1e-1)))
    dt_bias = dt + jnp.log(-jnp.expm1(-dt))
    return {
        'x': normal((BATCH, SEQ, D), 1.0),
        'c': normal((BATCH, D), 1.0),
        'ctx': normal((BATCH, CTX_LEN, D), 1.0),
        'c_ctx': normal((D,), 1.0),
        'w_mod': normal((L, D, 6 * D), 0.5 * D ** -0.5),
        'b_mod': normal((L, 6 * D), 0.02),
        'norm1_g': gain((L, D)),
        'norm2_g': gain((L, D)),
        'w_in': normal((L, D, D_IN), D ** -0.5),
        'gdn_conv_w': normal((L, GDN_CONV, GDN_CONV_CH), GDN_CONV ** -0.5),
        'gdn_a_log': a_log,
        'gdn_dt_bias': dt_bias,
        'gdn_norm_g': gain((L, GDN_DV)),
        'mla_qn_g': gain((L, MLA_Q_RANK)),
        'mla_kvn_g': gain((L, MLA_KV_RANK)),
        'mla_w_uq': normal((L, MLA_Q_RANK, MLA_HEADS * (MLA_NOPE + MLA_ROPE)), MLA_Q_RANK ** -0.5),
        'mla_w_ukv': normal((L, MLA_KV_RANK, MLA_HEADS * (MLA_NOPE + MLA_V)), MLA_KV_RANK ** -0.5),
        'mla_qk_g': gain((L, 2, MLA_NOPE + MLA_ROPE)),
        'swa_qk_g': gain((L, 2, HEAD_DIM)),
        'swa_sink': normal((L, SWA_HEADS), 1.0),
        'gqa_qk_g': gain((L, 2, HEAD_DIM)),
        'w_out': normal((L, D_MIX, D), D_MIX ** -0.5),
        'router_w': normal((L, D, N_EXPERTS), D ** -0.5),
        'router_bias': normal((L, N_EXPERTS), 0.01),
        'exp_w_gu': normal((L, N_EXPERTS, D, 2 * D_EXPERT), D ** -0.5),
        'exp_w_down': normal((L, N_EXPERTS, D_EXPERT, D), D_EXPERT ** -0.5),
        'shared_w_gu': normal((L, D, 2 * D_EXPERT), D ** -0.5),
        'shared_w_down': normal((L, D_EXPERT, D), D_EXPERT ** -0.5),
    }


def reference(x, c, ctx, c_ctx, w_mod, b_mod, norm1_g, norm2_g, w_in, gdn_conv_w, gdn_a_log, gdn_dt_bias,
              gdn_norm_g, mla_qn_g, mla_kvn_g, mla_w_uq, mla_w_ukv, mla_qk_g, swa_qk_g, swa_sink, gqa_qk_g,
              w_out, router_w, router_bias, exp_w_gu, exp_w_down, shared_w_gu, shared_w_down):
    bsz, t_len, d = x.shape
    n_ctx = ctx.shape[1]
    n_rows = t_len // GRID_W
    rope_hd = axial_rope_tables(n_rows, HEAD_DIM)
    rope_mla = axial_rope_tables(n_rows, MLA_ROPE)
    silu_c = jax.nn.silu(c)
    silu_cc = jax.nn.silu(c_ctx)
    xl, xc = x, ctx
    for l in range(DEPTH):
        need_ctx = l < DEPTH - 1
        mod_l = jnp.split((silu_c @ w_mod[l] + b_mod[l])[:, None, :], 6, axis=-1)
        mod_c = jnp.split((silu_cc @ w_mod[l] + b_mod[l])[None, None, :], 6, axis=-1)
        hl = modulate(rms_norm(xl, norm1_g[l]), mod_l[0], mod_l[1])
        hc = modulate(rms_norm(xc, norm1_g[l]), mod_c[0], mod_c[1])
        mix_c, mix_l = token_mixers(
            split_columns(hc @ w_in[l]), split_columns(hl @ w_in[l]),
            gdn_conv_w[l], gdn_a_log[l], gdn_dt_bias[l], gdn_norm_g[l],
            mla_qn_g[l], mla_kvn_g[l], mla_w_uq[l], mla_w_ukv[l], mla_qk_g[l],
            swa_qk_g[l], swa_sink[l], gqa_qk_g[l], rope_hd, rope_mla, need_ctx)
        xl = xl + mod_l[2] * (mix_l @ w_out[l])
        hl = modulate(rms_norm(xl, norm2_g[l]), mod_l[3], mod_l[4])
        if need_ctx:
            xc = xc + mod_c[2] * (mix_c @ w_out[l])
            hc = modulate(rms_norm(xc, norm2_g[l]), mod_c[3], mod_c[4])
            y = moe_ffn(jnp.concatenate([hc, hl], axis=1).reshape(-1, d), router_w[l], router_bias[l],
                        exp_w_gu[l], exp_w_down[l], shared_w_gu[l], shared_w_down[l]).reshape(bsz, n_ctx + t_len, d)
            xc = xc + mod_c[5] * y[:, :n_ctx]
            xl = xl + mod_l[5] * y[:, n_ctx:]
        else:
            y = moe_ffn(hl.reshape(-1, d), router_w[l], router_bias[l], exp_w_gu[l], exp_w_down[l],
                        shared_w_gu[l], shared_w_down[l]).reshape(bsz, t_len, d)
            xl = xl + mod_l[5] * y
    return xl
```

```cpp
#define N_LAUNCH_MODE 0
#include <hip/hip_runtime.h>
#include <cstdio>
#include <cstdint>
#define LAS __attribute__((address_space(3)))
#define GAS __attribute__((address_space(1)))
typedef unsigned short bf16_t;
typedef short bf16x8 __attribute__((ext_vector_type(8)));
typedef float f32x4 __attribute__((ext_vector_type(4)));
typedef float f32x2 __attribute__((ext_vector_type(2)));
typedef float f32x16 __attribute__((ext_vector_type(16)));
typedef unsigned u32x4 __attribute__((ext_vector_type(4)));
typedef unsigned u32x2 __attribute__((ext_vector_type(2)));
typedef __bf16 bf16x2_t __attribute__((ext_vector_type(2)));
#define DI __device__ __forceinline__
extern __shared__ __attribute__((aligned(16))) unsigned char lds_raw[];
constexpr int TIDTAB_OFF = 131072 + 1024;
DI int hw_wave_slot() { return (int)__builtin_amdgcn_s_getreg(((6 - 1) << 11) | 4) & 63; }
DI int tidx() { int w = *(const LAS int*)(lds_raw + TIDTAB_OFF + 4 * hw_wave_slot()); asm volatile("" : "+v"(w)); w = __builtin_amdgcn_readfirstlane(w);
    return (w << 6) | (int)__builtin_amdgcn_mbcnt_hi(~0u, __builtin_amdgcn_mbcnt_lo(~0u, 0u)); }

constexpr int NB = 4, SEQ = 8192, CTXL = 256, DM = 1024, TPB = SEQ + CTXL  , NT = NB * TPB  ;
constexpr int NP = 3584;
constexpr int NEXP = 64, TOPK = 6, DEXP = 384;
constexpr float EPS = 1e-6f;
constexpr int KT_PER_B = TPB / 64;
constexpr int C_GQ = 0, C_GK = 256, C_GV = 512, C_GZ = 768, C_SQ = 1024, C_SK = 1280, C_SV = 1408, C_DQ = 1536, C_DK = 1792, C_DV = 1920,
              C_MQN = 2048, C_MQP = 2304, C_MKN = 2432, C_MV = 2688, C_CQ = 2944, C_CKV = 3200, C_KR = 3328, C_GA = 3360, C_GB = 3368, C_END = 3376;
constexpr int R_GQ = 0, R_GK = 256, R_GV = 512, R_GZ = 768, R_GA = 1024, R_GB = 1032, R_CQ = 1040, R_CKV = 1296, R_KR = 1424, R_SQ = 1456, R_SK = 1712, R_SV = 1840,
              R_DQ = 1968, R_DK = 2224, R_DV = 2352, DIN = 2480;

DI unsigned f2bf(float f) { unsigned u = __builtin_bit_cast(unsigned, f); return (u + 0x7fffu + ((u >> 16) & 1u)) >> 16; }
DI unsigned pk2(float lo, float hi) { f32x2 v = {lo, hi}; bf16x2_t b = __builtin_convertvector(v, bf16x2_t); return __builtin_bit_cast(unsigned, b); }
DI float bf2f(unsigned short h) { return __builtin_bit_cast(float, (unsigned)h << 16); }
DI unsigned f8pack(float a, float b, float c, float d) {
    unsigned w = 0u;
    w = __builtin_amdgcn_cvt_pk_fp8_f32(__builtin_amdgcn_fmed3f(a, -448.f, 448.f), __builtin_amdgcn_fmed3f(b, -448.f, 448.f), w, false);
    return __builtin_amdgcn_cvt_pk_fp8_f32(__builtin_amdgcn_fmed3f(c, -448.f, 448.f), __builtin_amdgcn_fmed3f(d, -448.f, 448.f), w, true);
}
DI float bflo(unsigned w) { return __builtin_bit_cast(float, w << 16); }
DI float bfhi(unsigned w) { return __builtin_bit_cast(float, w & 0xffff0000u); }
DI float dpp_x1(float v) { return __builtin_bit_cast(float, __builtin_amdgcn_update_dpp(0, __builtin_bit_cast(int, v), 0xB1, 0xF, 0xF, true)); }
DI float dpp_x2(float v) { return __builtin_bit_cast(float, __builtin_amdgcn_update_dpp(0, __builtin_bit_cast(int, v), 0x4E, 0xF, 0xF, true)); }
DI float dpp_m8(float v) { return __builtin_bit_cast(float, __builtin_amdgcn_update_dpp(0, __builtin_bit_cast(int, v), 0x141, 0xF, 0xF, true)); }
DI float dpp_m16(float v) { return __builtin_bit_cast(float, __builtin_amdgcn_update_dpp(0, __builtin_bit_cast(int, v), 0x140, 0xF, 0xF, true)); }
DI int dpp_x1i(int v) { return __builtin_amdgcn_update_dpp(0, v, 0xB1, 0xF, 0xF, true); }
DI int dpp_x2i(int v) { return __builtin_amdgcn_update_dpp(0, v, 0x4E, 0xF, 0xF, true); }
DI int dpp_m8i(int v) { return __builtin_amdgcn_update_dpp(0, v, 0x141, 0xF, 0xF, true); }
DI int dpp_m16i(int v) { return __builtin_amdgcn_update_dpp(0, v, 0x140, 0xF, 0xF, true); }
DI float wave_sum(float v) {
    v += dpp_x1(v); v += dpp_x2(v); v += dpp_m8(v); v += dpp_m16(v); v += __shfl_xor(v, 16); v += __shfl_xor(v, 32);
    return v;
}
DI float sigmoidf(float x) { return __builtin_amdgcn_rcpf(1.f + __builtin_amdgcn_exp2f(-1.4426950408889634f * x)); }
DI float siluf(float x) { return x * sigmoidf(x); }
#define LDS_WAIT() asm volatile("s_waitcnt lgkmcnt(0)" ::: "memory")
#define VM_WAIT() asm volatile("s_waitcnt vmcnt(0)" ::: "memory")

#define XB_TMO      128
#define XB_XCNT(j)  (256  + 64 * (j))
#define XB_XSUB(j)  (1280 + 64 * (j))
#define XB_XGEN(j)  (2304 + 64 * (j))
#define XB_TOP      3328
#define XB_TOPGEN   3392
#define XCD_BAR_WORDS 3456
#define XB_SPIN_CAP (1u << 18)
DI unsigned xb_ld(unsigned* p)              { return __hip_atomic_load(p, __ATOMIC_RELAXED, __HIP_MEMORY_SCOPE_AGENT); }
DI unsigned xb_add(unsigned* p, unsigned v) { return __hip_atomic_fetch_add(p, v, __ATOMIC_RELAXED, __HIP_MEMORY_SCOPE_AGENT); }
DI unsigned xb_xcc_id() { return (unsigned)__builtin_amdgcn_s_getreg((3 << 11) | 20) & 0xFu; }
#define XB_SPIN(cond, bar) do { unsigned _sp = 0; while (cond) { __builtin_amdgcn_s_sleep(1); \
    if ((++_sp & 255u) == 0u) { if (xb_ld(&(bar)[XB_TMO])) break; if (_sp > XB_SPIN_CAP) { atomicAdd(&(bar)[XB_TMO], 1u); break; } } } } while (0)
struct XcdBarrier { unsigned* bar; unsigned x; volatile LAS unsigned* st; };
DI XcdBarrier xcd_barrier_post(unsigned* bar, volatile LAS unsigned* st) {
    XcdBarrier b; b.bar = bar; b.x = xb_xcc_id(); b.st = st;
    if (tidx() == 0) (void)xb_add(&bar[XB_XCNT(b.x)], 1u);
    return b;
}
DI void xcd_barrier_complete(unsigned* bar, unsigned x, unsigned& nloc, unsigned& nx) {
    const unsigned G = gridDim.x * gridDim.y * gridDim.z;
    unsigned sum, cnt, mine, sp = 0u;
    for (;;) {
        sum = 0u; cnt = 0u; mine = 0u;
#pragma unroll
        for (unsigned j = 0; j < 16; ++j) { const unsigned c = xb_ld(&bar[XB_XCNT(j)]); sum += c; cnt += (c > 0u) ? 1u : 0u; mine = (j == x) ? c : mine; }
        if (sum == G) break;
        __builtin_amdgcn_s_sleep(1);
        if ((++sp & 255u) == 0u) { if (xb_ld(&bar[XB_TMO])) break; if (sp > XB_SPIN_CAP) { atomicAdd(&bar[XB_TMO], 1u); break; } }
    }
    nloc = mine > 0u ? mine : 1u; nx = cnt > 0u ? cnt : 1u;
}
DI void xcd_barrier(const XcdBarrier& b) {
    asm volatile("s_waitcnt vmcnt(0)" ::: "memory");
    __syncthreads();
    if (tidx() == 0) {
        unsigned* bar = b.bar;
        __builtin_amdgcn_s_waitcnt(0);
        unsigned nloc = b.st[0], nx = b.st[1];
        if (nloc == 0u) { xcd_barrier_complete(bar, b.x, nloc, nx); b.st[0] = nloc; b.st[1] = nx; }
        const unsigned old = xb_add(&bar[XB_XSUB(b.x)], 1u);
        const unsigned gen = old / nloc;
        if (old + 1u == (gen + 1u) * nloc) {
            __builtin_amdgcn_fence(__ATOMIC_RELEASE, "agent");
            asm volatile("s_waitcnt vmcnt(0)" ::: "memory");
            const unsigned og = xb_add(&bar[XB_TOP], 1u);
            const unsigned tg = og / nx;
            if (og + 1u == (tg + 1u) * nx) xb_add(&bar[XB_TOPGEN], 1u);
            else XB_SPIN(xb_ld(&bar[XB_TOPGEN]) == tg, bar);
            __builtin_amdgcn_fence(__ATOMIC_ACQUIRE, "agent");
            xb_add(&bar[XB_XGEN(b.x)], 1u);
            asm volatile("s_waitcnt vmcnt(0)" ::: "memory");
        } else {
            XB_SPIN(xb_ld(&bar[XB_XGEN(b.x)]) == gen, bar);
            __builtin_amdgcn_fence(__ATOMIC_ACQUIRE, "agent");
            asm volatile("s_waitcnt vmcnt(0)" ::: "memory");
        }
    }
    __syncthreads();
}

namespace pg8 {
constexpr int BM = 256, BK = 64, HALF = 128, HTB = HALF * BK * 2, STAGE_BYTES = 8 * HTB, NXCD = 8, WGM = 8;
__host__ __device__ __forceinline__ int lds_byte(int r, int c) { const int st = (r >> 4) * 2 + (c >> 5), rr = r & 15, cc = c & 31, ob = rr * 64 + cc * 2; return st * 1024 + (ob ^ (((ob >> 9) & 1) << 5)); }
__host__ __device__ __forceinline__ void stage_rc(int b, int& R, int& C) { const int st = b / 1024, sb = b % 1024, swz = sb ^ (((sb >> 9) & 1) << 5); R = (st >> 1) * 16 + swz / 64; C = (st & 1) * 32 + (swz % 64) / 2; }
__host__ __device__ __forceinline__ int perm32(int rho) { const int n = rho >> 4, i = rho & 15; return 8 * (i >> 2) + 4 * n + (i & 3); }

struct Unit { int pm, pn; const char* A; const char* B; int slot0, cnt, ex; };

DI bool static_tile(int i, int G, int c, int nM, int nN, int& pm, int& pn) {
    const int nwg = nM * nN; const long L = (long)i * G + c; if (L >= nwg) return false;
    int wgid = (int)L; { const int q = nwg / NXCD, r = nwg % NXCD, xcd = wgid % NXCD, off = wgid / NXCD; wgid = (xcd < r ? xcd * (q + 1) : r * (q + 1) + (xcd - r) * q) + off; }
    const int nig = WGM * nN, gid = wgid / nig, fm = gid * WGM, gsz = (nM - fm) < WGM ? (nM - fm) : WGM;
    pm = fm + ((wgid % nig) % gsz); pn = (wgid % nig) / gsz; return true;
}

typedef int i32x4 __attribute__((ext_vector_type(4)));
typedef int i32x8 __attribute__((ext_vector_type(8)));
template <class Epi, class Sched, bool GATHER, int ZROW, int I8 = 0>
DI void gemm_phase(LAS unsigned char* lds, const int K, const Sched& S, const Epi& E, const int* lists = nullptr, int lstride = 0) {
    int tid_ = tidx(); asm volatile("" : "+v"(tid_));
    const int tid = tid_, wid = __builtin_amdgcn_readfirstlane(tid >> 6), lane = tid & 63, wr = wid >> 2, wc = wid & 3, fr = lane & 15, fq = lane >> 4;
    const int nt = K / BK;
    unsigned voffA[2], voffB[2]; int sR[2], sC[2];
#pragma unroll
    for (int i = 0; i < 2; ++i) { int R, C; stage_rc(tid * 16 + i * 8192, R, C); const int Rb = Epi::PERM ? ((R & ~31) + perm32(R & 31)) : R;
        voffA[i] = (unsigned)(R * K + C) * 2u; voffB[i] = (unsigned)(Rb * K + C) * 2u; sR[i] = R; sC[i] = C; }
    const size_t kstep = (size_t)(BK * 2);
    const size_t hstep = (size_t)HALF * K * 2;
    const unsigned ldsw = (unsigned)wid * 1024u;
    const int aoff = lds_byte(wr * 64 + fr, fq * 8), boff = lds_byte(wc * 32 + fr, fq * 8);
    unsigned vAc[2][2], vAn[2][2];
#define PG8_SA(b, h) (((b) * 2 + (h)) * HTB)
#define PG8_SB(b, h) ((4 + (b) * 2 + (h)) * HTB)
#define PG8_STAGE2(bufoff, gbase, o0, o1) do { \
        __builtin_amdgcn_global_load_lds((const unsigned*)((const char*)(gbase) + (o0)), (LAS unsigned*)(lds + (bufoff) + ldsw), 16, 0, 0); \
        __builtin_amdgcn_global_load_lds((const unsigned*)((const char*)(gbase) + (o1)), (LAS unsigned*)(lds + (bufoff) + ldsw + 8192), 16, 0, 0); } while (0)
#define PG8_STAGE(bufoff, gbase, voff) PG8_STAGE2(bufoff, gbase, (voff)[0], (voff)[1])
#define PG8_STAGE_A(bufoff, p, h, NX) do { if constexpr (GATHER) { const unsigned _o0 = (NX) ? vAn[h][0] : vAc[h][0], _o1 = (NX) ? vAn[h][1] : vAc[h][1]; PG8_STAGE2(bufoff, p, _o0, _o1); } \
        else { PG8_STAGE(bufoff, (p) + (h) * hstep, voffA); } } while (0)
#define PG8_LD8(p) __builtin_shufflevector(*(const LAS i32x4*)(p), *(const LAS i32x4*)((p) + 1024), 0, 1, 2, 3, 4, 5, 6, 7)
#define PG8_LDA(dst, b, h) do { if constexpr (I8 == 2) { _Pragma("unroll") for (int m = 0; m < 4; ++m) dst##_8[m] = PG8_LD8(lds + PG8_SA(b, h) + aoff + m * 2048); } \
        else { _Pragma("unroll") for (int m = 0; m < 4; ++m) _Pragma("unroll") for (int k = 0; k < 2; ++k) dst[m][k] = *(const LAS bf16x8*)(lds + PG8_SA(b, h) + aoff + m * 2048 + k * 1024); } } while (0)
#define PG8_LDB(dst, b, h) do { if constexpr (I8 == 2) { _Pragma("unroll") for (int n = 0; n < 2; ++n) dst##_8[n] = PG8_LD8(lds + PG8_SB(b, h) + boff + n * 2048); } \
        else { _Pragma("unroll") for (int n = 0; n < 2; ++n) _Pragma("unroll") for (int k = 0; k < 2; ++k) dst[n][k] = *(const LAS bf16x8*)(lds + PG8_SB(b, h) + boff + n * 2048 + k * 1024); } } while (0)
#define PG8_MMA(ai, bj, At, Bt) do { __builtin_amdgcn_s_setprio(1); _Pragma("unroll") for (int m = 0; m < 4; ++m) _Pragma("unroll") for (int n = 0; n < 2; ++n) { \
        if constexpr (I8 == 2) asm volatile("v_mfma_f32_16x16x128_f8f6f4 %0, %1, %2, %0" : "+v"(acc[ai][bj][m][n]) : "v"(Bt##_8[n]), "v"(At##_8[m]));     \
        else { _Pragma("unroll") for (int k = 0; k < 2; ++k) \
        { if constexpr (I8 == 1) acc[ai][bj][m][n] = __builtin_bit_cast(f32x4, __builtin_amdgcn_mfma_i32_16x16x64_i8(__builtin_bit_cast(i32x4, Bt[n][k]), __builtin_bit_cast(i32x4, At[m][k]), __builtin_bit_cast(i32x4, acc[ai][bj][m][n]), 0, 0, 0)); \
          else acc[ai][bj][m][n] = __builtin_amdgcn_mfma_f32_16x16x32_bf16(Bt[n][k], At[m][k], acc[ai][bj][m][n], 0, 0, 0); } } } __builtin_amdgcn_s_setprio(0); } while (0)
#define PG8_WAIT_V(n) asm volatile("s_waitcnt vmcnt(" #n ")" ::: "memory")
#define PG8_WAIT_L(n) asm volatile("s_waitcnt lgkmcnt(" #n ")" ::: "memory")
#define PG8_BAR __builtin_amdgcn_s_barrier()
#define PG8_SCHED __builtin_amdgcn_sched_barrier(0)
#define PG8_ROWS(u, v) do { if constexpr (GATHER) { _Pragma("unroll") for (int _h = 0; _h < 2; ++_h) _Pragma("unroll") for (int _i = 0; _i < 2; ++_i) { \
        const int _slot = (u).slot0 + sR[_i] + 128 * _h; const int _cl = (_slot < (u).cnt) ? _slot : (u).cnt - 1; int _idx = ((u).ex >= 0) ? lists[(size_t)(u).ex * lstride + _cl] : _cl; if (_slot >= (u).cnt) _idx = ZROW; \
        v[_h][_i] = (unsigned)_idx * (unsigned)(K * 2) + (unsigned)(sC[_i] * 2); } } } while (0)
    Unit cur, nxt; int ui = 0;
    if (!S.next(0, cur)) return;
    f32x4 acc[2][2][4][2];
#pragma unroll
    for (int a = 0; a < 2; ++a)
#pragma unroll
        for (int b = 0; b < 2; ++b)
#pragma unroll
            for (int m = 0; m < 4; ++m)
#pragma unroll
                for (int n = 0; n < 2; ++n) acc[a][b][m][n] = (f32x4){0.f, 0.f, 0.f, 0.f};
    bf16x8 At[4][2], B0[2][2], B1[2][2]; i32x8 At_8[4], B0_8[2], B1_8[2];
    const char* cA = cur.A; const char* cB = cur.B;
    PG8_ROWS(cur, vAc);
    PG8_STAGE(PG8_SB(0, 0), cB, voffB); PG8_STAGE(PG8_SB(0, 1), cB + hstep, voffB); PG8_STAGE_A(PG8_SA(0, 0), cA, 0, false); PG8_STAGE_A(PG8_SA(0, 1), cA, 1, false);
    if (wr == 1) PG8_BAR;
    PG8_WAIT_V(2); PG8_BAR;
    PG8_STAGE(PG8_SB(1, 0), cB + kstep, voffB); PG8_STAGE_A(PG8_SA(1, 0), cA + kstep, 0, false); PG8_STAGE(PG8_SB(1, 1), cB + hstep + kstep, voffB);
    PG8_WAIT_V(6); PG8_BAR;
    for (;;) {
        const bool has_next = S.next(ui + 1, nxt);
        const char* nA = has_next ? nxt.A : cA; const char* nB = has_next ? nxt.B : cB;
        if constexpr (GATHER) { if (has_next) { PG8_ROWS(nxt, vAn); } else {
#pragma unroll
            for (int h = 0; h < 2; ++h) { vAn[h][0] = vAc[h][0]; vAn[h][1] = vAc[h][1]; } } }
#pragma unroll 1
        for (int t = 0; t < nt; t += 2) {
            const bool last = (t == nt - 2);
            const char* a1 = cA + (size_t)(t + 1) * kstep;
            const char* a2 = last ? nA : cA + (size_t)(t + 2) * kstep; const char* b2 = last ? nB : cB + (size_t)(t + 2) * kstep;
            const char* a3 = a2 + kstep; const char* b3 = b2 + kstep;
            PG8_LDB(B0, 0, 0); PG8_LDB(B1, 0, 1); PG8_SCHED; PG8_LDA(At, 0, 0); PG8_STAGE_A(PG8_SA(1, 1), a1, 1, false);
            PG8_WAIT_V(8); PG8_WAIT_L(0); PG8_BAR; PG8_MMA(0, 0, At, B0); PG8_MMA(0, 1, At, B1); PG8_BAR; PG8_SCHED;
            PG8_LDA(At, 0, 1); PG8_STAGE(PG8_SB(0, 0), b2, voffB); PG8_STAGE(PG8_SB(0, 1), b2 + hstep, voffB); PG8_STAGE_A(PG8_SA(0, 0), a2, 0, last);
            PG8_WAIT_V(8); PG8_WAIT_L(0); PG8_BAR; PG8_MMA(1, 0, At, B0); PG8_MMA(1, 1, At, B1); PG8_BAR; PG8_SCHED;
            PG8_LDB(B0, 1, 0); PG8_LDB(B1, 1, 1); PG8_SCHED; PG8_LDA(At, 1, 0); PG8_STAGE_A(PG8_SA(0, 1), a2, 1, last);
            PG8_WAIT_V(8); PG8_WAIT_L(0); PG8_BAR; PG8_MMA(0, 0, At, B0); PG8_MMA(0, 1, At, B1); PG8_BAR; PG8_SCHED;
            PG8_LDA(At, 1, 1); PG8_STAGE(PG8_SB(1, 0), b3, voffB); PG8_STAGE(PG8_SB(1, 1), b3 + hstep, voffB); PG8_STAGE_A(PG8_SA(1, 0), a3, 0, last);
            PG8_WAIT_V(8); PG8_WAIT_L(0); PG8_BAR; PG8_MMA(1, 0, At, B0); PG8_MMA(1, 1, At, B1); PG8_BAR; PG8_SCHED;
        }
        if constexpr (I8 == 2) asm volatile("s_nop 15\n\ts_nop 15" ::: "memory");
        if (wr == 0) PG8_BAR;
        E(acc, cur, wr, wc, fr, fq);
        if (!has_next) break;
#pragma unroll
        for (int a = 0; a < 2; ++a)
#pragma unroll
            for (int b = 0; b < 2; ++b)
#pragma unroll
                for (int m = 0; m < 4; ++m)
#pragma unroll
                    for (int n = 0; n < 2; ++n) acc[a][b][m][n] = (f32x4){0.f, 0.f, 0.f, 0.f};
        cur = nxt; cA = nA; cB = nB; ++ui;
        if constexpr (GATHER) {
#pragma unroll
            for (int h = 0; h < 2; ++h) { vAc[h][0] = vAn[h][0]; vAc[h][1] = vAn[h][1]; } }
        if (wr == 1) PG8_BAR;
    }
    PG8_WAIT_V(0);
    PG8_BAR;
#undef PG8_SA
#undef PG8_SB
#undef PG8_STAGE
#undef PG8_STAGE2
#undef PG8_STAGE_A
#undef PG8_LDA
#undef PG8_LD8
#undef PG8_LDB
#undef PG8_MMA
#undef PG8_WAIT_V
#undef PG8_WAIT_L
#undef PG8_BAR
#undef PG8_SCHED
#undef PG8_ROWS
}
}
namespace pg8 {
DI int rfl(int v) { return __builtin_amdgcn_readfirstlane(v); }
struct SchedDense {
    const char* A; const char* Bt; int K, nM, nN, G, c; bool lat_only;
    DI bool next(int i, Unit& u) const {
        int pm, pn; if (!static_tile(i, G, c, nM, nN, pm, pn)) return false;
        if (lat_only) pm = (pm >> 5) * 33 + 1 + (pm & 31);
        u.pm = pm; u.pn = pn; u.A = A + (size_t)pm * 256 * K * 2; u.B = Bt + (size_t)pn * 256 * K * 2; u.slot0 = 0; u.cnt = 0; u.ex = 0; return true;
    }
};
template <int NCOL> struct SchedMoE {
    const LAS int* tstart; const LAS int* ecnt;
    const char* A; const char* Bt; int K, G, c, browbytes;
    bool gather;
    DI bool next(int i, Unit& u) const {
        const int TT = rfl(tstart[65]); unsigned L = (unsigned)(i * G + c);
#if defined(G1_REP) || defined(G2_REP)
        { const unsigned rep_ = (NCOL == 3) ? G1_REP : G2_REP; if (L >= (unsigned)(TT * NCOL) * rep_) return false; L %= (unsigned)(TT * NCOL); }
#else
        if (L >= (unsigned)(TT * NCOL)) return false;
#endif
        const int rt = (int)(L / (unsigned)NCOL), pn = (int)(L % (unsigned)NCOL);
        int e = 0;
#pragma unroll
        for (int stp = 64; stp >= 1; stp >>= 1) { const int c = e + stp; if (c <= 64 && rfl(tstart[c <= 64 ? c : 64]) <= rt) e = c; }
        const int t0 = rfl(tstart[e]);
        u.pm = rt; u.pn = pn; u.ex = (e == 64) ? -1 : e; u.slot0 = (rt - t0) * 256; u.cnt = (e == 64) ? NT : rfl(ecnt[e]);
        u.A = gather ? A : A + (size_t)rt * 256 * K * 2;
        u.B = Bt + (size_t)e * browbytes + (size_t)pn * 256 * K * 2;
        return true;
    }
};

struct EpiP {
    static constexpr bool PERM = true;
    bf16_t* O; int ldc;
    DI void operator()(const f32x4 (&acc)[2][2][4][2], const Unit& u, int wr, int wc, int fr, int fq) const {
        const int row0 = u.pm * BM + wr * 64 + fr, col0 = u.pn * BM + wc * 32 + 8 * fq;
#pragma unroll
        for (int ai = 0; ai < 2; ++ai)
#pragma unroll
            for (int m = 0; m < 4; ++m) { bf16_t* rowp = O + (size_t)(row0 + ai * HALF + m * 16) * ldc + col0;
#pragma unroll
                for (int bj = 0; bj < 2; ++bj) { const f32x4 v0 = acc[ai][bj][m][0], v1 = acc[ai][bj][m][1];
                    u32x4 w; w.x = pk2(v0[0], v0[1]); w.y = pk2(v0[2], v0[3]); w.z = pk2(v1[0], v1[1]); w.w = pk2(v1[2], v1[3]);
                    *(u32x4*)(rowp + bj * HALF) = w; } }
    }
};
struct EpiPF8 {
    static constexpr bool PERM = true;
    bf16_t* O; int ldc; const float* colmax;
    DI void operator()(const f32x4 (&acc)[2][2][4][2], const Unit& u, int wr, int wc, int fr, int fq) const {
        const int row0 = u.pm * BM + wr * 64 + fr, col0 = u.pn * BM + wc * 32 + 8 * fq;
        const float* cm = colmax + (size_t)((u.ex >= 0) ? u.ex : 64) * DM;
        f32x4 sb[2][2];
#pragma unroll
        for (int bj = 0; bj < 2; ++bj) { sb[bj][0] = *(const f32x4*)(cm + col0 + bj * HALF) * (1.f / 448.f); sb[bj][1] = *(const f32x4*)(cm + col0 + bj * HALF + 4) * (1.f / 448.f); }
#pragma unroll
        for (int ai = 0; ai < 2; ++ai)
#pragma unroll
            for (int m = 0; m < 4; ++m) { bf16_t* rowp = O + (size_t)(row0 + ai * HALF + m * 16) * ldc + col0;
#pragma unroll
                for (int bj = 0; bj < 2; ++bj) { const f32x4 v0 = acc[ai][bj][m][0] * sb[bj][0], v1 = acc[ai][bj][m][1] * sb[bj][1];
                    u32x4 w; w.x = pk2(v0[0], v0[1]); w.y = pk2(v0[2], v0[3]); w.z = pk2(v1[0], v1[1]); w.w = pk2(v1[2], v1[3]);
                    *(u32x4*)(rowp + bj * HALF) = w; } }
    }
};
struct EpiPI8 {
    static constexpr bool PERM = true;
    bf16_t* O; int ldc; const float* sa; const unsigned* colmax;
    DI void operator()(const f32x4 (&acc)[2][2][4][2], const Unit& u, int wr, int wc, int fr, int fq) const {
        const int row0 = u.pm * BM + wr * 64 + fr, col0 = u.pn * BM + wc * 32 + 8 * fq;
        f32x4 sb[2][2];
#pragma unroll
        for (int bj = 0; bj < 2; ++bj) { const u32x4 c0 = *(const u32x4*)(colmax + col0 + bj * HALF), c1 = *(const u32x4*)(colmax + col0 + bj * HALF + 4);
            sb[bj][0] = (f32x4){__uint_as_float(c0.x), __uint_as_float(c0.y), __uint_as_float(c0.z), __uint_as_float(c0.w)} * (1.f / 127.f);
            sb[bj][1] = (f32x4){__uint_as_float(c1.x), __uint_as_float(c1.y), __uint_as_float(c1.z), __uint_as_float(c1.w)} * (1.f / 127.f); }
#pragma unroll
        for (int ai = 0; ai < 2; ++ai)
#pragma unroll
            for (int m = 0; m < 4; ++m) { const int row = row0 + ai * HALF + m * 16; const float s = sa[row]; bf16_t* rowp = O + (size_t)row * ldc + col0;
#pragma unroll
                for (int bj = 0; bj < 2; ++bj) { const i32x4 i0 = __builtin_bit_cast(i32x4, acc[ai][bj][m][0]), i1 = __builtin_bit_cast(i32x4, acc[ai][bj][m][1]);
                    const f32x4 v0 = (f32x4){(float)i0.x, (float)i0.y, (float)i0.z, (float)i0.w} * sb[bj][0] * s, v1 = (f32x4){(float)i1.x, (float)i1.y, (float)i1.z, (float)i1.w} * sb[bj][1] * s;
                    u32x4 w; w.x = pk2(v0[0], v0[1]); w.y = pk2(v0[2], v0[3]); w.z = pk2(v1[0], v1[1]); w.w = pk2(v1[2], v1[3]);
                    *(u32x4*)(rowp + bj * HALF) = w; } }
    }
};
struct EpiResid {
    static constexpr bool PERM = true;
    const float* xin; const float* cin; bf16_t* X; const float* mod;
    int layer0;
    DI void operator()(const f32x4 (&acc)[2][2][4][2], const Unit& u, int wr, int wc, int fr, int fq) const {
        const int b = u.pm / 33, j = u.pm % 33; const bool isctx = (j == 0);
        const float* rbase = isctx ? cin + (size_t)(b * 256) * DM : xin + (size_t)(b * 8192 + (j - 1) * 256) * DM;
        bf16_t* obase = X + (size_t)u.pm * 256 * DM;
        const float* gate = mod + (size_t)(isctx ? 4 : b) * 6144 + 2 * DM;
        const int r0 = wr * 64 + fr, col0 = u.pn * BM + wc * 32 + 8 * fq;
        f32x4 gv[2][2];
#pragma unroll
        for (int bj = 0; bj < 2; ++bj)
#pragma unroll
            for (int n = 0; n < 2; ++n) gv[bj][n] = *(const f32x4*)(gate + col0 + bj * HALF + 4 * n);
#pragma unroll
        for (int ai = 0; ai < 2; ++ai)
#pragma unroll
            for (int m = 0; m < 4; ++m) { const size_t off = (size_t)(r0 + ai * HALF + m * 16) * DM + col0;
#pragma unroll
                for (int bj = 0; bj < 2; ++bj) { f32x4 r0v, r1v;
                    if (layer0) { r0v = *(const f32x4*)(rbase + off + bj * HALF); r1v = *(const f32x4*)(rbase + off + bj * HALF + 4); }
                    else { const u32x4 w = *(const u32x4*)(obase + off + bj * HALF); r0v = (f32x4){bflo(w.x), bfhi(w.x), bflo(w.y), bfhi(w.y)}; r1v = (f32x4){bflo(w.z), bfhi(w.z), bflo(w.w), bfhi(w.w)}; }
                    const f32x4 o0 = r0v + gv[bj][0] * acc[ai][bj][m][0], o1 = r1v + gv[bj][1] * acc[ai][bj][m][1];
                    u32x4 ow; ow.x = pk2(o0[0], o0[1]); ow.y = pk2(o0[2], o0[3]); ow.z = pk2(o1[0], o1[1]); ow.w = pk2(o1[2], o1[3]);
                    *(u32x4*)(obase + off + bj * HALF) = ow; }
                if (m & 1) asm volatile("" ::: "memory"); }
    }
};
struct EpiResidF8 {
    static constexpr bool PERM = true;
    const float* xin; const float* cin; bf16_t* X; const float* mod;
    int layer0; const float* colmax;
    DI void operator()(const f32x4 (&acc)[2][2][4][2], const Unit& u, int wr, int wc, int fr, int fq) const {
        const int b = u.pm / 33, j = u.pm % 33; const bool isctx = (j == 0);
        const float* rbase = isctx ? cin + (size_t)(b * 256) * DM : xin + (size_t)(b * 8192 + (j - 1) * 256) * DM;
        bf16_t* obase = X + (size_t)u.pm * 256 * DM;
        const float* gate = mod + (size_t)(isctx ? 4 : b) * 6144 + 2 * DM;
        const int r0 = wr * 64 + fr, col0 = u.pn * BM + wc * 32 + 8 * fq;
        f32x4 gv[2][2];
#pragma unroll
        for (int bj = 0; bj < 2; ++bj)
#pragma unroll
            for (int n = 0; n < 2; ++n) gv[bj][n] = *(const f32x4*)(gate + col0 + bj * HALF + 4 * n) * *(const f32x4*)(colmax + col0 + bj * HALF + 4 * n) * (1.f / 448.f);
#pragma unroll
        for (int ai = 0; ai < 2; ++ai)
#pragma unroll
            for (int m = 0; m < 4; ++m) { const size_t off = (size_t)(r0 + ai * HALF + m * 16) * DM + col0;
#pragma unroll
                for (int bj = 0; bj < 2; ++bj) { f32x4 r0v, r1v;
                    if (layer0) { r0v = *(const f32x4*)(rbase + off + bj * HALF); r1v = *(const f32x4*)(rbase + off + bj * HALF + 4); }
                    else { const u32x4 w = *(const u32x4*)(obase + off + bj * HALF); r0v = (f32x4){bflo(w.x), bfhi(w.x), bflo(w.y), bfhi(w.y)}; r1v = (f32x4){bflo(w.z), bfhi(w.z), bflo(w.w), bfhi(w.w)}; }
                    const f32x4 o0 = r0v + gv[bj][0] * acc[ai][bj][m][0], o1 = r1v + gv[bj][1] * acc[ai][bj][m][1];
                    u32x4 ow; ow.x = pk2(o0[0], o0[1]); ow.y = pk2(o0[2], o0[3]); ow.z = pk2(o1[0], o1[1]); ow.w = pk2(o1[2], o1[3]);
                    *(u32x4*)(obase + off + bj * HALF) = ow; }
                if (m & 1) asm volatile("" ::: "memory"); }
    }
};
struct EpiRouter {
    static constexpr bool PERM = false;
    float* L;
    DI void operator()(const f32x4 (&acc)[2][2][4][2], const Unit& u, int wr, int wc, int fr, int fq) const {
        if (wc >= 2 || u.pn != 0) return;
        const int row0 = u.pm * BM + wr * 64 + fr, col0 = wc * 32 + 4 * fq;
#pragma unroll
        for (int ai = 0; ai < 2; ++ai)
#pragma unroll
            for (int m = 0; m < 4; ++m)
#pragma unroll
                for (int n = 0; n < 2; ++n) *(f32x4*)(L + (size_t)(row0 + ai * HALF + m * 16) * 64 + col0 + n * 16) = acc[ai][0][m][n];
    }
};
struct EpiSwiglu {
    static constexpr bool PERM = true;
    bf16_t* act;
    DI void operator()(const f32x4 (&acc)[2][2][4][2], const Unit& u, int wr, int wc, int fr, int fq) const {
        const int row0 = u.pm * BM + wr * 64 + fr, col0 = (u.pn * BM + wc * 32 + 8 * fq) >> 1;
#pragma unroll
        for (int ai = 0; ai < 2; ++ai)
#pragma unroll
            for (int m = 0; m < 4; ++m) { bf16_t* rowp = act + (size_t)(row0 + ai * HALF + m * 16) * DEXP + col0;
#pragma unroll
                for (int bj = 0; bj < 2; ++bj) { const f32x4 g = acc[ai][bj][m][0], uu = acc[ai][bj][m][1];
                    u32x2 w; w.x = pk2(siluf(g[0]) * uu[0], siluf(g[1]) * uu[1]); w.y = pk2(siluf(g[2]) * uu[2], siluf(g[3]) * uu[3]);
                    *(u32x2*)(rowp + bj * (HALF / 2)) = w; } }
    }
};
struct EpiSwigluI8 {
    static constexpr bool PERM = true;
    bf16_t* act; const float* sal; const float* satok; const unsigned* colmax;
    DI void operator()(const f32x4 (&acc)[2][2][4][2], const Unit& u, int wr, int wc, int fr, int fq) const {
        const int rl0 = wr * 64 + fr, gcol0 = u.pn * BM + wc * 32 + 8 * fq;
        const int e = (u.ex >= 0) ? u.ex : 64;
        f32x4 sbg[2], sbu[2];
#pragma unroll
        for (int bj = 0; bj < 2; ++bj) { const u32x4 c0 = *(const u32x4*)(colmax + e * 768 + gcol0 + bj * HALF), c1 = *(const u32x4*)(colmax + e * 768 + gcol0 + bj * HALF + 4);
            sbg[bj] = (f32x4){__uint_as_float(c0.x), __uint_as_float(c0.y), __uint_as_float(c0.z), __uint_as_float(c0.w)} * (1.f / 127.f);
            sbu[bj] = (f32x4){__uint_as_float(c1.x), __uint_as_float(c1.y), __uint_as_float(c1.z), __uint_as_float(c1.w)} * (1.f / 127.f); }
#pragma unroll
        for (int ai = 0; ai < 2; ++ai)
#pragma unroll
            for (int m = 0; m < 4; ++m) { const int rl = rl0 + ai * HALF + m * 16, slot = u.slot0 + rl;
                float sa = 0.f; if (slot < u.cnt) sa = (u.ex >= 0) ? sal[(size_t)u.ex * NT + slot] : satok[slot];
                bf16_t* rowp = act + (size_t)(u.pm * BM + rl) * DEXP + (gcol0 >> 1);
#pragma unroll
                for (int bj = 0; bj < 2; ++bj) { const i32x4 ig = __builtin_bit_cast(i32x4, acc[ai][bj][m][0]), iu = __builtin_bit_cast(i32x4, acc[ai][bj][m][1]);
                    const f32x4 g = (f32x4){(float)ig.x, (float)ig.y, (float)ig.z, (float)ig.w} * sbg[bj] * sa, uu = (f32x4){(float)iu.x, (float)iu.y, (float)iu.z, (float)iu.w} * sbu[bj] * sa;
                    u32x2 w; w.x = pk2(siluf(g[0]) * uu[0], siluf(g[1]) * uu[1]); w.y = pk2(siluf(g[2]) * uu[2], siluf(g[3]) * uu[3]);
                    *(u32x2*)(rowp + bj * (HALF / 2)) = w; } }
    }
};
struct EpiSwigluI8F8 {
    static constexpr bool PERM = true;
    unsigned char* act; const float* sal; const float* satok; const unsigned* colmax;
    DI void operator()(const f32x4 (&acc)[2][2][4][2], const Unit& u, int wr, int wc, int fr, int fq) const {
        const int rl0 = wr * 64 + fr, gcol0 = u.pn * BM + wc * 32 + 8 * fq;
        const int e = (u.ex >= 0) ? u.ex : 64;
        f32x4 sbg[2], sbu[2];
#pragma unroll
        for (int bj = 0; bj < 2; ++bj) { const u32x4 c0 = *(const u32x4*)(colmax + e * 768 + gcol0 + bj * HALF), c1 = *(const u32x4*)(colmax + e * 768 + gcol0 + bj * HALF + 4);
            sbg[bj] = (f32x4){__uint_as_float(c0.x), __uint_as_float(c0.y), __uint_as_float(c0.z), __uint_as_float(c0.w)} * (1.f / 127.f);
            sbu[bj] = (f32x4){__uint_as_float(c1.x), __uint_as_float(c1.y), __uint_as_float(c1.z), __uint_as_float(c1.w)} * (1.f / 127.f); }
#pragma unroll
        for (int ai = 0; ai < 2; ++ai)
#pragma unroll
            for (int m = 0; m < 4; ++m) { const int rl = rl0 + ai * HALF + m * 16, slot = u.slot0 + rl;
                float sa = 0.f; if (slot < u.cnt) sa = (u.ex >= 0) ? sal[(size_t)u.ex * NT + slot] : satok[slot];
                unsigned char* rowp = act + (size_t)(u.pm * BM + rl) * 512 + (gcol0 >> 1);
#pragma unroll
                for (int bj = 0; bj < 2; ++bj) { const i32x4 ig = __builtin_bit_cast(i32x4, acc[ai][bj][m][0]), iu = __builtin_bit_cast(i32x4, acc[ai][bj][m][1]);
                    const f32x4 g = (f32x4){(float)ig.x, (float)ig.y, (float)ig.z, (float)ig.w} * sbg[bj] * sa, uu = (f32x4){(float)iu.x, (float)iu.y, (float)iu.z, (float)iu.w} * sbu[bj] * sa;
                    const float a0 = __builtin_amdgcn_fmed3f(siluf(g[0]) * uu[0], -448.f, 448.f), a1 = __builtin_amdgcn_fmed3f(siluf(g[1]) * uu[1], -448.f, 448.f);
                    const float a2 = __builtin_amdgcn_fmed3f(siluf(g[2]) * uu[2], -448.f, 448.f), a3 = __builtin_amdgcn_fmed3f(siluf(g[3]) * uu[3], -448.f, 448.f);
                    unsigned w = 0u; w = __builtin_amdgcn_cvt_pk_fp8_f32(a0, a1, w, false); w = __builtin_amdgcn_cvt_pk_fp8_f32(a2, a3, w, true);
                    *(unsigned*)(rowp + bj * (HALF / 2)) = w; } }
    }
};
}
constexpr size_t MiB = 1u << 20;
constexpr size_t WS_CTL = 0, CTL_ZERO_BYTES = 1 * MiB;
constexpr size_t WS_TAB = 1 * MiB;
constexpr size_t WS_WIN = 2 * MiB, WIN_L = (size_t)NP * DM * 2;
constexpr size_t WS_WOUT = 16 * MiB, WOUT_L = (size_t)DM * DM * 2;
constexpr size_t WS_WR = 20 * MiB, WR_L = (size_t)256 * DM * 2;
constexpr size_t WS_WGU = 22 * MiB, WGU_E = (size_t)768 * DM * 2, WGU_L = 65 * WGU_E;
constexpr size_t WGU8_E = (size_t)768 * DM, WGU8_L = 65 * WGU8_E;
constexpr size_t WS_H8 = WS_WGU + 98 * MiB;
constexpr size_t WS_SA = WS_WGU + 132 * MiB;
constexpr size_t WS_SAL = WS_WGU + 133 * MiB;
constexpr size_t WS_WD = 217 * MiB, WD_E = (size_t)DM * 512, WD_L = 65 * WD_E;
constexpr size_t WS_SD = WS_WGU + 142 * MiB;
constexpr size_t WS_H = 315 * MiB;
constexpr size_t WS_X = 382 * MiB;
constexpr size_t WS_MIX = 514 * MiB;
constexpr size_t WS_LOG = 580 * MiB;
constexpr size_t WS_LIST = 589 * MiB;
constexpr size_t WS_GLIST = 598 * MiB;
constexpr size_t WS_POS = 607 * MiB;
constexpr int MAXTILES = 988;
constexpr size_t WS_ACT = 609 * MiB;
constexpr size_t WS_BIG = 795 * MiB;
constexpr size_t B_P = WS_BIG, B_QS = WS_BIG + 231 * MiB, B_QD = WS_BIG + 248 * MiB, B_QM = WS_BIG + 265 * MiB,
                 B_KS = WS_BIG + 290 * MiB, B_VS = WS_BIG + 299 * MiB, B_KD = WS_BIG + 308 * MiB, B_VD = WS_BIG + 317 * MiB, B_KM = WS_BIG + 326 * MiB, B_VM = WS_BIG + 360 * MiB,
                 B_GQ = WS_BIG + 377 * MiB, B_GK = WS_BIG + 394 * MiB, B_GV = WS_BIG + 411 * MiB, B_LA = WS_BIG + 428 * MiB, B_BE = WS_BIG + 430 * MiB,
                 B_G2 = WS_BIG + 432 * MiB, B_DEC = WS_BIG + 598 * MiB, B_OF = WS_BIG + 599 * MiB;
constexpr size_t WS_END = WS_BIG + 666 * MiB;
constexpr size_t WIN8_L = (size_t)NP * DM;
constexpr size_t WS_FT = WS_BIG;
constexpr size_t IMG64 = 8192, IMGM = 16384;
constexpr int CW_BAR = 4096, CW_QUEUE = 8192, CW_ECNT = 8448, CW_QUEUE2 = 12288, CW_MOD = 16384, CW_CMAX = 81920, CW_CMAXW = 184320, CW_CMAXO = 192512;
constexpr int RING_BYTES = 131072, MISC_OFF = RING_BYTES, LDS_BYTES = 147456;

struct Args { const float* in[28]; float* out; unsigned char* ws; int ph_lo, ph_hi; };

typedef const __attribute__((address_space(4))) Args* KArgs;
struct Frame {
    LAS unsigned char* lds; volatile LAS unsigned* MISC;
    unsigned* ctl; unsigned char* ws;
    int tid, lane, wave, vcu, G, bx;
};

template <class F>
DI void transpose_item(const float* W, int ldw, int K, bf16_t* WT, LAS float* scr, int kb, int n0, int lane, F srccol) {
    const int k0 = 64 * kb; const int sc = srccol(n0 + (lane & 31));
    float tv[32];
#pragma unroll
    for (int i = 0; i < 32; ++i) { const int kk = 2 * i + (lane >> 5); tv[i] = (sc >= 0) ? W[(size_t)(k0 + kk) * ldw + sc] : 0.f; }
#pragma unroll
    for (int i = 0; i < 32; ++i) { const int kk = 2 * i + (lane >> 5); scr[kk * 33 + (lane & 31)] = tv[i]; }
    LDS_WAIT(); asm volatile("" ::: "memory");
    const int c = lane & 7;
#pragma unroll
    for (int j = 0; j < 4; ++j) { const int n = (lane >> 3) + 8 * j; const LAS float* s = scr + (8 * c) * 33 + n;
        u32x4 o; o.x = pk2(s[0 * 33], s[1 * 33]); o.y = pk2(s[2 * 33], s[3 * 33]); o.z = pk2(s[4 * 33], s[5 * 33]); o.w = pk2(s[6 * 33], s[7 * 33]);
        *(u32x4*)(WT + (size_t)(n0 + n) * K + k0 + 8 * c) = o; }
    LDS_WAIT(); asm volatile("" ::: "memory");
}
DI int win_srccol(int n) {
    if (n < 1024) return n;
    if (n < 1536) return n - 1024 + R_SQ;
    if (n < 2048) return n - 1536 + R_DQ;
    if (n < C_CQ) return -1;
    if (n < C_CKV) return n - C_CQ + R_CQ;
    if (n < C_KR) return n - C_CKV + R_CKV;
    if (n < C_GA) return n - C_KR + R_KR;
    if (n < C_GB) return n - C_GA + R_GA;
    if (n < C_END) return n - C_GB + R_GB;
    return -1;
}
DI int gu_srccol(int n) { return (n & 4) ? 384 + 4 * (n >> 3) + (n & 3) : 4 * (n >> 3) + (n & 3); }

constexpr int I_WR = 16 * 8, I_L = I_WR, I_CONV = I_L + 128 * 14;
DI void convert_items(unsigned char* ws, KArgs a, LAS float* scr, int l, int it0, int it1, int step, int lane) {
    for (int it = it0; it < it1; it += step) {
        int r = it;
        if (r < I_WR) { transpose_item(a->in[22] + (size_t)l * DM * 64, 64, DM, (bf16_t*)(ws + WS_WR + l * WR_L), scr, r / 8, (r % 8) * 32, lane, [](int n) { return n < 64 ? n : -1; }); continue; }
        r -= I_WR;
        {
          const int kb = r / 112, nb = r % 112, np0 = 2048 + 8 * nb; const bool isq = nb < 48;
          int sc0; const float* U; const float* gn; int J, ldu, coff;
          if (isq) { J = 256; ldu = 384; U = a->in[15] + (size_t)l * 256 * 384; gn = a->in[13] + l * 256; coff = R_CQ;
              if (np0 < C_MQP) { const int h = (np0 - C_MQN) >> 6, d = (np0 - C_MQN) & 63; sc0 = h * 96 + d; } else { const int h = (np0 - C_MQP) >> 5, d = (np0 - C_MQP) & 31; sc0 = h * 96 + 64 + d; } }
          else { J = 128; ldu = 512; U = a->in[16] + (size_t)l * 128 * 512; gn = a->in[14] + l * 128; coff = R_CKV;
              if (np0 < C_MV) { const int h = (np0 - C_MKN) >> 6, d = (np0 - C_MKN) & 63; sc0 = h * 128 + d; } else { const int h = (np0 - C_MV) >> 6, d = (np0 - C_MV) & 63; sc0 = h * 128 + 64 + d; } }
          const float* wrow = a->in[8] + (size_t)l * DM * DIN + (size_t)(64 * kb + lane) * DIN + coff;
          float acc[8];
#pragma unroll
          for (int q = 0; q < 8; ++q) acc[q] = 0.f;
#pragma unroll 2
          for (int j = 0; j < J; j += 4) { const f32x4 w4 = *(const f32x4*)(wrow + j) * *(const f32x4*)(gn + j);
#pragma unroll
              for (int e = 0; e < 4; ++e) { const float w = w4[e]; const f32x4 u0 = *(const f32x4*)(U + (size_t)(j + e) * ldu + sc0), u1 = *(const f32x4*)(U + (size_t)(j + e) * ldu + sc0 + 4);
                  acc[0] += w * u0.x; acc[1] += w * u0.y; acc[2] += w * u0.z; acc[3] += w * u0.w; acc[4] += w * u1.x; acc[5] += w * u1.y; acc[6] += w * u1.z; acc[7] += w * u1.w; } }
          float* op = (float*)(ws + WS_FT) + ((size_t)l * 896 + (np0 - 2048)) * DM + 64 * kb + lane;
#pragma unroll
          for (int q = 0; q < 8; ++q) op[(size_t)q * DM] = acc[q]; }
    }
}
DI float wave_max(float v) { v = fmaxf(v, dpp_x1(v)); v = fmaxf(v, dpp_x2(v)); v = fmaxf(v, dpp_m8(v)); v = fmaxf(v, dpp_m16(v)); v = fmaxf(v, __shfl_xor(v, 16)); return fmaxf(v, __shfl_xor(v, 32)); }
DI unsigned q8pack(float a, float b, float c, float d, float inv) {
    const int qa = (int)rintf(a * inv), qb = (int)rintf(b * inv), qc = (int)rintf(c * inv), qd = (int)rintf(d * inv);
    return (unsigned)(qa & 255) | ((unsigned)(qb & 255) << 8) | ((unsigned)(qc & 255) << 16) | ((unsigned)qd << 24);
}
DI void wgu_quant_items(const Frame& F, KArgs a) {
    int tid_ = F.tid; asm volatile("" : "+v"(tid_)); const int tid = tid_, lane = tid & 63, wave = tid >> 6, c = tid & 31, kr = tid >> 5;
    LAS float* tile = (LAS float*)F.lds; unsigned char* ws = F.ws;
    constexpr int NWGU = 2 * 65 * 24, NWIN = NWGU + 2 * 84, NIT = NWIN + 2 * 32;
    float v[64];
#define WQ_ISSUE(it_) do { const float* src_; size_t st_; bool ok_ = true; \
        if ((it_) < NWGU) { const int le_ = (it_) / 24, q_ = (it_) % 24, l_ = le_ / 65, e_ = le_ % 65; st_ = 16 * 768; \
            src_ = ((e_ < 64) ? a->in[24] + ((size_t)l_ * 64 + e_) * DM * 768 : a->in[26] + (size_t)l_ * DM * 768) + 16 * q_ + gu_srccol(c) + (size_t)kr * 768; } \
        else if ((it_) < NWIN) { const int j_ = (it_) - NWGU, l_ = j_ / 84, k_ = j_ % 84, q_ = k_ < 64 ? k_ : k_ + 28, sc_ = win_srccol(32 * q_ + c); ok_ = sc_ >= 0; st_ = 16 * DIN; \
            src_ = a->in[8] + (size_t)l_ * DM * DIN + (ok_ ? sc_ : 0) + (size_t)kr * DIN; } \
        else { const int j_ = (it_) - NWIN, l_ = j_ / 32, q_ = j_ % 32; st_ = 16 * DM; src_ = a->in[21] + (size_t)l_ * DM * DM + 32 * q_ + c + (size_t)kr * DM; } \
        _Pragma("unroll") for (int i = 0; i < 64; ++i) v[i] = ok_ ? __builtin_nontemporal_load(src_ + (size_t)i * st_) : 0.f; } while (0)
    int it = F.vcu;
    if (it < NIT) WQ_ISSUE(it);
    for (; it < NIT; it += F.G) {
#pragma unroll
        for (int i = 0; i < 64; ++i) tile[(16 * i + kr) * 32 + (c ^ (i & 31))] = v[i];
        LDS_WAIT(); __syncthreads();
        const int nx = it + F.G; if (nx < NIT) WQ_ISSUE(nx);
        unsigned char* obase; float* cbase;
        if (it < NWGU) { const int r0 = (it / 24) * 768 + 32 * (it % 24); obase = ws + WS_WGU + (size_t)r0 * 1024; cbase = (float*)(F.ctl + CW_CMAX) + r0; }
        else if (it < NWIN) { const int j = it - NWGU, l = j / 84, k = j % 84, r0 = l * NP + 32 * (k < 64 ? k : k + 28); obase = ws + WS_WIN + (size_t)r0 * 1024; cbase = (float*)(F.ctl + CW_CMAXW) + r0; }
        else { const int r0 = (it - NWIN) * 32; obase = ws + WS_WOUT + (size_t)r0 * 1024; cbase = (float*)(F.ctl + CW_CMAXO) + r0; }
        const bool f8 = it >= NWIN;
#pragma unroll
        for (int cc = 0; cc < 4; ++cc) { const int col = 4 * wave + cc; float x[16]; float mx = 0.f;
#pragma unroll
            for (int j = 0; j < 16; ++j) { x[j] = tile[(16 * lane + j) * 32 + (col ^ (lane & 31))]; mx = fmaxf(mx, fabsf(x[j])); }
            mx = wave_max(mx); const float inv = mx > 0.f ? (f8 ? 448.f : 127.f) / mx : 0.f;
            u32x4 o;
            if (f8) { o.x = f8pack(x[0] * inv, x[1] * inv, x[2] * inv, x[3] * inv); o.y = f8pack(x[4] * inv, x[5] * inv, x[6] * inv, x[7] * inv); o.z = f8pack(x[8] * inv, x[9] * inv, x[10] * inv, x[11] * inv); o.w = f8pack(x[12] * inv, x[13] * inv, x[14] * inv, x[15] * inv); }
            else { o.x = q8pack(x[0], x[1], x[2], x[3], inv); o.y = q8pack(x[4], x[5], x[6], x[7], inv); o.z = q8pack(x[8], x[9], x[10], x[11], inv); o.w = q8pack(x[12], x[13], x[14], x[15], inv); }
            ((u32x4*)(obase + (size_t)col * 1024))[lane] = o;
            if (lane == 0) cbase[col] = mx; }
        LDS_WAIT(); __syncthreads();
    }
#undef WQ_ISSUE
}
DI void wd_quant_items(const Frame& F, KArgs a) {
    int tid_ = F.tid; asm volatile("" : "+v"(tid_)); const int tid = tid_, lane = tid & 63, wave = tid >> 6, c = tid & 31, kr = tid >> 5;
    LAS float* tile = (LAS float*)F.lds; unsigned char* ws = F.ws;
    constexpr int NIT = 2 * 65 * 32;
    float v[24];
#define WD_ISSUE(it_) do { const int le_ = (it_) / 32, q_ = (it_) % 32, l_ = le_ / 65, e_ = le_ % 65; \
        const float* src_ = ((e_ < 64) ? a->in[25] + ((size_t)l_ * 64 + e_) * DEXP * DM : a->in[27] + (size_t)l_ * DEXP * DM) + 32 * q_ + c + (size_t)kr * DM; \
        _Pragma("unroll") for (int i = 0; i < 24; ++i) v[i] = __builtin_nontemporal_load(src_ + (size_t)i * 16 * DM); } while (0)
    int it = F.vcu;
    if (it < NIT) WD_ISSUE(it);
    for (; it < NIT; it += F.G) {
#pragma unroll
        for (int i = 0; i < 24; ++i) tile[(16 * i + kr) * 32 + (c ^ ((2 * i + (kr >> 3)) & 31))] = v[i];
        LDS_WAIT(); __syncthreads();
        const int nx = it + F.G; if (nx < NIT) WD_ISSUE(nx);
        const int le = it / 32, q = it % 32;
#pragma unroll
        for (int cc = 0; cc < 4; ++cc) { const int col = 4 * wave + cc; float x[8]; float mx = 0.f; const int kl = lane < 48 ? lane : 0;
#pragma unroll
            for (int j = 0; j < 8; ++j) { x[j] = tile[(8 * kl + j) * 32 + (col ^ (kl & 31))]; mx = fmaxf(mx, fabsf(x[j])); }
            mx = wave_max(mx); const float inv = mx > 0.f ? 448.f / mx : 0.f;
            u32x2 o = {0u, 0u};
            if (lane < 48) {
                o.x = __builtin_amdgcn_cvt_pk_fp8_f32(__builtin_amdgcn_fmed3f(x[0] * inv, -448.f, 448.f), __builtin_amdgcn_fmed3f(x[1] * inv, -448.f, 448.f), o.x, false);
                o.x = __builtin_amdgcn_cvt_pk_fp8_f32(__builtin_amdgcn_fmed3f(x[2] * inv, -448.f, 448.f), __builtin_amdgcn_fmed3f(x[3] * inv, -448.f, 448.f), o.x, true);
                o.y = __builtin_amdgcn_cvt_pk_fp8_f32(__builtin_amdgcn_fmed3f(x[4] * inv, -448.f, 448.f), __builtin_amdgcn_fmed3f(x[5] * inv, -448.f, 448.f), o.y, false);
                o.y = __builtin_amdgcn_cvt_pk_fp8_f32(__builtin_amdgcn_fmed3f(x[6] * inv, -448.f, 448.f), __builtin_amdgcn_fmed3f(x[7] * inv, -448.f, 448.f), o.y, true); }
            const int n = 32 * q + col;
            ((u32x2*)(ws + WS_WD + (size_t)le * WD_E + (size_t)n * 512))[lane] = o;
            if (lane == 0) ((float*)(ws + WS_SD))[le * DM + n] = mx; }
        LDS_WAIT(); __syncthreads();
    }
#undef WD_ISSUE
}
DI void fold_quant_row(unsigned char* ws, unsigned* ctl, int r, int lane) {
    const int l = r / 896, n = r % 896; const f32x4* src = (const f32x4*)(ws + WS_FT + (size_t)r * 4096) + lane;
    f32x4 x[4]; float mx = 0.f;
#pragma unroll
    for (int j = 0; j < 4; ++j) { x[j] = src[64 * j]; mx = fmaxf(fmaxf(mx, fmaxf(fabsf(x[j].x), fabsf(x[j].y))), fmaxf(fabsf(x[j].z), fabsf(x[j].w))); }
    mx = wave_max(mx); const float inv = mx > 0.f ? 127.f / mx : 0.f;
    unsigned* dst = (unsigned*)(ws + WS_WIN + ((size_t)l * NP + 2048 + n) * 1024) + lane;
#pragma unroll
    for (int j = 0; j < 4; ++j) dst[64 * j] = q8pack(x[j].x, x[j].y, x[j].z, x[j].w, inv);
    if (lane == 0) ((float*)(ctl + CW_CMAXW))[l * NP + 2048 + n] = mx;
}
#ifndef CONV_BG
#define CONV_BG 0
#endif
DI void p0_prologue(const Frame& F, KArgs a) {
    LAS float* scr = (LAS float*)(F.lds + F.wave * 16384);
    int lane_ = F.lane; asm volatile("" : "+v"(lane_)); const int gw = F.vcu * 8 + F.wave, NGW = F.G * 8, lane = lane_;
    unsigned char* ws = F.ws;
#ifndef P0_DUP
#define P0_DUP 0
#endif
    for (int rp = 0; rp < ((P0_DUP & 1) ? 2 : 1); ++rp) { wgu_quant_items(F, a); wd_quant_items(F, a); }
    for (int rp = 0; rp < ((P0_DUP & 4) ? 2 : 1); ++rp)
    if (F.vcu < 2 * 96) {
        LAS float* sct = (LAS float*)F.lds; LAS float* red = (LAS float*)(F.lds + 32768); float* modacc = (float*)(F.ctl + CW_MOD);
        for (int i = F.tid; i < 5 * DM; i += 512) { const int bb = i / DM, k = i % DM; const float cv = (bb < 4) ? a->in[1][bb * DM + k] : a->in[3][k]; sct[k * 8 + bb] = siluf(cv); }
        LDS_WAIT(); __syncthreads();
        for (int it = F.vcu; it < 2 * 96; it += F.G) {
            const int l = it / 96, n = (it % 96) * 64 + lane, k0 = F.wave * 128;
            const float* W = a->in[4] + (size_t)l * DM * 6144 + (size_t)k0 * 6144 + n;
            float acc[5] = {0.f, 0.f, 0.f, 0.f, 0.f};
#pragma unroll 1
            for (int kb = 0; kb < 128; kb += 16) { float w[16];
#pragma unroll
                for (int j = 0; j < 16; ++j) w[j] = __builtin_nontemporal_load(W + (size_t)(kb + j) * 6144);
#pragma unroll
                for (int j = 0; j < 16; ++j) { const f32x4 s4 = *(const LAS f32x4*)(sct + (k0 + kb + j) * 8); const float s5 = sct[(k0 + kb + j) * 8 + 4];
                    acc[0] += s4.x * w[j]; acc[1] += s4.y * w[j]; acc[2] += s4.z * w[j]; acc[3] += s4.w * w[j]; acc[4] += s5 * w[j]; } }
#pragma unroll
            for (int bb = 0; bb < 5; ++bb) red[(F.wave * 5 + bb) * 64 + lane] = acc[bb];
            LDS_WAIT(); __syncthreads();
            if (F.tid < 320) { const int bb = F.tid >> 6, c = F.tid & 63; float sum = red[bb * 64 + c];
#pragma unroll
                for (int w8 = 1; w8 < 8; ++w8) sum += red[(w8 * 5 + bb) * 64 + c];
                const int nn = (it % 96) * 64 + c; modacc[((size_t)l * 5 + bb) * 6144 + nn] = sum + a->in[5][l * 6144 + nn]; }
            LDS_WAIT(); __syncthreads();
        }
    }
    __syncthreads();
    for (int rp = 0; rp < ((P0_DUP & 2) ? 2 : 1); ++rp) {
    convert_items(ws, a, scr, 0, gw, I_CONV, NGW, lane);
    if (!CONV_BG) convert_items(ws, a, scr, 1, gw, I_CONV, NGW, lane); }
    { float* tab = (float*)(ws + WS_TAB);
      for (int i = gw * 64 + lane; i < 3072; i += NGW * 64) {
          if (i < 2048) { const int pos = i >> 4, fi = i & 15; const float inv = powf(10000.f, -(float)(2 * fi) / 32.f), ang = (float)pos * inv; tab[i] = cosf(ang); tab[2048 + i] = sinf(ang); }
          else { const int q = i - 2048, pos = q >> 3, fi = q & 7; const float inv = powf(10000.f, -(float)(2 * fi) / 16.f), ang = (float)pos * inv; tab[4096 + q] = cosf(ang); tab[5120 + q] = sinf(ang); } } }
    if (gw == 0) { ((u32x4*)((bf16_t*)(ws + WS_H) + (size_t)NT * DM))[lane] = (u32x4){0u, 0u, 0u, 0u}; ((u32x4*)((bf16_t*)(ws + WS_H) + (size_t)NT * DM))[64 + lane] = (u32x4){0u, 0u, 0u, 0u};
                   ((u32x4*)(ws + WS_H8 + (size_t)NT * DM))[lane] = (u32x4){0u, 0u, 0u, 0u}; }
}

DI void norm_row(const float* xrow, const float* g, const float* shift, const float* scale, unsigned* qrow, float* sa, int lane) {
    const f32x4* xr = (const f32x4*)xrow + lane;
    f32x4 v[4]; float s = 0.f;
#pragma unroll
    for (int j = 0; j < 4; ++j) { v[j] = xr[64 * j]; s += (v[j].x * v[j].x + v[j].y * v[j].y) + (v[j].z * v[j].z + v[j].w * v[j].w); }
    const float r = rsqrtf(wave_sum(s) * (1.f / DM) + EPS);
    float mx = 0.f;
#pragma unroll
    for (int j = 0; j < 4; ++j) { const f32x4 gg = ((const f32x4*)g)[lane + 64 * j], sc = ((const f32x4*)scale)[lane + 64 * j], sh = ((const f32x4*)shift)[lane + 64 * j];
        const f32x4 o = v[j] * r * gg * (sc + 1.f) + sh; v[j] = o;
        mx = fmaxf(fmaxf(mx, fmaxf(fabsf(o.x), fabsf(o.y))), fmaxf(fabsf(o.z), fabsf(o.w))); }
    mx = wave_max(mx);
    const float inv = mx > 0.f ? 127.f / mx : 0.f;
#pragma unroll
    for (int j = 0; j < 4; ++j) qrow[lane + 64 * j] = q8pack(v[j].x, v[j].y, v[j].z, v[j].w, inv);
    if (lane == 0) *sa = mx * (1.f / 127.f);
}
DI void norm_row_b(const bf16_t* xrow, const float* g, const float* shift, const float* scale, bf16_t* orow, int lane) {
    const u32x2* xr = (const u32x2*)xrow + lane;
    f32x4 v[4]; float s = 0.f;
#pragma unroll
    for (int j = 0; j < 4; ++j) { const u32x2 w = xr[64 * j]; v[j] = (f32x4){bflo(w.x), bfhi(w.x), bflo(w.y), bfhi(w.y)}; s += (v[j].x * v[j].x + v[j].y * v[j].y) + (v[j].z * v[j].z + v[j].w * v[j].w); }
    const float r = rsqrtf(wave_sum(s) * (1.f / DM) + EPS);
#pragma unroll
    for (int j = 0; j < 4; ++j) { const f32x4 gg = ((const f32x4*)g)[lane + 64 * j], sc = ((const f32x4*)scale)[lane + 64 * j], sh = ((const f32x4*)shift)[lane + 64 * j];
        const f32x4 o = v[j] * r * gg * (sc + 1.f) + sh;
        u32x2 w; w.x = pk2(o.x, o.y); w.y = pk2(o.z, o.w); ((u32x2*)orow)[lane + 64 * j] = w; }
}
DI void norm_row_q(const bf16_t* xrow, const float* g, const float* shift, const float* scale, bf16_t* orow, unsigned* qrow, float* sa, int lane) {
    const u32x2* xr = (const u32x2*)xrow + lane;
    f32x4 v[4]; float s = 0.f;
#pragma unroll
    for (int j = 0; j < 4; ++j) { const u32x2 w = xr[64 * j]; v[j] = (f32x4){bflo(w.x), bfhi(w.x), bflo(w.y), bfhi(w.y)}; s += (v[j].x * v[j].x + v[j].y * v[j].y) + (v[j].z * v[j].z + v[j].w * v[j].w); }
    const float r = rsqrtf(wave_sum(s) * (1.f / DM) + EPS);
    float mx = 0.f;
#pragma unroll
    for (int j = 0; j < 4; ++j) { const f32x4 gg = ((const f32x4*)g)[lane + 64 * j], sc = ((const f32x4*)scale)[lane + 64 * j], sh = ((const f32x4*)shift)[lane + 64 * j];
        const f32x4 o = v[j] * r * gg * (sc + 1.f) + sh; v[j] = o;
        mx = fmaxf(fmaxf(mx, fmaxf(fabsf(o.x), fabsf(o.y))), fmaxf(fabsf(o.z), fabsf(o.w)));
        u32x2 w; w.x = pk2(o.x, o.y); w.y = pk2(o.z, o.w); ((u32x2*)orow)[lane + 64 * j] = w; }
    mx = wave_max(mx);
    const float inv = mx > 0.f ? 127.f / mx : 0.f;
#pragma unroll
    for (int j = 0; j < 4; ++j) qrow[lane + 64 * j] = q8pack(v[j].x, v[j].y, v[j].z, v[j].w, inv);
    if (lane == 0) *sa = mx * (1.f / 127.f);
}
DI const float* resid_row_l0(KArgs a, int row) { const int b = row / TPB, i = row % TPB; return (i < CTXL) ? a->in[2] + (size_t)(b * CTXL + i) * DM : a->in[0] + (size_t)(b * SEQ + i - CTXL) * DM; }

DI void load8(const bf16_t* p, float (&x)[8]) { const u32x4 w = *(const u32x4*)p; x[0] = bflo(w.x); x[1] = bfhi(w.x); x[2] = bflo(w.y); x[3] = bfhi(w.y); x[4] = bflo(w.z); x[5] = bfhi(w.z); x[6] = bflo(w.w); x[7] = bfhi(w.w); }
DI void unpack8(const u32x4 w, float (&x)[8]) { x[0] = bflo(w.x); x[1] = bfhi(w.x); x[2] = bflo(w.y); x[3] = bfhi(w.y); x[4] = bflo(w.z); x[5] = bfhi(w.z); x[6] = bflo(w.w); x[7] = bfhi(w.w); }
DI void store8(bf16_t* p, const float (&y)[8]) { u32x4 w; w.x = pk2(y[0], y[1]); w.y = pk2(y[2], y[3]); w.z = pk2(y[4], y[5]); w.w = pk2(y[6], y[7]); *(u32x4*)p = w; }
DI void loadf8(const float* p, float (&x)[8]) { const f32x4 a = ((const f32x4*)p)[0], b = ((const f32x4*)p)[1]; x[0] = a.x; x[1] = a.y; x[2] = a.z; x[3] = a.w; x[4] = b.x; x[5] = b.y; x[6] = b.z; x[7] = b.w; }
DI void loadl8(const LAS float* p, float (&x)[8]) { const f32x4 a = ((const LAS f32x4*)p)[0], b = ((const LAS f32x4*)p)[1]; x[0] = a.x; x[1] = a.y; x[2] = a.z; x[3] = a.w; x[4] = b.x; x[5] = b.y; x[6] = b.z; x[7] = b.w; }
template <int XM> DI void rope8(float (&y)[8], const LAS float* cs, const LAS float* sn, bool first, bool apply) {
    float c8[8], s8[8];
    if (apply) { loadl8(cs, c8); loadl8(sn, s8); } else {
#pragma unroll
        for (int j = 0; j < 8; ++j) { c8[j] = 1.f; s8[j] = 0.f; } }
#pragma unroll
    for (int j = 0; j < 8; ++j) { const float p = (XM == 1) ? dpp_x1(y[j]) : dpp_x2(y[j]); y[j] = first ? y[j] * c8[j] - p * s8[j] : y[j] * c8[j] + p * s8[j]; }
}
constexpr float LOG2E = 1.4426950408889634f;
constexpr float QSCALE64 = 0.125f * LOG2E;
constexpr float QSCALEM = 0.10206207261596575f * LOG2E;

DI void vstage8(LAS bf16_t* stage, int slot, int d0, int tau, const float (&y)[8]) {
    const int hi = (tau >> 2) & 1, jj = (tau & 3) + 4 * (tau >> 3);
#pragma unroll
    for (int j = 0; j < 8; ++j) stage[slot * 1024 + (d0 + j) * 16 + hi * 8 + jj] = (bf16_t)f2bf(y[j]);
}

template <int XM> DI void rope8l(float (&y)[8], const LAS float* cs, const LAS float* sn, bool first) {
    float c8[8], s8[8]; loadl8(cs, c8); loadl8(sn, s8);
#pragma unroll
    for (int j = 0; j < 8; ++j) { const float p = (XM == 1) ? dpp_x1(y[j]) : dpp_x2(y[j]); y[j] = first ? y[j] * c8[j] - p * s8[j] : y[j] * c8[j] + p * s8[j]; }
}
DI void prep_phase(const Frame& F, KArgs a, int l, int rep) {
    unsigned char* ws = F.ws; int lane_ = F.lane; const int wave = F.wave;
    const bf16_t* P = (const bf16_t*)(ws + B_P);
    const float* tab = (const float*)(ws + WS_TAB);
    LAS float* tl = (LAS float*)F.lds;
    const LAS float* cos64 = tl, *sin64 = tl + 2048, *cos32 = tl + 4096, *sin32 = tl + 5120;
    const LAS float* convw = tl + 6144;
    const LAS float* swa_q = tl + 9984, *swa_k = tl + 10048, *gqa_q = tl + 10112, *gqa_k = tl + 10176, *mla_q = tl + 10240  , *mla_k = tl + 10336  , *ones8 = tl + 10432, *zeros8 = tl + 10440;
    { const float* cwg = a->in[9] + (size_t)l * 5 * 768; const float* sg = a->in[18] + l * 128; const float* gg = a->in[20] + l * 128; const float* mg = a->in[17] + l * 192;
      for (int i = F.tid; i < 10448; i += 512) { float v;
          if (i < 6144) v = tab[i]; else if (i < 9984) v = cwg[i - 6144];
          else if (i < 10048) v = sg[i - 9984] * QSCALE64; else if (i < 10112) v = sg[i - 9984];
          else if (i < 10176) v = gg[i - 10112] * QSCALE64; else if (i < 10240) v = gg[i - 10112];
          else if (i < 10336) v = mg[i - 10240] * QSCALEM; else if (i < 10432) v = mg[i - 10240];
          else v = (i < 10440) ? 1.f : 0.f;
          tl[i] = v; }
      LDS_WAIT(); __syncthreads(); }
    const int gwv = F.vcu * 8 + wave, NGWV = F.G * 8;
    for (int g = gwv; g < NT / 2; g += NGWV) {
        const int row0 = g * 2, b = row0 / TPB, i0 = row0 % TPB; const bool isctx = i0 < CTXL; const bool lat = !isctx;
        asm volatile("" : "+v"(lane_)); const int lane = lane_, L = lane;
        float vt[3][8];
        unsigned vp[3][8];
        u32x4 RAW[2][5], CQ[6], CV[6];
        { const u32x4 z4 = (u32x4){0u, 0u, 0u, 0u}; const int seglo = isctx ? 0 : CTXL, seghi = isctx ? CTXL : TPB;
          const bf16_t* pA = P + (size_t)row0 * NP;
#define PREP_RAW(tk) do { const bf16_t* pr = pA + (size_t)(tk) * NP; \
              RAW[tk][0] = (L < 54) ? __builtin_nontemporal_load((const u32x4*)(pr + C_CQ + 8 * L)) : z4; RAW[tk][1] = __builtin_nontemporal_load((const u32x4*)(pr + C_SQ + 8 * L)); RAW[tk][2] = __builtin_nontemporal_load((const u32x4*)(pr + C_DQ + 8 * L)); \
              RAW[tk][3] = __builtin_nontemporal_load((const u32x4*)(pr + C_MQN + 8 * L)); RAW[tk][4] = (L < 48) ? __builtin_nontemporal_load((const u32x4*)(pr + 2560 + 8 * L)) : z4; } while (0)
          PREP_RAW(0);
#pragma unroll
          for (int jj = 0; jj < 6; ++jj) { const int ii = i0 + jj - 2; const bool ok = (ii >= seglo && ii < seghi);
              CQ[jj] = ok ? *(const u32x4*)(pA + (ptrdiff_t)(jj - 2) * NP + 8 * L) : z4; CV[jj] = (ok && L < 32) ? *(const u32x4*)(pA + (ptrdiff_t)(jj - 2) * NP + 512 + 8 * L) : z4; } }
        __builtin_amdgcn_sched_barrier(0);
#pragma unroll
        for (int tk = 0; tk < 2; ++tk) {
            const int row = row0 + tk, i = i0 + tk, kt = i >> 6, kv = i & 63;
            const int t = i - CTXL, rpos = lat ? (t >> 6) : 0, cpos = lat ? (t & 63) : 0;
            float x[8], y[8];
#pragma unroll
            for (int s = 0; s < 2; ++s) {
                const int c = (s == 0) ? 8 * L : 512 + 8 * (L & 31);
                float accv[8];
#pragma unroll
                for (int j = 0; j < 8; ++j) accv[j] = 0.f;
#pragma unroll
                for (int jj = 0; jj < 5; ++jj) { unpack8(s ? CV[tk + jj] : CQ[tk + jj], x); float w8[8]; loadl8(convw + jj * 768 + c, w8);
#pragma unroll
                    for (int j = 0; j < 8; ++j) accv[j] += x[j] * w8[j]; }
                float ss = 0.f;
#pragma unroll
                for (int j = 0; j < 8; ++j) { accv[j] = siluf(accv[j]); ss += accv[j] * accv[j]; }
                ss += dpp_x1(ss); ss += dpp_x2(ss); ss += dpp_m8(ss);
                if (s == 0) { const float nr = __builtin_amdgcn_rsqf(ss + EPS) * ((L < 32) ? 0.125f : 1.f);
#pragma unroll
                    for (int j = 0; j < 8; ++j) y[j] = accv[j] * nr;
                    store8((bf16_t*)(ws + (L < 32 ? B_GQ : B_GK)) + (size_t)row * 256 + 8 * (L & 31), y); }
                else if (L < 32) store8((bf16_t*)(ws + B_GV) + (size_t)row * 256 + 8 * L, accv);
            }
            if (tk == 0) { const u32x4 z4 = (u32x4){0u, 0u, 0u, 0u}; const bf16_t* pA = P + (size_t)row0 * NP; PREP_RAW(1); }
            float r_q, r_kv;
            {
                float ss = 0.f;
                unpack8(RAW[tk][0], x);
#pragma unroll
                for (int j = 0; j < 8; ++j) ss += x[j] * x[j];
                const float p1 = ss + dpp_x1(ss), p2 = p1 + dpp_x2(p1), p3 = p2 + dpp_m8(p2), p4 = p3 + dpp_m16(p3), p5 = p4 + __shfl_xor(p4, 16);
                r_q = __builtin_amdgcn_rsqf(__shfl(p5, 0) * (1.f / 256.f) + EPS); r_kv = __builtin_amdgcn_rsqf(__shfl(p4, 32) * (1.f / 128.f) + EPS);
                const int q = (L - 48) & 3; const float nr = __builtin_amdgcn_rsqf(p2 * (1.f / 32.f) + EPS);
                float g8[8]; loadl8(mla_k + 64 + 8 * q, g8);
#pragma unroll
                for (int j = 0; j < 8; ++j) y[j] = x[j] * nr * g8[j];
                { const int pos = (q & 2) ? cpos : rpos; rope8l<1>(y, lat ? cos32 + pos * 8 : ones8, lat ? sin32 + pos * 8 : zeros8, (q & 1) == 0); }
                if (L >= 48 && L < 52) {
#pragma unroll
                    for (int h = 0; h < 4; ++h) { bf16_t* img = (bf16_t*)(ws + B_KM + ((size_t)((b * 4 + h) * KT_PER_B + kt)) * IMGM); store8(img + 4096 + kv * 32 + ((q ^ ((kv >> 2) & 3)) << 3), y); } }
                { const int gsel = L & 15; const float gv = bf2f(P[(size_t)row * NP + C_GA + gsel]);
                  const float z = gv + a->in[11][l * 8 + (gsel & 7)]; const float sp = (z > 20.f) ? z : __logf(1.f + __expf(z));
                  const float la = -__expf(a->in[10][l * 8 + (gsel & 7)]) * sp, be = sigmoidf(gv);
                  if (L < 16) ((float*)(ws + (gsel < 8 ? B_LA : B_BE)))[((size_t)((gsel >> 2) & 1) * NT + row) * 4 + (gsel & 3)] = (gsel < 8) ? la : be; }
            }
#pragma unroll
            for (int s = 0; s < 2; ++s) {
                unpack8(RAW[tk][1 + s], x);
                float ss = 0.f;
#pragma unroll
                for (int j = 0; j < 8; ++j) ss += x[j] * x[j];
                ss += dpp_x1(ss); ss += dpp_x2(ss); ss += dpp_m8(ss);
                const bool isq = L < 32, isv = L >= 48;
                const float nr = isv ? 1.f : __builtin_amdgcn_rsqf(ss * (1.f / 64.f) + EPS);
                const LAS float* gp = isv ? ones8 : (isq ? (s ? gqa_q : swa_q) : (s ? gqa_k : swa_k)) + 8 * (L & 7);
                float g8[8]; loadl8(gp, g8);
#pragma unroll
                for (int j = 0; j < 8; ++j) y[j] = x[j] * nr * g8[j];
                { const int pos = (L & 4) ? cpos : rpos; const bool rp = lat && !isv;
                  rope8l<2>(y, rp ? cos64 + pos * 16 + 8 * (L & 1) : ones8, rp ? sin64 + pos * 16 + 8 * (L & 1) : zeros8, (L & 2) == 0); }
                const int hk = (L - 32) >> 3;
                bf16_t* qd = (bf16_t*)(ws + (s ? B_QD : B_QS)) + (size_t)row * 256 + 8 * L;
                bf16_t* kd = (bf16_t*)(ws + (s ? B_KD : B_KS) + ((size_t)((b * 2 + (hk & 1)) * KT_PER_B + kt)) * IMG64) + kv * 64 + (((L & 7) ^ ((kv >> 1) & 7)) << 3);
                if (!isv) store8(isq ? qd : kd, y);
#pragma unroll
                for (int j = 0; j < 8; ++j) { if (tk == 0) vt[s][j] = y[j]; else vp[s][j] = pk2(vt[s][j], y[j]); }
            }
            {
                unpack8(RAW[tk][3], x);
                const float pre = (L < 48) ? r_q : r_kv; float ss = 0.f;
#pragma unroll
                for (int j = 0; j < 8; ++j) { x[j] *= pre; ss += x[j] * x[j]; }
                const float p1 = ss + dpp_x1(ss), p2 = p1 + dpp_x2(p1), p3 = p2 + dpp_m8(p2);
                const bool ispe = (L >= 32 && L < 48);
                const float nr = ispe ? __builtin_amdgcn_rsqf(p2 * (1.f / 32.f) + EPS) : __builtin_amdgcn_rsqf(p3 * (1.f / 64.f) + EPS);
                const LAS float* gp = (L < 32) ? mla_q + 8 * (L & 7) : ispe ? mla_q + 64 + 8 * (L & 3) : mla_k + 8 * (L & 7);
                float g8[8]; loadl8(gp, g8);
#pragma unroll
                for (int j = 0; j < 8; ++j) y[j] = x[j] * nr * g8[j];
                { const int pos = (L & 2) ? cpos : rpos; const bool rp = lat && ispe; rope8l<1>(y, rp ? cos32 + pos * 8 : ones8, rp ? sin32 + pos * 8 : zeros8, (L & 1) == 0); }
                const int qoff = (L < 32) ? (L >> 3) * 96 + 8 * (L & 7) : ((L - 32) >> 2) * 96 + 64 + 8 * (L & 3);
                bf16_t* qd = (bf16_t*)(ws + B_QM) + (size_t)row * 384 + qoff;
                bf16_t* kd = (bf16_t*)(ws + B_KM + ((size_t)((b * 4 + (((L - 48) >> 3) & 1)) * KT_PER_B + kt)) * IMGM) + kv * 64 + (((L & 7) ^ ((kv >> 1) & 7)) << 3);
                store8((L < 48) ? qd : kd, y);
            }
            {
                unpack8(RAW[tk][4], x);
                float ss = 0.f;
#pragma unroll
                for (int j = 0; j < 8; ++j) { x[j] *= r_kv; ss += x[j] * x[j]; }
                ss += dpp_x1(ss); ss += dpp_x2(ss); ss += dpp_m8(ss);
                const bool isk = L < 16;
                const float nr = isk ? __builtin_amdgcn_rsqf(ss * (1.f / 64.f) + EPS) : 1.f;
                float g8[8]; loadl8(isk ? mla_k + 8 * (L & 7) : ones8, g8);
#pragma unroll
                for (int j = 0; j < 8; ++j) y[j] = x[j] * nr * g8[j];
                bf16_t* kd = (bf16_t*)(ws + B_KM + ((size_t)((b * 4 + 2 + ((L >> 3) & 1)) * KT_PER_B + kt)) * IMGM) + kv * 64 + (((L & 7) ^ ((kv >> 1) & 7)) << 3);
                if (isk) store8(kd, y);
#pragma unroll
                for (int j = 0; j < 8; ++j) { if (tk == 0) vt[2][j] = y[j]; else vp[2][j] = pk2(vt[2][j], y[j]); }
            }
        }
        { const int kt = i0 >> 6, kv0 = i0 & 63, G = (kv0 >> 4) & 3, hq = (kv0 >> 2) & 1, b4 = ((kv0 & 3) + 4 * ((kv0 & 15) >> 3)) * 2;
          if (L >= 48) { const int hv = (L - 48) >> 3;
#pragma unroll
              for (int s = 0; s < 2; ++s) { unsigned char* img = ws + (s ? B_VD : B_VS) + ((size_t)((b * 2 + hv) * KT_PER_B + kt)) * IMG64;
#pragma unroll
                  for (int j = 0; j < 8; ++j) { const int d = 8 * (L & 7) + j; *(unsigned*)(img + d * 128 + (((2 * G + hq) ^ ((d >> 1) & 7)) << 4) + b4) = vp[s][j]; } } }
          if (L >= 16 && L < 48) { const int h = (L - 16) >> 3; unsigned char* img = ws + B_VM + ((size_t)((b * 4 + h) * KT_PER_B + kt)) * IMG64;
#pragma unroll
              for (int j = 0; j < 8; ++j) { const int d = 8 * (L & 7) + j; *(unsigned*)(img + d * 128 + (((2 * G + hq) ^ ((d >> 1) & 7)) << 4) + b4) = vp[2][j]; } } }
    }
}
constexpr int ATT_SLOT = 24576, ATT_VOFF = 16384;
#define MFMA32(a, b, c) __builtin_amdgcn_mfma_f32_32x32x16_bf16((a), (b), (c), 0, 0, 0)
DI int crow(int r, int hi) { return (r & 3) + 8 * (r >> 2) + 4 * hi; }

constexpr size_t G2_ITEM = 40960;
DI int permpos(int x) { return (2 * (x >> 4) + ((x >> 2) & 1)) * 8 + (x & 3) + 4 * ((x & 15) >> 3); }
DI int fragoff(int row, int ch) { return (((row >> 5) * 4 + (ch >> 1)) * 64 + (ch & 1) * 32 + (row & 31)) * 8; }
DI size_t g2_index(int b, int h, int dir, int c) { return (size_t)(((b * 4 + h) * 2 + dir) * KT_PER_B + c); }

DI void gdn_chunk_phase(const Frame& F, KArgs a, int l) {
    unsigned char* ws = F.ws; int tid_ = F.tid; const int wave = F.wave;
    constexpr int LP = 68;
    LAS float* qs = (LAS float*)F.lds; LAS float* ks = qs + 64 * LP; LAS float* vs = ks + 64 * LP;
    LAS float* KK = vs + 64 * LP; LAS float* QK = KK + 64 * LP; LAS float* AT = QK + 64 * LP;
    LAS float* gl = AT + 2 * 64 * LP; LAS float* bl = gl + 128;
    LAS bf16_t* WS_ = (LAS bf16_t*)KK; LAS bf16_t* US_ = WS_ + 2 * 64 * 64;
    const float* LA = (const float*)(ws + B_LA); const float* BE = (const float*)(ws + B_BE);
    u32x4 pq = {0u, 0u, 0u, 0u}, pk = pq, pv = pq; bf16x8 fa[4], fb[4]; float pla = 0.f, pbe = 0.f;
#pragma unroll
    for (int q = 0; q < 4; ++q) { fa[q] = (bf16x8){0, 0, 0, 0, 0, 0, 0, 0}; fb[q] = fa[q]; }
#define G2_FETCH(it) do { if ((it) < NB * 4 * KT_PER_B) { const int _t = tid_, _ln = _t & 63; const int _b = (it) / (4 * KT_PER_B), _r0 = (it) % (4 * KT_PER_B), _h = _r0 / KT_PER_B, _c = _r0 % KT_PER_B; const int _row0 = _b * TPB + 64 * _c; \
        const size_t _o = (size_t)(_row0 + (_t >> 3)) * 256 + _h * 64 + 8 * (_t & 7); \
        pq = *(const u32x4*)((const bf16_t*)(ws + B_GQ) + _o); pk = *(const u32x4*)((const bf16_t*)(ws + B_GK) + _o); pv = *(const u32x4*)((const bf16_t*)(ws + B_GV) + _o); \
        if (wave < 2) { const int _tok = wave ? 63 - _ln : _ln; pla = LA[((size_t)wave * NT + _row0 + _tok) * 4 + _h]; pbe = BE[((size_t)wave * NT + _row0 + _tok) * 4 + _h]; } \
        { const int _mat = wave >> 2, _mi = (wave >> 1) & 1, _nj = wave & 1, _n = _ln & 31, _hi = _ln >> 5; \
          const bf16_t* _ar = (const bf16_t*)(ws + (_mat ? B_GQ : B_GK)) + (size_t)(_row0 + 32 * _mi + _n) * 256 + _h * 64 + 8 * _hi; \
          const bf16_t* _br = (const bf16_t*)(ws + B_GK) + (size_t)(_row0 + 32 * _nj + _n) * 256 + _h * 64 + 8 * _hi; \
          _Pragma("unroll") for (int _q = 0; _q < 4; ++_q) { fa[_q] = *(const bf16x8*)(_ar + 16 * _q); fb[_q] = *(const bf16x8*)(_br + 16 * _q); } } } } while (0)
    asm volatile("" : "+v"(tid_));
    G2_FETCH(F.vcu);
    for (int item = F.vcu; item < NB * 4 * KT_PER_B; item += F.G) {
        asm volatile("" : "+v"(tid_));
        const int tid = tid_, lane = tid & 63;
        const int b = item / (4 * KT_PER_B), r0 = item % (4 * KT_PER_B), h = r0 / KT_PER_B, c = r0 % KT_PER_B;
        { const int i = tid >> 3, ch = tid & 7;
          float x[8];
          unpack8(pq, x);
#pragma unroll
          for (int j = 0; j < 8; ++j) qs[i * LP + 8 * ch + j] = x[j];
          unpack8(pk, x);
#pragma unroll
          for (int j = 0; j < 8; ++j) ks[i * LP + 8 * ch + j] = x[j];
          unpack8(pv, x);
#pragma unroll
          for (int j = 0; j < 8; ++j) vs[i * LP + 8 * ch + j] = x[j]; }
        if (wave < 2) { const int d = wave;
            float g = pla;
#pragma unroll
            for (int o = 1; o < 64; o <<= 1) { const float t = __shfl_up(g, o); if (lane >= o) g += t; }
            gl[d * 64 + lane] = g; bl[d * 64 + lane] = pbe; }
        {
          const int mat = wave >> 2, mi = (wave >> 1) & 1, nj = wave & 1, n = lane & 31, hi = lane >> 5;
          f32x16 acc;
#pragma unroll
          for (int r = 0; r < 16; ++r) acc[r] = 0.f;
#pragma unroll
          for (int ks4 = 0; ks4 < 4; ++ks4) acc = MFMA32(fa[ks4], fb[ks4], acc);
          LAS float* M = mat ? QK : KK;
#pragma unroll
          for (int r = 0; r < 16; ++r) M[(32 * mi + crow(r, hi)) * LP + 32 * nj + n] = acc[r]; }
        G2_FETCH(item + F.G);
        LDS_WAIT(); __syncthreads();
        { const int d = tid >> 8, t2 = tid & 255, i = t2 >> 2, jq = (t2 & 3) * 16;
          const float gi = gl[d * 64 + i], bi = bl[d * 64 + i];
          const int ti = d ? 63 - i : i;
          bf16_t* qkm = (bf16_t*)(ws + B_G2 + g2_index(b, h, d, c) * G2_ITEM + 2 * 8192);
          float qv[16];
#pragma unroll
          for (int jj = 0; jj < 16; ++jj) { const int j = jq + jj, tj = d ? 63 - j : j;
              const float e = (i >= j) ? __expf(gi - gl[d * 64 + j]) : 0.f;
              AT[(d * 64 + j) * LP + (i & 1) * 32 + (i >> 1)] = (i > j) ? bi * KK[ti * LP + tj] * e : 0.f;
              qv[jj] = QK[ti * LP + tj] * e; }
          { float y0[8] = {qv[0], qv[1], qv[2], qv[3], qv[8], qv[9], qv[10], qv[11]}, y1[8] = {qv[4], qv[5], qv[6], qv[7], qv[12], qv[13], qv[14], qv[15]};
            store8(qkm + fragoff(i, 2 * (jq >> 4)), y0); store8(qkm + fragoff(i, 2 * (jq >> 4) + 1), y1); } }
        LDS_WAIT(); __syncthreads();
        { const int par = tid & 1, col = tid >> 1, d = col >> 7, cc2 = col & 127; const bool isu = cc2 < 64; const int cc = cc2 & 63;
          float r[32];
#pragma unroll
          for (int i2 = 0; i2 < 32; ++i2) { const int i = 2 * i2 + par; const int ti = d ? 63 - i : i; const float bi = bl[d * 64 + i];
              r[i2] = isu ? bi * vs[ti * LP + cc] : bi * __expf(gl[d * 64 + i]) * ks[ti * LP + cc]; }
#pragma clang loop unroll(full)
          for (int j = 0; j < 63; ++j) { const float mine = r[j >> 1], other = dpp_x1(mine); const float xj = ((j & 1) == par) ? mine : other;
              const LAS f32x4* ap = (const LAS f32x4*)(AT + (d * 64 + j) * LP + par * 32);
              const int ib = (j >> 1) >> 2;
#pragma clang loop unroll(full)
              for (int g4 = ib; g4 < 8; ++g4) { const f32x4 av = ap[g4];
#pragma clang loop unroll(full)
                  for (int e4 = 0; e4 < 4; ++e4) { const int i2 = 4 * g4 + e4;
                      if (i2 > (j >> 1)) r[i2] -= av[e4] * xj;
                      else if (i2 == (j >> 1)) { const float a0 = (2 * i2 + par > j) ? av[e4] : 0.f; r[i2] -= a0 * xj; } } }
              if ((j & 3) == 3) asm volatile("" ::: "memory"); }
          LAS bf16_t* dst = (isu ? US_ : WS_) + d * 4096 + cc;
#pragma unroll
          for (int i2 = 0; i2 < 32; ++i2) dst[(2 * i2 + par) * 64] = (bf16_t)f2bf(isu ? r[i2] : -r[i2]); }
#pragma unroll
        for (int q = 0; q < 4; ++q) { const int id = tid + 512 * q, d = id >> 10, mat = (id >> 9) & 1, rowm = (id >> 3) & 63, ch = id & 7;
            float y[8];
            const float glast = gl[d * 64 + 63];
#pragma unroll
            for (int e = 0; e < 8; ++e) { const int x = 16 * (ch >> 1) + 8 * (e >> 2) + 4 * (ch & 1) + (e & 3);
                if (mat == 0) { const int ti = d ? 63 - rowm : rowm; y[e] = qs[ti * LP + x] * __expf(gl[d * 64 + rowm]); }
                else { const int tj = d ? 63 - x : x; y[e] = ks[tj * LP + rowm] * __expf(glast - gl[d * 64 + x]); } }
            store8((bf16_t*)(ws + B_G2 + g2_index(b, h, d, c) * G2_ITEM + (mat ? 3 : 1) * 8192) + fragoff(rowm, ch), y); }
        if (tid < 2) ((float*)(ws + B_DEC))[g2_index(b, h, tid, c)] = __expf(gl[tid * 64 + 63]);
        LDS_WAIT(); __syncthreads();
#pragma unroll
        for (int q = 0; q < 2; ++q) { const int id = tid + 512 * q, d = id >> 9, i = (id >> 3) & 63, ch = id & 7; u32x4 w;
            unsigned hv[8];
#pragma unroll
            for (int e = 0; e < 8; ++e) { const int x = 16 * (ch >> 1) + 8 * (e >> 2) + 4 * (ch & 1) + (e & 3); hv[e] = WS_[d * 4096 + i * 64 + x]; }
            w.x = hv[0] | (hv[1] << 16); w.y = hv[2] | (hv[3] << 16); w.z = hv[4] | (hv[5] << 16); w.w = hv[6] | (hv[7] << 16);
            *(u32x4*)((bf16_t*)(ws + B_G2 + g2_index(b, h, d, c) * G2_ITEM) + fragoff(i, ch)) = w; }
#pragma unroll
        for (int q = 0; q < 2; ++q) { const int id = tid + 512 * q, d = id >> 9, dv = (id >> 3) & 63, qq = id & 7; u32x4 w;
            unsigned hv[8];
#pragma unroll
            for (int e = 0; e < 8; ++e) { const int rr = 8 * (qq & 1) + e, i = 32 * (qq >> 2) + (rr & 3) + 8 * (rr >> 2) + 4 * ((qq >> 1) & 1); hv[e] = US_[d * 4096 + i * 64 + dv]; }
            w.x = hv[0] | (hv[1] << 16); w.y = hv[2] | (hv[3] << 16); w.z = hv[4] | (hv[5] << 16); w.w = hv[6] | (hv[7] << 16);
            *(u32x4*)((bf16_t*)(ws + B_G2 + g2_index(b, h, d, c) * G2_ITEM + 4 * 8192) + (dv >> 5) * 2048 + ((((qq >> 2) * 2 + (qq & 1)) * 64 + ((qq >> 1) & 1) * 32 + (dv & 31)) * 8)) = w; }
        LDS_WAIT(); __syncthreads();
    }
}

#undef G2_FETCH
DI bf16x8 pack8(const f32x16& v, int s8) {
    u32x4 w; w.x = pk2(v[s8 + 0], v[s8 + 1]); w.y = pk2(v[s8 + 2], v[s8 + 3]); w.z = pk2(v[s8 + 4], v[s8 + 5]); w.w = pk2(v[s8 + 6], v[s8 + 7]); return __builtin_bit_cast(bf16x8, w);
}
DI void gdn_scan_wave(unsigned char* ws, int chain, int lane_in) {
    int lane = lane_in; asm volatile("" : "+v"(lane));
    const int hh = chain & 1, dir = (chain >> 1) & 1, h = (chain >> 2) & 3, b = chain >> 4;
    const int n = lane & 31, hi = lane >> 5;
    f32x16 S0, S1;
#pragma unroll
    for (int r = 0; r < 16; ++r) { S0[r] = 0.f; S1[r] = 0.f; }
    float* OD = (float*)(ws + B_OF) + (size_t)dir * NT * 256;
#pragma unroll 1
    for (int s = 0; s < KT_PER_B; ++s) {
        const int c = dir ? (s < 4 ? 3 - s : 135 - s) : s;
        const unsigned char* base = ws + B_G2 + g2_index(b, h, dir, c) * G2_ITEM;
        const float dl = ((const float*)(ws + B_DEC))[g2_index(b, h, dir, c)];
        const unsigned char* ap = base + lane * 16;
        bf16x8 fa[2][8]; u32x4 ut[4];
        { const u32x4* up = (const u32x4*)(base + 4 * 8192 + hh * 4096) + lane;
#pragma unroll
          for (int q = 0; q < 4; ++q) ut[q] = up[q * 64]; }
#pragma unroll
        for (int X = 0; X < 2; ++X)
#pragma unroll
            for (int f = 0; f < 8; ++f) fa[X][f] = *(const bf16x8*)(ap + X * 8192 + f * 1024);
        __builtin_amdgcn_sched_barrier(0);
        bf16x8 sb[4]; sb[0] = pack8(S0, 0); sb[1] = pack8(S0, 8); sb[2] = pack8(S1, 0); sb[3] = pack8(S1, 8);
        f32x16 vn0, vn1, o0, o1;
#pragma unroll
        for (int q = 0; q < 2; ++q) { const u32x4 w = ut[q];
            vn0[8 * q + 0] = bflo(w.x); vn0[8 * q + 1] = bfhi(w.x); vn0[8 * q + 2] = bflo(w.y); vn0[8 * q + 3] = bfhi(w.y); vn0[8 * q + 4] = bflo(w.z); vn0[8 * q + 5] = bfhi(w.z); vn0[8 * q + 6] = bflo(w.w); vn0[8 * q + 7] = bfhi(w.w);
            const u32x4 w1 = ut[2 + q];
            vn1[8 * q + 0] = bflo(w1.x); vn1[8 * q + 1] = bfhi(w1.x); vn1[8 * q + 2] = bflo(w1.y); vn1[8 * q + 3] = bfhi(w1.y); vn1[8 * q + 4] = bflo(w1.z); vn1[8 * q + 5] = bfhi(w1.z); vn1[8 * q + 6] = bflo(w1.w); vn1[8 * q + 7] = bfhi(w1.w); }
#pragma unroll
        for (int r = 0; r < 16; ++r) { o0[r] = 0.f; o1[r] = 0.f; }
#pragma unroll
        for (int G = 0; G < 4; ++G) {
            vn0 = MFMA32(fa[0][G], sb[G], vn0); vn1 = MFMA32(fa[0][4 + G], sb[G], vn1);
            o0 = MFMA32(fa[1][G], sb[G], o0);   o1 = MFMA32(fa[1][4 + G], sb[G], o1); }
        __builtin_amdgcn_sched_barrier(0);
        bf16x8 fb[2][8];
#pragma unroll
        for (int X = 0; X < 2; ++X)
#pragma unroll
            for (int f = 0; f < 8; ++f) fb[X][f] = *(const bf16x8*)(ap + (2 + X) * 8192 + f * 1024);
        __builtin_amdgcn_sched_barrier(0);
        bf16x8 vb[4]; vb[0] = pack8(vn0, 0); vb[1] = pack8(vn0, 8); vb[2] = pack8(vn1, 0); vb[3] = pack8(vn1, 8);
#pragma unroll
        for (int r = 0; r < 16; ++r) { S0[r] *= dl; S1[r] *= dl; }
#pragma unroll
        for (int G = 0; G < 4; ++G) {
            o0 = MFMA32(fb[0][G], vb[G], o0);   o1 = MFMA32(fb[0][4 + G], vb[G], o1);
            S0 = MFMA32(fb[1][G], vb[G], S0);   S1 = MFMA32(fb[1][4 + G], vb[G], S1); }
        { const int rowc = b * TPB + 64 * c; const long sd = dir ? -256 : 256;
          float* p = OD + (size_t)(rowc + (dir ? 63 : 0)) * 256 + h * 64 + 32 * hh + n + sd * 4 * hi;
#pragma unroll
          for (int r = 0; r < 16; ++r) { const int i0 = (r & 3) + 8 * (r >> 2); p[sd * i0] = o0[r]; p[sd * (32 + i0)] = o1[r]; } }
    }
}

DI void gdn_out_bh(unsigned char* ws, KArgs a, int l, int b, int h, int wave, int lane_in) {
    int lane = lane_in; asm volatile("" : "+v"(lane));
    unsigned char* mix = ws + WS_MIX; const bf16_t* P = (const bf16_t*)(ws + B_P); const float* OF = (const float*)(ws + B_OF);
    const int sub = lane >> 4, c4 = h * 64 + 4 * (lane & 15);
    const f32x4 g4 = *(const f32x4*)(a->in[12] + l * 64 + 4 * (lane & 15));
    const int r0 = b * TPB + wave * 4 + sub;
    for (int k = 0; k < TPB / 32; k += 4) {
        f32x4 of[4], ob[4]; u32x2 zw[4];
#pragma unroll
        for (int q = 0; q < 4; ++q) { const size_t row = (size_t)(r0 + 32 * (k + q));
            of[q] = *(const f32x4*)(OF + row * 256 + c4); ob[q] = *(const f32x4*)(OF + (size_t)NT * 256 + row * 256 + c4); zw[q] = *(const u32x2*)(P + row * NP + C_GZ + c4); }
#pragma unroll
        for (int q = 0; q < 4; ++q) { const size_t row = (size_t)(r0 + 32 * (k + q)); const f32x4 o = of[q] + ob[q];
            float ss = o.x * o.x + o.y * o.y + o.z * o.z + o.w * o.w;
            ss += dpp_x1(ss); ss += dpp_x2(ss); ss += dpp_m8(ss); ss += dpp_m16(ss);
            const float r = rsqrtf(ss * (1.f / 64.f) + EPS);
            const float z0 = bflo(zw[q].x), z1 = bfhi(zw[q].x), z2 = bflo(zw[q].y), z3 = bfhi(zw[q].y);
            *(unsigned*)(mix + row * DM + c4) = f8pack(o.x * r * g4.x * siluf(z0), o.y * r * g4.y * siluf(z1), o.z * r * g4.z * siluf(z2), o.w * r * g4.w * siluf(z3)); }
    }
}
DI void gdn_out_phase(const Frame& F, KArgs a, int l) {
    unsigned char* ws = F.ws; int lane_ = F.lane; asm volatile("" : "+v"(lane_)); const int lane = lane_;
    unsigned char* mix = ws + WS_MIX; const bf16_t* P = (const bf16_t*)(ws + B_P);
    const float* OF = (const float*)(ws + B_OF); const float* gg = a->in[12] + l * 64;
    const int gw = F.vcu * 8 + F.wave, NGW = F.G * 8;
    const f32x4 g4 = *(const f32x4*)(gg + 4 * (lane & 15));
    f32x4 nof, nob; u32x2 nz;
#define G4_FETCH(r) do { const int _r = ((r) < NT) ? (r) : gw; nof = *(const f32x4*)(OF + (size_t)_r * 256 + 4 * lane); nob = *(const f32x4*)(OF + (size_t)NT * 256 + (size_t)_r * 256 + 4 * lane); \
        nz = *(const u32x2*)(P + (size_t)_r * NP + C_GZ + 4 * lane); } while (0)
    G4_FETCH(gw);
    for (int row = gw; row < NT; row += NGW) {
        const f32x4 o = nof + nob; const u32x2 zw = nz;
        G4_FETCH(row + NGW);
        float ss = o.x * o.x + o.y * o.y + o.z * o.z + o.w * o.w;
        ss += dpp_x1(ss); ss += dpp_x2(ss); ss += dpp_m8(ss); ss += dpp_m16(ss);
        const float r = rsqrtf(ss * (1.f / 64.f) + EPS);
        const float z0 = bflo(zw.x), z1 = bfhi(zw.x), z2 = bflo(zw.y), z3 = bfhi(zw.y);
        *(unsigned*)(mix + (size_t)row * DM + 4 * lane) = f8pack(o.x * r * g4.x * siluf(z0), o.y * r * g4.y * siluf(z1), o.z * r * g4.z * siluf(z2), o.w * r * g4.w * siluf(z3));
    }
#undef G4_FETCH
}
#ifndef SCAN_REPS
#define SCAN_REPS 1
#endif
struct AttnDesc {
    const bf16_t* Q; int qpitch;
    const unsigned char* Kimg; const unsigned char* Vimg; int kstride;
    int ntiles, nA, base2;
    int mask; int qpos0;
    int has_sink; float sink;
    unsigned char* O;
};

template <int DK, bool NOMAX>
DI void attn_unit(LAS unsigned char* lds, const AttnDesc& D) {
    constexpr int NKS = DK / 16, KP = (DK == 96) ? 2 : 1;
    int tid_ = tidx(); asm volatile("" : "+v"(tid_));
    const int tid = tid_, lane = tid & 63, r32 = lane & 31, hi = lane >> 5; const int wid = __builtin_amdgcn_readfirstlane(tid >> 6);
    bf16x8 qf[NKS];
    { const bf16_t* qp = D.Q + (size_t)(wid * 32 + r32) * D.qpitch + 8 * hi;
#pragma unroll
      for (int ks = 0; ks < NKS; ++ks) qf[ks] = *(const bf16x8*)(qp + 16 * ks); }
    const unsigned lane16 = (unsigned)lane * 16u;
#define ATT_TILE(t) ((t) < D.nA ? (t) : D.base2 + ((t) - D.nA))
#define ATT_DMA_K(t, ksl) do { const unsigned char* _k = D.Kimg + (size_t)ATT_TILE(t) * D.kstride + wid * 1024 + lane16; \
        __builtin_amdgcn_global_load_lds((const unsigned*)_k, (LAS unsigned*)(lds + (ksl) * 16384 + wid * 1024), 16, 0, 0); \
        if (KP == 2) __builtin_amdgcn_global_load_lds((const unsigned*)(_k + 8192), (LAS unsigned*)(lds + (ksl) * 16384 + 8192 + wid * 1024), 16, 0, 0); } while (0)
#define ATT_DMA_V(t, vsl) do { const unsigned char* _v = D.Vimg + (size_t)ATT_TILE(t) * 8192 + wid * 1024 + lane16; \
        __builtin_amdgcn_global_load_lds((const unsigned*)_v, (LAS unsigned*)(lds + 32768 + (vsl) * 8192 + wid * 1024), 16, 0, 0); } while (0)
    const int NTL = D.ntiles;
    const int kswz = (r32 >> 1) & 7, pswz = (r32 >> 2) & 3;
    const int koff0 = r32 * 128, koffp = 8192 + r32 * 64;
    const int qpos = D.qpos0 + wid * 32 + r32;
    f32x16 o0, o1, zero16, S0, S1, N0, N1;
#pragma unroll
    for (int r = 0; r < 16; ++r) { o0[r] = 0.f; o1[r] = 0.f; zero16[r] = 0.f; }
    float m_used = 0.f, lsum = 0.f;
    bf16x8 pf[4];
#pragma unroll
    for (int G = 0; G < 4; ++G) pf[G] = (bf16x8){0, 0, 0, 0, 0, 0, 0, 0};
#define ATT_QK(X0, X1, ksl) do { const LAS unsigned char* _kb = lds + (ksl) * 16384; bf16x8 _a0[NKS], _a1[NKS]; \
        _Pragma("unroll") for (int ks = 0; ks < 4; ++ks) { _a0[ks] = *(const LAS bf16x8*)(_kb + koff0 + (((2 * ks + hi) ^ kswz) << 4)); _a1[ks] = *(const LAS bf16x8*)(_kb + 4096 + koff0 + (((2 * ks + hi) ^ kswz) << 4)); } \
        if (DK == 96) { _Pragma("unroll") for (int ks = 0; ks < 2; ++ks) { _a0[NKS - 2 + ks] = *(const LAS bf16x8*)(_kb + koffp + (((2 * ks + hi) ^ pswz) << 4)); _a1[NKS - 2 + ks] = *(const LAS bf16x8*)(_kb + 2048 + koffp + (((2 * ks + hi) ^ pswz) << 4)); } } \
        if (ATT_PROBE & 1) { _Pragma("unroll") for (int ks = 0; ks < 4; ++ks) { const bf16x8 _e0 = *(const volatile LAS bf16x8*)(_kb + koff0 + (((2 * ks + hi) ^ kswz) << 4)), _e1 = *(const volatile LAS bf16x8*)(_kb + 4096 + koff0 + (((2 * ks + hi) ^ kswz) << 4)); asm volatile("" :: "v"(_e0), "v"(_e1)); } } \
        X0 = MFMA32(_a0[0], qf[0], zero16); X1 = MFMA32(_a1[0], qf[0], zero16); \
        _Pragma("unroll") for (int ks = 1; ks < NKS; ++ks) { X0 = MFMA32(_a0[ks], qf[ks], X0); X1 = MFMA32(_a1[ks], qf[ks], X1); } } while (0)
#define ATT_PV(vsl) do { const LAS unsigned char* _vb = lds + 32768 + (vsl) * 8192; \
        _Pragma("unroll") for (int G = 0; G < 4; ++G) { const bf16x8 _v0 = *(const LAS bf16x8*)(_vb + koff0 + (((2 * G + hi) ^ kswz) << 4)); const bf16x8 _v1 = *(const LAS bf16x8*)(_vb + 4096 + koff0 + (((2 * G + hi) ^ kswz) << 4)); \
            if (ATT_PROBE & 1) { const bf16x8 _e0 = *(const volatile LAS bf16x8*)(_vb + koff0 + (((2 * G + hi) ^ kswz) << 4)), _e1 = *(const volatile LAS bf16x8*)(_vb + 4096 + koff0 + (((2 * G + hi) ^ kswz) << 4)); asm volatile("" :: "v"(_e0), "v"(_e1)); } \
            o0 = MFMA32(_v0, pf[G], o0); o1 = MFMA32(_v1, pf[G], o1); } } while (0)
#define ATT_MAX(t, S0, S1) do { \
        if (D.mask && (t) >= D.nA) { const int _kv0 = (ATT_TILE(t) - 4) * 64; \
            _Pragma("unroll") for (int r = 0; r < 16; ++r) { const int _d0 = qpos - (_kv0 + crow(r, hi)); const int _d1 = _d0 - 32; \
                if (_d0 > 128 || _d0 < -128) S0[r] = -INFINITY; if (_d1 > 128 || _d1 < -128) S1[r] = -INFINITY; } } \
        if constexpr (!NOMAX) { \
        float _mt = fmaxf(S0[0], S1[0]); \
        _Pragma("unroll") for (int r = 1; r < 16; ++r) _mt = fmaxf(_mt, fmaxf(S0[r], S1[r])); \
        { auto _rr = __builtin_amdgcn_permlane32_swap(__float_as_uint(_mt), __float_as_uint(_mt), false, false); _mt = fmaxf(__uint_as_float(_rr[0]), __uint_as_float(_rr[1])); } \
        _mt -= m_used; \
        if (__builtin_expect(__any(_mt > 8.f || m_used != 0.f), 0)) { const float _d = (_mt > 8.f) ? _mt : 0.f; const float _al = __builtin_amdgcn_exp2f(-_d); m_used += _d; lsum *= _al; \
            _Pragma("unroll") for (int r = 0; r < 16; ++r) { S0[r] -= m_used; S1[r] -= m_used; o0[r] *= _al; o1[r] *= _al; } \
            _Pragma("unroll") for (int G = 0; G < 4; ++G) { u32x4 _w = __builtin_bit_cast(u32x4, pf[G]); \
                _w.x = pk2(bflo(_w.x) * _al, bfhi(_w.x) * _al); _w.y = pk2(bflo(_w.y) * _al, bfhi(_w.y) * _al); _w.z = pk2(bflo(_w.z) * _al, bfhi(_w.z) * _al); _w.w = pk2(bflo(_w.w) * _al, bfhi(_w.w) * _al); \
                pf[G] = __builtin_bit_cast(bf16x8, _w); } } } } while (0)
#ifndef ATT_PROBE
#define ATT_PROBE 0
#endif
#define ATT_EXP(S0, S1) do { float _ps = 0.f; \
        if (ATT_PROBE & 2) { _Pragma("unroll") for (int r = 0; r < 16; ++r) { float _d0, _d1; asm volatile("v_exp_f32 %0, %2\n\tv_exp_f32 %1, %3" : "=v"(_d0), "=v"(_d1) : "v"(S0[r]), "v"(S1[r])); } } \
        _Pragma("unroll") for (int r = 0; r < 16; ++r) { S0[r] = __builtin_amdgcn_exp2f(S0[r]); S1[r] = __builtin_amdgcn_exp2f(S1[r]); _ps += S0[r] + S1[r]; } \
        lsum += _ps; pf[0] = pack8(S0, 0); pf[1] = pack8(S0, 8); pf[2] = pack8(S1, 0); pf[3] = pack8(S1, 8); } while (0)
    ATT_DMA_K(0, 0); ATT_DMA_V(0, 0); ATT_DMA_K(1, 1);
    if (KP == 2) asm volatile("s_waitcnt vmcnt(3)\n\ts_barrier" ::: "memory"); else asm volatile("s_waitcnt vmcnt(2)\n\ts_barrier" ::: "memory");
    ATT_QK(S0, S1, 0);
    asm volatile("s_waitcnt vmcnt(0)\n\ts_barrier" ::: "memory");
    ATT_DMA_K(2, 0); ATT_DMA_V(1, 1);
    if constexpr (NOMAX) ATT_DMA_V(2, 2);
    ATT_MAX(0, S0, S1);
    ATT_QK(N0, N1, 1);
    ATT_EXP(S0, S1);
    S0 = N0; S1 = N1;
    constexpr int VR = NOMAX ? 4 : 3;
    int vprev = 0, vnext = VR - 1;
#define ATT_BODY(t, C0, C1, X0, X1) do { \
        if (ATT_PROBE & 4) asm volatile("s_barrier" ::: "memory"); \
        asm volatile("s_waitcnt vmcnt(1)\n\ts_barrier" ::: "memory"); \
        if ((t) + 2 < NTL) ATT_DMA_K((t) + 2, (t) & 1); \
        ATT_DMA_V((t) + 1, vnext); \
        ATT_MAX(t, C0, C1); \
        ATT_PV(vprev); \
        ATT_QK(X0, X1, ((t) + 1) & 1); \
        ATT_EXP(C0, C1); \
        vprev = (vprev == 2) ? 0 : vprev + 1; vnext = (vnext == 2) ? 0 : vnext + 1; } while (0)
    constexpr int MF = 8 + 2 * NKS;
    const unsigned lbase = (unsigned)(size_t)lds;
    unsigned xo[4], xp[2];
#pragma unroll
    for (int G = 0; G < 4; ++G) xo[G] = lbase + koff0 + (((2 * G + hi) ^ kswz) << 4);
#pragma unroll
    for (int ks = 0; ks < 2; ++ks) xp[ks] = lbase + koffp + (((2 * ks + hi) ^ pswz) << 4);
#define ATT_RD(i, KSL, VSL) do { if ((i) < 8) asm volatile("ds_read_b128 %0, %1 offset:%2" : "=v"(_f[(i) < MF ? (i) : 0]) : "v"(xo[((i) >> 1) & 3]), "n"(32768 + (VSL) * 8192 + ((i) & 1) * 4096)); \
        else if ((i) < 16) asm volatile("ds_read_b128 %0, %1 offset:%2" : "=v"(_f[(i) < MF ? (i) : 0]) : "v"(xo[(((i) - 8) >> 1) & 3]), "n"((KSL) * 16384 + ((i) & 1) * 4096)); \
        else if ((i) < MF) asm volatile("ds_read_b128 %0, %1 offset:%2" : "=v"(_f[(i) < MF ? (i) : 0]) : "v"(xp[(((i) - 16) >> 1) & 1]), "n"((KSL) * 16384 + ((i) & 1) * 2048)); } while (0)
#define ATT_CVT(c_, C0, C1) do { const int _G = (c_) >> 2, _p = (c_) & 3, _b = 8 * (_G & 1) + 2 * _p; \
        unsigned _w = (_G < 2) ? pk2(C0[_b], C0[_b + 1]) : pk2(C1[_b], C1[_b + 1]); asm volatile("" : "+v"(_w)); \
        u32x4 _q = __builtin_bit_cast(u32x4, pf[_G]); _q[_p] = _w; pf[_G] = __builtin_bit_cast(bf16x8, _q); } while (0)
#define ATT_G(i, KSL, VP, C0, C1, X0, X1) do { if ((i) < MF) { \
            if ((i) + 3 < MF) ATT_RD((i) + 3, KSL, VP); \
            asm volatile("s_waitcnt lgkmcnt(%1)" : "+v"(_f[(i) < MF ? (i) : 0]) : "n"(((i) + 3 < MF) ? 3 : ((MF - 1 - (i)) > 0 ? (MF - 1 - (i)) : 0))); \
            if ((i) < 8) { if ((i) & 1) { o1 = MFMA32(_f[(i) < MF ? (i) : 0], pf[((i) >> 1) & 3], o1); asm volatile("" : "+v"(o1)); } else { o0 = MFMA32(_f[(i) < MF ? (i) : 0], pf[((i) >> 1) & 3], o0); asm volatile("" : "+v"(o0)); } } \
            else { constexpr int _ks = ((i) - 8) >> 1; if ((i) & 1) { X1 = MFMA32(_f[(i) < MF ? (i) : 0], qf[(_ks >= 0 && _ks < NKS) ? _ks : 0], _ks == 0 ? zero16 : X1); asm volatile("" : "+v"(X1)); } \
                   else { X0 = MFMA32(_f[(i) < MF ? (i) : 0], qf[(_ks >= 0 && _ks < NKS) ? _ks : 0], _ks == 0 ? zero16 : X0); asm volatile("" : "+v"(X0)); } } } \
        if ((i) < 16) { float _e0 = __builtin_amdgcn_exp2f((i) < 8 ? C0[(2 * (i)) & 15] : C1[(2 * (i)) & 15]), _e1 = __builtin_amdgcn_exp2f((i) < 8 ? C0[(2 * (i) + 1) & 15] : C1[(2 * (i) + 1) & 15]); \
            asm volatile("" : "+v"(_e0), "+v"(_e1)); \
            if ((i) < 8) { C0[(2 * (i)) & 15] = _e0; C0[(2 * (i) + 1) & 15] = _e1; } else { C1[(2 * (i)) & 15] = _e0; C1[(2 * (i) + 1) & 15] = _e1; } \
            } \
        if ((i) >= 1 && (i) <= 16) { constexpr int _j = (i) - 1;        \
            _ps0 += (_j < 8 ? C0[(2 * _j) & 15] : C1[(2 * _j) & 15]); _ps1 += (_j < 8 ? C0[(2 * _j + 1) & 15] : C1[(2 * _j + 1) & 15]); asm volatile("" : "+v"(_ps0), "+v"(_ps1)); } \
        if ((i) >= 4) ATT_CVT((i) - 4, C0, C1); \
        __builtin_amdgcn_sched_barrier(0); } while (0)
#define ATT_BODY_F(t, KSL, VP, C0, C1, X0, X1) do {        \
        asm volatile("s_waitcnt vmcnt(1)\n\ts_barrier" ::: "memory"); \
        if ((t) + 2 < NTL) { ATT_DMA_K((t) + 2, (t) & 1); ATT_DMA_V((t) + 2, ((VP) + 3) & 3); } \
        if (D.mask && (t) >= D.nA) { const int _kv0 = (ATT_TILE(t) - 4) * 64; \
            _Pragma("unroll") for (int r = 0; r < 16; ++r) { const int _d0 = qpos - (_kv0 + crow(r, hi)); const int _d1 = _d0 - 32; \
                if (_d0 > 128 || _d0 < -128) C0[r] = -INFINITY; if (_d1 > 128 || _d1 < -128) C1[r] = -INFINITY; } } \
        float _ps0 = 0.f, _ps1 = 0.f; \
        __builtin_amdgcn_sched_barrier(0); \
        ATT_G(0, KSL, VP, C0, C1, X0, X1); ATT_G(1, KSL, VP, C0, C1, X0, X1); ATT_G(2, KSL, VP, C0, C1, X0, X1); ATT_G(3, KSL, VP, C0, C1, X0, X1); ATT_G(4, KSL, VP, C0, C1, X0, X1); \
        ATT_G(5, KSL, VP, C0, C1, X0, X1); ATT_G(6, KSL, VP, C0, C1, X0, X1); ATT_G(7, KSL, VP, C0, C1, X0, X1); ATT_G(8, KSL, VP, C0, C1, X0, X1); ATT_G(9, KSL, VP, C0, C1, X0, X1); \
        ATT_G(10, KSL, VP, C0, C1, X0, X1); ATT_G(11, KSL, VP, C0, C1, X0, X1); ATT_G(12, KSL, VP, C0, C1, X0, X1); ATT_G(13, KSL, VP, C0, C1, X0, X1); ATT_G(14, KSL, VP, C0, C1, X0, X1); \
        ATT_G(15, KSL, VP, C0, C1, X0, X1); ATT_G(16, KSL, VP, C0, C1, X0, X1); ATT_G(17, KSL, VP, C0, C1, X0, X1); ATT_G(18, KSL, VP, C0, C1, X0, X1); ATT_G(19, KSL, VP, C0, C1, X0, X1); \
        lsum += _ps0 + _ps1; \
        ATT_RD(0, KSL, ((VP) + 1) & 3); ATT_RD(1, KSL, ((VP) + 1) & 3); ATT_RD(2, KSL, ((VP) + 1) & 3);        \
        __builtin_amdgcn_sched_barrier(0); } while (0)
    int t = 1;
    bf16x8 _f[MF];
    if constexpr (NOMAX) {
        ATT_RD(0, 0, 0); ATT_RD(1, 0, 0); ATT_RD(2, 0, 0);
        __builtin_amdgcn_sched_barrier(0);
#pragma unroll 1
        for (; t + 3 < NTL - 1; t += 4) { ATT_BODY_F(t, 0, 0, S0, S1, N0, N1); ATT_BODY_F(t + 1, 1, 1, N0, N1, S0, S1); ATT_BODY_F(t + 2, 0, 2, S0, S1, N0, N1); ATT_BODY_F(t + 3, 1, 3, N0, N1, S0, S1); }
        if (t < NTL - 1) { ATT_BODY_F(t, 0, 0, S0, S1, N0, N1); ++t;
            if (t < NTL - 1) { ATT_BODY_F(t, 1, 1, N0, N1, S0, S1); ++t;
                if (t < NTL - 1) { ATT_BODY_F(t, 0, 2, S0, S1, N0, N1); ++t; S0 = N0; S1 = N1; } }
            else { S0 = N0; S1 = N1; } }
        vprev = (NTL - 2) & 3;
        asm volatile("s_waitcnt lgkmcnt(0)" : "+v"(_f[0]), "+v"(_f[1]), "+v"(_f[2]));
    } else {
#pragma unroll 1
        for (; t + 1 < NTL - 1; t += 2) { ATT_BODY(t, S0, S1, N0, N1); ATT_BODY(t + 1, N0, N1, S0, S1); }
        if (t < NTL - 1) { ATT_BODY(t, S0, S1, N0, N1); S0 = N0; S1 = N1; }
    }
    asm volatile("s_waitcnt vmcnt(1)\n\ts_barrier" ::: "memory");
    ATT_MAX(NTL - 1, S0, S1);
    ATT_PV(vprev);
    ATT_EXP(S0, S1);
    vprev = (vprev == VR - 1) ? 0 : vprev + 1;
    asm volatile("s_waitcnt vmcnt(0)\n\ts_barrier" ::: "memory");
    ATT_PV(vprev);
    float lt = lsum;
    { auto rr = __builtin_amdgcn_permlane32_swap(__float_as_uint(lt), __float_as_uint(lt), false, false); lt = __uint_as_float(rr[0]) + __uint_as_float(rr[1]); }
    if (D.has_sink) lt += __builtin_amdgcn_exp2f(D.sink * LOG2E - m_used);
    const float inv = 1.f / lt;
    unsigned char* op = D.O + (size_t)(wid * 32 + r32) * DM + 4 * hi;
#pragma unroll
    for (int rr = 0; rr < 4; ++rr) {
        *(unsigned*)(op + 8 * rr) = f8pack(o0[4 * rr] * inv, o0[4 * rr + 1] * inv, o0[4 * rr + 2] * inv, o0[4 * rr + 3] * inv);
        *(unsigned*)(op + 32 + 8 * rr) = f8pack(o1[4 * rr] * inv, o1[4 * rr + 1] * inv, o1[4 * rr + 2] * inv, o1[4 * rr + 3] * inv); }
    asm volatile("s_waitcnt lgkmcnt(0)\n\ts_barrier" ::: "memory");
#undef ATT_TILE
#undef ATT_DMA_K
#undef ATT_DMA_V
#undef ATT_QK
#undef ATT_PV
#undef ATT_MAX
#undef ATT_EXP
#undef ATT_BODY
#undef ATT_BODY_F
#undef ATT_RD
#undef ATT_G
#undef ATT_CVT
}

DI void attn_phase(const Frame& F, KArgs a, int l, int rep) {
    unsigned char* ws = F.ws; LAS unsigned char* lds = F.lds;
    const int NUNITS = 16 + ((l == 0) ? 1584 : 1536);
    unsigned* queue = F.ctl + CW_QUEUE + 64 * l + 32 * rep;
    unsigned char* mix = ws + WS_MIX;
    if (F.wave == 0) { const float* sg = a->in[18] + l * 128; const float* gg = a->in[20] + l * 128; const float* mg = a->in[17] + l * 192; const int ln = F.lane;
        const float sq = wave_max(fabsf(sg[ln])), sk = wave_max(fabsf(sg[64 + ln])), gq = wave_max(fabsf(gg[ln])), gk = wave_max(fabsf(gg[64 + ln]));
        const float mqn = wave_max(fabsf(mg[ln])), mqp = wave_max(fabsf(mg[64 + (ln & 31)])), mkn = wave_max(fabsf(mg[96 + ln])), mkp = wave_max(fabsf(mg[160 + (ln & 31)]));
        const float bs = 65.f * sq * sk * QSCALE64, bg = 65.f * gq * gk * QSCALE64, bm = 1.02f * sqrtf(64.f * mqn * mqn + 32.f * mqp * mqp) * sqrtf(64.f * mkn * mkn + 32.f * mkp * mkp) * QSCALEM;
        const float smax = fmaxf(fmaxf(fabsf(a->in[19][l * 4 + 0]), fabsf(a->in[19][l * 4 + 1])), fmaxf(fabsf(a->in[19][l * 4 + 2]), fabsf(a->in[19][l * 4 + 3]))) * LOG2E;
        if (ln == 0) F.MISC[193] = ((bs <= 64.f && smax <= 64.f) ? 1u : 0u) | ((bg <= 64.f) ? 2u : 0u) | ((bm <= 64.f) ? 4u : 0u); }
    __syncthreads();
    const unsigned fastf = (unsigned)__builtin_amdgcn_readfirstlane((int)F.MISC[193]);
    for (;;) {
        if (F.tid == 0) F.MISC[192] = __hip_atomic_fetch_add(queue, 1u, __ATOMIC_RELAXED, __HIP_MEMORY_SCOPE_AGENT);
        __syncthreads();
        int u = __builtin_amdgcn_readfirstlane((int)F.MISC[192]);
        __syncthreads();
        if (u >= NUNITS) break;
        if (u < 16) { if (F.wave < 4) { for (int rp = 0; rp < SCAN_REPS; ++rp) gdn_scan_wave(ws, u * 4 + F.wave, F.lane); }
            __threadfence(); __syncthreads(); __threadfence();
            gdn_out_bh(ws, a, l, u >> 2, u & 3, F.wave, F.lane); continue; }
        u -= 16;
        int type, b, h, qt; bool ctxq = false;
        if (u < 1536) { type = u >> 9; const int v = u & 511; b = v >> 7; h = (v >> 5) & 3; qt = v & 31; if (type == 1) type = 2; else if (type == 2) type = 1; }
        else { const int v = u - 1536; type = v >> 4; b = (v >> 2) & 3; h = v & 3; qt = 0; ctxq = true; }
        const int row0 = b * TPB + (ctxq ? 0 : CTXL + qt * 256);
        AttnDesc D;
        D.ntiles = ctxq ? 4 : KT_PER_B; D.nA = D.ntiles; D.base2 = 0; D.mask = 0; D.qpos0 = qt * 256; D.has_sink = 0; D.sink = 0.f;
        if (type == 0) {
            D.Q = (const bf16_t*)(ws + B_QM) + (size_t)row0 * 384 + h * 96; D.qpitch = 384;
            D.Kimg = ws + B_KM + (size_t)((b * 4 + h) * KT_PER_B) * IMGM; D.kstride = (int)IMGM; D.Vimg = ws + B_VM + (size_t)((b * 4 + h) * KT_PER_B) * IMG64;
            D.O = mix + (size_t)row0 * DM + 256 + h * 64;
            if (fastf & 4u) attn_unit<96, true>(lds, D); else attn_unit<96, false>(lds, D);
        } else {
            const int hk = h >> 1;
            D.Q = (const bf16_t*)(ws + (type == 1 ? B_QS : B_QD)) + (size_t)row0 * 256 + h * 64; D.qpitch = 256;
            D.Kimg = ws + (type == 1 ? B_KS : B_KD) + (size_t)((b * 2 + hk) * KT_PER_B) * IMG64; D.kstride = (int)IMG64;
            D.Vimg = ws + (type == 1 ? B_VS : B_VD) + (size_t)((b * 2 + hk) * KT_PER_B) * IMG64;
            D.O = mix + (size_t)row0 * DM + (type == 1 ? 512 : 768) + h * 64;
            if (type == 1) { D.has_sink = 1; D.sink = a->in[19][l * 4 + h];
                if (!ctxq) { const int lo = (qt * 256 - 128 < 0) ? 0 : qt * 256 - 128, hiq = (qt * 256 + 383 > SEQ - 1) ? SEQ - 1 : qt * 256 + 383;
                    D.nA = 4; D.base2 = 4 + (lo >> 6); D.ntiles = 4 + ((hiq >> 6) - (lo >> 6) + 1); D.mask = 1; } }
            if (fastf & (type == 1 ? 1u : 2u)) attn_unit<64, true>(lds, D); else attn_unit<64, false>(lds, D);
        }
    }
}
DI void moe_tables(const Frame& F, int l) {
    LAS int* tstart = (LAS int*)(F.MISC + 16); LAS int* ecnt = (LAS int*)(F.MISC + 96);
    if (F.tid < 64) ecnt[F.tid] = (int)__hip_atomic_load(F.ctl + CW_ECNT + l * 64 + F.tid, __ATOMIC_RELAXED, __HIP_MEMORY_SCOPE_AGENT);
    LDS_WAIT(); __syncthreads();
    if (F.tid < 64) {
        const int tiles = (ecnt[F.tid] + 255) >> 8; int incl = tiles;
#pragma unroll
        for (int o = 1; o < 64; o <<= 1) { const int t = __shfl_up(incl, o); if ((int)F.tid >= o) incl += t; }
        tstart[F.tid] = incl - tiles;
        if (F.tid == 63) { tstart[64] = incl; tstart[65] = incl + NT / 256; } }
    LDS_WAIT(); __syncthreads();
}

DI void topk_phase(const Frame& F, KArgs a, int l) {
    unsigned char* ws = F.ws; int tid_ = F.tid; asm volatile("" : "+v"(tid_)); const int tid = tid_, lane = tid & 63, wave = F.wave;
    constexpr int TPI = 132;
    LAS int* hist = (LAS int*)F.lds; LAS int* base = hist + 64; LAS int* selL = hist + 128; LAS float* gateL = (LAS float*)(hist + 128 + TPI * 6);
    const float* LOGI = (const float*)(ws + WS_LOG); const float bias = a->in[23][l * 64 + lane];
    int* LIST = (int*)(ws + WS_LIST); float* GATES = (float*)(ws + WS_GLIST); int* POS = (int*)(ws + WS_POS);
    unsigned* ecnt = F.ctl + CW_ECNT + l * 64;
    for (int item = F.vcu; item < NT / TPI; item += F.G) {
        if (tid < 64) hist[tid] = 0;
        LDS_WAIT(); __syncthreads();
        const int t0 = (wave < 4) ? wave * 17 : 68 + (wave - 4) * 16, nt = (wave < 4) ? 17 : 16;
        float lg[17];
#pragma unroll
        for (int tl = 0; tl < 17; ++tl) { const int tokl = t0 + ((tl < nt) ? tl : 0); lg[tl] = LOGI[(size_t)(item * TPI + tokl) * 64 + lane]; }
#pragma unroll
        for (int tl = 0; tl < 17; ++tl) {
            if (tl < nt) {
            const int tokl = t0 + tl;
            const float score = sigmoidf(lg[tl]);
            float val = score + bias; int mye = 0; float mys = 0.f, ssum = 0.f;
#pragma unroll
            for (int k = 0; k < TOPK; ++k) {
                float v = val; int i = lane;
#pragma unroll
                for (int st = 0; st < 6; ++st) { float ov; int oi;
                    if (st == 0) { ov = dpp_x1(v); oi = dpp_x1i(i); } else if (st == 1) { ov = dpp_x2(v); oi = dpp_x2i(i); } else if (st == 2) { ov = dpp_m8(v); oi = dpp_m8i(i); }
                    else if (st == 3) { ov = dpp_m16(v); oi = dpp_m16i(i); } else if (st == 4) { ov = __shfl_xor(v, 16); oi = __shfl_xor(i, 16); } else { ov = __shfl_xor(v, 32); oi = __shfl_xor(i, 32); }
                    if (ov > v || (ov == v && oi < i)) { v = ov; i = oi; } }
                const float sk = __shfl(score, i); ssum += sk;
                if (lane == k) { mye = i; mys = sk; }
                if (lane == i) val = -INFINITY;
            }
            if (lane < TOPK) { const int rank = __hip_atomic_fetch_add(&hist[mye], 1, __ATOMIC_RELAXED, __HIP_MEMORY_SCOPE_WORKGROUP); selL[tokl * 6 + lane] = mye | (rank << 8); gateL[tokl * 6 + lane] = mys / ssum * 2.5f; }
            }
        }
        LDS_WAIT(); __syncthreads();
        if (tid < 64) { const int hcnt = hist[tid]; base[tid] = hcnt ? (int)__hip_atomic_fetch_add(ecnt + tid, (unsigned)hcnt, __ATOMIC_RELAXED, __HIP_MEMORY_SCOPE_AGENT) : 0; }
        LDS_WAIT(); __syncthreads();
        for (int idx = tid; idx < TPI * 6; idx += 512) { const int tokl = idx / 6, k = idx % 6, sv = selL[idx], e = sv & 0xff, slot = base[e] + (sv >> 8), row = item * TPI + tokl;
            LIST[(size_t)e * NT + slot] = row; ((float*)(ws + WS_SAL))[(size_t)e * NT + slot] = ((const float*)(ws + WS_SA))[row]; GATES[(size_t)row * 8 + k] = gateL[idx]; POS[(size_t)row * 8 + k] = (e << 16) | slot; }
        LDS_WAIT(); __syncthreads();
    }
}

DI void combine_phase(const Frame& F, KArgs a, int l) {
    unsigned char* ws = F.ws; int lane_ = F.lane; asm volatile("" : "+v"(lane_)); const int lane = lane_;
    const LAS int* tstart = (const LAS int*)(F.MISC + 16);
    const bf16_t* Y = (const bf16_t*)(ws + WS_BIG); const int* POS = (const int*)(ws + WS_POS); const float* GATES = (const float*)(ws + WS_GLIST);
    bf16_t* X = (bf16_t*)(ws + WS_X); const float* mod = (const float*)(F.ctl + CW_MOD) + (size_t)l * 5 * 6144;
    const int gw = F.vcu * 8 + F.wave, NGW = F.G * 8;
    const int sbase = tstart[64] * 256;
    u32x4 pw0, pw1, gw0, gw1;
    if (gw < NT) { pw0 = *(const u32x4*)(POS + (size_t)gw * 8); pw1 = *(const u32x4*)(POS + (size_t)gw * 8 + 4); gw0 = *(const u32x4*)(GATES + (size_t)gw * 8); gw1 = *(const u32x4*)(GATES + (size_t)gw * 8 + 4); }
    for (int row = gw; row < NT; row += NGW) {
        const int b = row / TPB, i = row % TPB; const bool isctx = i < CTXL;
        const u32x4 cp0 = pw0, cp1 = pw1, cg0 = gw0, cg1 = gw1;
        { const int nrow = (row + NGW < NT) ? row + NGW : row;
          pw0 = *(const u32x4*)(POS + (size_t)nrow * 8); pw1 = *(const u32x4*)(POS + (size_t)nrow * 8 + 4); gw0 = *(const u32x4*)(GATES + (size_t)nrow * 8); gw1 = *(const u32x4*)(GATES + (size_t)nrow * 8 + 4); }
        if (l == 1 && isctx) continue;
        const float* md = mod + (size_t)(isctx ? 4 : b) * 6144;
        int pr[7]; float gt[7];
        { const unsigned pv[6] = {cp0.x, cp0.y, cp0.z, cp0.w, cp1.x, cp1.y}; const unsigned gvv[6] = {cg0.x, cg0.y, cg0.z, cg0.w, cg1.x, cg1.y};
#pragma unroll
          for (int k = 0; k < 6; ++k) { const int p = (int)pv[k]; pr[k] = tstart[p >> 16] * 256 + (p & 0xffff); gt[k] = __builtin_bit_cast(float, gvv[k]); } }
        pr[6] = sbase + row; gt[6] = 1.f;
        float xo[2][8];
#pragma unroll
        for (int j = 0; j < 2; ++j) { const int col = 8 * lane + 512 * j; float acc[8];
#pragma unroll
            for (int q = 0; q < 8; ++q) acc[q] = 0.f;
#pragma unroll
            for (int k = 0; k < 7; ++k) { float y[8]; unpack8(__builtin_nontemporal_load((const u32x4*)(Y + (size_t)pr[k] * DM + col)), y);
#pragma unroll
                for (int q = 0; q < 8; ++q) acc[q] += gt[k] * y[q]; }
            float xr[8], g5[8]; load8(X + (size_t)row * DM + col, xr); loadf8(md + 5 * DM + col, g5);
#pragma unroll
            for (int q = 0; q < 8; ++q) xo[j][q] = xr[q] + g5[q] * acc[q]; }
        if (l == 0) {
            float ss = 0.f;
#pragma unroll
            for (int j = 0; j < 2; ++j) { store8(X + (size_t)row * DM + 8 * lane + 512 * j, xo[j]);
#pragma unroll
                for (int q = 0; q < 8; ++q) ss += xo[j][q] * xo[j][q]; }
            const float r = rsqrtf(wave_sum(ss) * (1.f / DM) + EPS);
            const float* md1 = (const float*)(F.ctl + CW_MOD) + (size_t)5 * 6144 + (size_t)(isctx ? 4 : b) * 6144; const float* g1 = a->in[6] + DM;
            float mxo = 0.f;
#pragma unroll
            for (int j = 0; j < 2; ++j) { const int col = 8 * lane + 512 * j; float gg[8], sh[8], sc[8]; loadf8(g1 + col, gg); loadf8(md1 + col, sh); loadf8(md1 + DM + col, sc);
#pragma unroll
                for (int q = 0; q < 8; ++q) { xo[j][q] = xo[j][q] * r * gg[q] * (1.f + sc[q]) + sh[q]; mxo = fmaxf(mxo, fabsf(xo[j][q])); } }
            mxo = wave_max(mxo); const float inv = mxo > 0.f ? 127.f / mxo : 0.f;
#pragma unroll
            for (int j = 0; j < 2; ++j) { u32x2 w; w.x = q8pack(xo[j][0], xo[j][1], xo[j][2], xo[j][3], inv); w.y = q8pack(xo[j][4], xo[j][5], xo[j][6], xo[j][7], inv);
                *(u32x2*)(ws + WS_H8 + (size_t)row * DM + 8 * lane + 512 * j) = w; }
            if (lane == 0) ((float*)(ws + WS_SA))[row] = mxo * (1.f / 127.f);
        } else {
            float* op = a->out + ((size_t)b * SEQ + (i - CTXL)) * DM;
#pragma unroll
            for (int j = 0; j < 2; ++j) { f32x4* xp = (f32x4*)(op + 8 * lane + 512 * j); xp[0] = (f32x4){xo[j][0], xo[j][1], xo[j][2], xo[j][3]}; xp[1] = (f32x4){xo[j][4], xo[j][5], xo[j][6], xo[j][7]}; }
        }
    }
}
#ifndef DBG_PHASES
#define DBG_PHASES 0
#endif
constexpr int NPHASES = 2 + 24;
DI KArgs kargs() { KArgs ap = (KArgs)__builtin_amdgcn_kernarg_segment_ptr(); asm volatile("" : "+s"(ap)); return ap; }
DI Frame make_frame() {
    Frame F; int tid = tidx(); asm volatile("" : "+v"(tid)); int bx = blockIdx.x, G = gridDim.x; asm volatile("" : "+s"(bx), "+s"(G));
    F.lds = (LAS unsigned char*)lds_raw; F.MISC = (volatile LAS unsigned*)(F.lds + MISC_OFF);
    F.tid = tid; F.lane = tid & 63; F.wave = __builtin_amdgcn_readfirstlane(tid >> 6);
    F.G = G; F.vcu = (G % 8 == 0) ? (bx % 8) * (G / 8) + bx / 8 : bx; F.bx = bx;
    F.ws = kargs()->ws; F.ctl = (unsigned*)(F.ws + WS_CTL);
    return F;
}
#ifndef PH_MASK
#define PH_MASK 0xFFFFFFFFu
#endif
#define PHON(j) (((PH_MASK) >> (j)) & 1u)
#ifndef DUP_MASK
#define DUP_MASK 0u
#endif
#ifndef DUP_L
#define DUP_L 0
#endif
#define NREP(j) ((((DUP_MASK) >> (j)) & 1u) && l == DUP_L ? 2 : 1)
__global__ void __launch_bounds__(512, 2) mega_fwd(Args args) {
    { LAS unsigned* m = (LAS unsigned*)(lds_raw + MISC_OFF); for (int u = threadIdx.x; u < (LDS_BYTES - MISC_OFF) / 4; u += 512) m[u] = 0u; }
    __syncthreads();
    if ((threadIdx.x & 63) == 0) *(volatile LAS int*)(lds_raw + TIDTAB_OFF + 4 * hw_wave_slot()) = (int)(threadIdx.x >> 6);
    __syncthreads();
    const int lo = args.ph_lo, hi = args.ph_hi;
    if (hi - lo > 1) { const Frame F = make_frame(); (void)xcd_barrier_post(F.ctl + CW_BAR, F.MISC); }
#define IN(k) (lo <= (k) && (k) < hi)
#define SEAM(k) do { if (IN(k) && IN((k) + 1)) { const Frame Fb = make_frame(); XcdBarrier bar; bar.bar = Fb.ctl + CW_BAR; bar.x = xb_xcc_id(); bar.st = Fb.MISC; xcd_barrier(bar); } } while (0)
#define SEAMX() do { const Frame Fb = make_frame(); XcdBarrier bar; bar.bar = Fb.ctl + CW_BAR; bar.x = xb_xcc_id(); bar.st = Fb.MISC; xcd_barrier(bar); } while (0)
    if (PHON(0) && IN(0)) { for (int rep = 0; rep < ((DUP_MASK & 1u) ? 2 : 1); ++rep) { if (rep) SEAMX(); const Frame F = make_frame(); p0_prologue(F, kargs()); } } SEAM(0);
    if (PHON(1) && IN(1)) {
        const Frame F = make_frame(); KArgs A_ = kargs(); const int gw = F.vcu * 8 + F.wave, NGW = F.G * 8; bf16_t* H = (bf16_t*)(F.ws + WS_H); const float* modall = (const float*)(F.ctl + CW_MOD);
        for (int row = gw; row < NT; row += NGW) { const int b = row / TPB, i = row % TPB; const float* md = modall + (size_t)(i < CTXL ? 4 : b) * 6144;
            norm_row(resid_row_l0(A_, row), A_->in[6], md, md + DM, (unsigned*)(F.ws + WS_H8 + (size_t)row * DM), (float*)(F.ws + WS_SA) + row, F.lane); }
        for (int r = gw; r < 2 * 896; r += NGW) fold_quant_row(F.ws, F.ctl, r, F.lane);
    } SEAM(1);
#pragma unroll
    for (int l = 0; l < 2; ++l) {
        const int pb = 2 + 12 * l;
        if (PHON(2) && IN(pb + 0)) { for (int rep = 0; rep < NREP(2); ++rep) { if (rep) SEAMX();
            const Frame F = make_frame(); unsigned char* ws = F.ws;
            pg8::SchedDense S{(const char*)(ws + WS_H8), (const char*)(ws + WS_WIN + l * WIN8_L), DM / 2, NT / 256, NP / 256, F.G, F.bx, false};
            pg8::EpiPI8 E{(bf16_t*)(ws + B_P), NP, (const float*)(ws + WS_SA), (const unsigned*)(F.ctl + CW_CMAXW) + l * NP};
            pg8::gemm_phase<pg8::EpiPI8, pg8::SchedDense, false, 0, true>(F.lds, DM / 2, S, E);
        } } SEAM(pb + 0);
        if (PHON(3) && IN(pb + 1)) { for (int rep = 0; rep < NREP(3); ++rep) { if (rep) SEAMX(); const Frame F = make_frame(); prep_phase(F, kargs(), l, rep); } } SEAM(pb + 1);
        if (PHON(4) && IN(pb + 2)) { for (int rep = 0; rep < NREP(4); ++rep) { if (rep) SEAMX(); const Frame F = make_frame(); gdn_chunk_phase(F, kargs(), l); } } SEAM(pb + 2);
        if (PHON(5) && IN(pb + 3)) { for (int rep = 0; rep < NREP(5); ++rep) { if (rep) SEAMX(); const Frame F = make_frame(); attn_phase(F, kargs(), l, rep); } } SEAM(pb + 3);
#ifdef EXTRA_BARS
        if (l == 0 && IN(pb + 5)) { for (int xb = 0; xb < EXTRA_BARS; ++xb) SEAMX(); }
#endif
        if (PHON(7) && IN(pb + 5)) { for (int rep = 0; rep < NREP(7); ++rep) { if (rep) SEAMX();
            const Frame F = make_frame(); unsigned char* ws = F.ws; KArgs A_ = kargs();
            pg8::SchedDense S{(const char*)(ws + WS_MIX), (const char*)(ws + WS_WOUT + l * (size_t)DM * DM), DM / 2, (l == 0) ? NT / 256 : 128, 4, F.G, F.bx, l == 1};
            pg8::EpiResidF8 E{A_->in[0], A_->in[2], (bf16_t*)(ws + WS_X), (const float*)(F.ctl + CW_MOD) + (size_t)l * 5 * 6144, l == 0 ? 1 : 0, (const float*)(F.ctl + CW_CMAXO) + l * DM};
            pg8::gemm_phase<pg8::EpiResidF8, pg8::SchedDense, false, 0, 2>(F.lds, DM / 2, S, E);
        } } SEAM(pb + 5);
        if (PHON(8) && IN(pb + 6)) { for (int rep = 0; rep < NREP(8); ++rep) { if (rep) SEAMX();
            const Frame F = make_frame(); const int gw = F.vcu * 8 + F.wave, NGW = F.G * 8; const float* g2 = kargs()->in[7] + l * DM;
            const bf16_t* X = (const bf16_t*)(F.ws + WS_X); bf16_t* H = (bf16_t*)(F.ws + WS_H); const float* mod = (const float*)(F.ctl + CW_MOD) + (size_t)l * 5 * 6144;
            for (int row = gw; row < NT; row += NGW) { const int b = row / TPB, i = row % TPB; const float* md = mod + (size_t)(i < CTXL ? 4 : b) * 6144;
                norm_row_q(X + (size_t)row * DM, g2, md + 3 * DM, md + 4 * DM, H + (size_t)row * DM, (unsigned*)(F.ws + WS_H8 + (size_t)row * DM), (float*)(F.ws + WS_SA) + row, F.lane); }
        } } SEAM(pb + 6);
        if (PHON(9) && IN(pb + 7)) { for (int rep = 0; rep < NREP(9); ++rep) { if (rep) SEAMX();
            const Frame F = make_frame(); unsigned char* ws = F.ws;
            pg8::SchedDense S{(const char*)(ws + WS_H), (const char*)(ws + WS_WR + l * WR_L), DM, NT / 256, 1, F.G, F.bx, false};
            pg8::EpiRouter E{(float*)(ws + WS_LOG)};
            pg8::gemm_phase<pg8::EpiRouter, pg8::SchedDense, false, 0>(F.lds, DM, S, E);
        } } SEAM(pb + 7);
        if (PHON(10) && IN(pb + 8)) { for (int rep = 0; rep < NREP(10); ++rep) { if (rep) SEAMX(); const Frame F = make_frame(); topk_phase(F, kargs(), l); } } SEAM(pb + 8);
        if (PHON(11) && IN(pb + 9)) { for (int rep = 0; rep < NREP(11); ++rep) { if (rep) SEAMX();
            const Frame F = make_frame(); unsigned char* ws = F.ws;
            moe_tables(F, l);
            pg8::SchedMoE<3> S{(const LAS int*)(F.MISC + 16), (const LAS int*)(F.MISC + 96), (const char*)(ws + WS_H8), (const char*)(ws + WS_WGU + l * WGU8_L), DM / 2, F.G, F.vcu, (int)WGU8_E, true};
            pg8::EpiSwigluI8F8 E{(unsigned char*)(ws + WS_ACT), (const float*)(ws + WS_SAL), (const float*)(ws + WS_SA), (const unsigned*)(F.ctl + CW_CMAX) + l * 65 * 768};
            pg8::gemm_phase<pg8::EpiSwigluI8F8, pg8::SchedMoE<3>, true, NT, 1>(F.lds, DM / 2, S, E, (const int*)(ws + WS_LIST), NT);
        } } SEAM(pb + 9);
        if (PHON(12) && IN(pb + 10)) { for (int rep = 0; rep < NREP(12); ++rep) { if (rep) SEAMX();
            const Frame F = make_frame(); unsigned char* ws = F.ws;
            moe_tables(F, l);
            pg8::SchedMoE<4> S{(const LAS int*)(F.MISC + 16), (const LAS int*)(F.MISC + 96), (const char*)(ws + WS_ACT), (const char*)(ws + WS_WD + l * WD_L), 256, F.G, F.vcu, (int)WD_E, false};
            pg8::EpiPF8 E{(bf16_t*)(ws + WS_BIG), DM, (const float*)(ws + WS_SD) + (size_t)l * 65 * DM};
            pg8::gemm_phase<pg8::EpiPF8, pg8::SchedMoE<4>, false, 0, 2>(F.lds, 256, S, E);
        } } SEAM(pb + 10);
        if (PHON(13) && IN(pb + 11)) { for (int rep = 0; rep < NREP(13); ++rep) { if (rep) SEAMX(); const Frame F = make_frame(); moe_tables(F, l); combine_phase(F, kargs(), l); } } SEAM(pb + 11);
    }
    if (IN(NPHASES)) {
        const Frame F = make_frame(); const int gw = F.vcu * 8 + F.wave, NGW = F.G * 8; const bf16_t* X = (const bf16_t*)(F.ws + WS_X); float* out = kargs()->out;
        for (int row = gw; row < NT; row += NGW) { const int b = row / TPB, i = row % TPB; if (i < CTXL) continue;
            const u32x2* s = (const u32x2*)(X + (size_t)row * DM); f32x4* d = (f32x4*)(out + ((size_t)b * SEQ + i - CTXL) * DM);
#pragma unroll
            for (int j = 0; j < 4; ++j) { const u32x2 w = s[F.lane + 64 * j]; d[F.lane + 64 * j] = (f32x4){bflo(w.x), bfhi(w.x), bflo(w.y), bfhi(w.y)}; } }
    }
#undef IN
#undef SEAM
}

#ifndef N_LAUNCH_MODE
#define N_LAUNCH_MODE 0
#endif
extern "C" void kernel_launch(void* const* d_in, const int* in_sizes, int n_in, void* d_out, int out_size, void* d_ws, size_t ws_size, hipStream_t stream) {
    static int grid = 0;
    if (grid == 0) {
        if (n_in != 28 || ws_size < WS_END) { fprintf(stderr, "kernel_launch: need 28 inputs and %zu bytes of workspace (got %d, %zu)\n", (size_t)WS_END, n_in, ws_size); grid = -1; return; }
        int dev = 0, cus = 0, per_cu = 0;
        if (hipGetDevice(&dev) != hipSuccess || hipDeviceGetAttribute(&cus, hipDeviceAttributeMultiprocessorCount, dev) != hipSuccess) { grid = -1; return; }
        if (hipFuncSetAttribute((const void*)mega_fwd, hipFuncAttributeMaxDynamicSharedMemorySize, LDS_BYTES) != hipSuccess) { fprintf(stderr, "kernel_launch: hipFuncSetAttribute failed\n"); grid = -1; return; }
        if (hipOccupancyMaxActiveBlocksPerMultiprocessor(&per_cu, (const void*)mega_fwd, 512, LDS_BYTES) != hipSuccess || per_cu < 1) { fprintf(stderr, "kernel_launch: occupancy query says %d\n", per_cu); }
        (void)hipGetLastError();
        grid = cus;
    }
    if (grid < 0) return;
    (void)hipMemsetAsync((char*)d_ws + WS_CTL, 0, CTL_ZERO_BYTES, stream);
    Args a{};
    for (int i = 0; i < 28; ++i) a.in[i] = (const float*)d_in[i];
    a.out = (float*)d_out; a.ws = (unsigned char*)d_ws;
#if N_LAUNCH_MODE == 0
    a.ph_lo = 0; a.ph_hi = NPHASES;
    hipLaunchKernelGGL(mega_fwd, dim3(grid), dim3(512), LDS_BYTES, stream, a);
#else
    const int np = DBG_PHASES > 0 ? DBG_PHASES : NPHASES;
    for (int p = 0; p < np; ++p) { a.ph_lo = p; a.ph_hi = p + 1; hipLaunchKernelGGL(mega_fwd, dim3(grid), dim3(512), LDS_BYTES, stream, a); }
    if (DBG_PHASES > 0) { a.ph_lo = NPHASES; a.ph_hi = NPHASES + 1; hipLaunchKernelGGL(mega_fwd, dim3(grid), dim3(512), LDS_BYTES, stream, a); }
#endif
}
```

```cpp
#define N_LAUNCH_MODE 0
#include <hip/hip_runtime.h>
#include <cstdio>
#include <cstdint>
#define LAS __attribute__((address_space(3)))
#define GAS __attribute__((address_space(1)))
typedef unsigned short bf16_t;
typedef short bf16x8 __attribute__((ext_vector_type(8)));
typedef float f32x4 __attribute__((ext_vector_type(4)));
typedef float f32x2 __attribute__((ext_vector_type(2)));
typedef float f32x16 __attribute__((ext_vector_type(16)));
typedef unsigned u32x4 __attribute__((ext_vector_type(4)));
typedef unsigned u32x2 __attribute__((ext_vector_type(2)));
typedef __bf16 bf16x2_t __attribute__((ext_vector_type(2)));
#define DI __device__ __forceinline__
extern __shared__ __attribute__((aligned(16))) unsigned char lds_raw[];
constexpr int TIDTAB_OFF = 131072 + 1024;
DI int hw_wave_slot() { return (int)__builtin_amdgcn_s_getreg(((6 - 1) << 11) | 4) & 63; }
DI int tidx() { int w = *(const LAS int*)(lds_raw + TIDTAB_OFF + 4 * hw_wave_slot()); asm volatile("" : "+v"(w)); w = __builtin_amdgcn_readfirstlane(w);
    return (w << 6) | (int)__builtin_amdgcn_mbcnt_hi(~0u, __builtin_amdgcn_mbcnt_lo(~0u, 0u)); }

constexpr int NB = 4, SEQ = 8192, CTXL = 256, DM = 1024, TPB = SEQ + CTXL  , NT = NB * TPB  ;
constexpr int NP = 3584;
constexpr int NEXP = 64, TOPK = 6, DEXP = 384;
constexpr float EPS = 1e-6f;
constexpr int KT_PER_B = TPB / 64;
constexpr int C_GQ = 0, C_GK = 256, C_GV = 512, C_GZ = 768, C_SQ = 1024, C_SK = 1280, C_SV = 1408, C_DQ = 1536, C_DK = 1792, C_DV = 1920,
              C_MQN = 2048, C_MQP = 2304, C_MKN = 2432, C_MV = 2688, C_CQ = 2944, C_CKV = 3200, C_KR = 3328, C_GA = 3360, C_GB = 3368, C_END = 3376;
constexpr int R_GQ = 0, R_GK = 256, R_GV = 512, R_GZ = 768, R_GA = 1024, R_GB = 1032, R_CQ = 1040, R_CKV = 1296, R_KR = 1424, R_SQ = 1456, R_SK = 1712, R_SV = 1840,
              R_DQ = 1968, R_DK = 2224, R_DV = 2352, DIN = 2480;

DI unsigned f2bf(float f) { unsigned u = __builtin_bit_cast(unsigned, f); return (u + 0x7fffu + ((u >> 16) & 1u)) >> 16; }
DI unsigned pk2(float lo, float hi) { f32x2 v = {lo, hi}; bf16x2_t b = __builtin_convertvector(v, bf16x2_t); return __builtin_bit_cast(unsigned, b); }
DI float bf2f(unsigned short h) { return __builtin_bit_cast(float, (unsigned)h << 16); }
DI unsigned f8pack(float a, float b, float c, float d) {
    unsigned w = 0u;
    w = __builtin_amdgcn_cvt_pk_fp8_f32(__builtin_amdgcn_fmed3f(a, -448.f, 448.f), __builtin_amdgcn_fmed3f(b, -448.f, 448.f), w, false);
    return __builtin_amdgcn_cvt_pk_fp8_f32(__builtin_amdgcn_fmed3f(c, -448.f, 448.f), __builtin_amdgcn_fmed3f(d, -448.f, 448.f), w, true);
}
DI float bflo(unsigned w) { return __builtin_bit_cast(float, w << 16); }
DI float bfhi(unsigned w) { return __builtin_bit_cast(float, w & 0xffff0000u); }
DI float dpp_x1(float v) { return __builtin_bit_cast(float, __builtin_amdgcn_update_dpp(0, __builtin_bit_cast(int, v), 0xB1, 0xF, 0xF, true)); }
DI float dpp_x2(float v) { return __builtin_bit_cast(float, __builtin_amdgcn_update_dpp(0, __builtin_bit_cast(int, v), 0x4E, 0xF, 0xF, true)); }
DI float dpp_m8(float v) { return __builtin_bit_cast(float, __builtin_amdgcn_update_dpp(0, __builtin_bit_cast(int, v), 0x141, 0xF, 0xF, true)); }
DI float dpp_m16(float v) { return __builtin_bit_cast(float, __builtin_amdgcn_update_dpp(0, __builtin_bit_cast(int, v), 0x140, 0xF, 0xF, true)); }
DI int dpp_x1i(int v) { return __builtin_amdgcn_update_dpp(0, v, 0xB1, 0xF, 0xF, true); }
DI int dpp_x2i(int v) { return __builtin_amdgcn_update_dpp(0, v, 0x4E, 0xF, 0xF, true); }
DI int dpp_m8i(int v) { return __builtin_amdgcn_update_dpp(0, v, 0x141, 0xF, 0xF, true); }
DI int dpp_m16i(int v) { return __builtin_amdgcn_update_dpp(0, v, 0x140, 0xF, 0xF, true); }
DI float wave_sum(float v) {
    v += dpp_x1(v); v += dpp_x2(v); v += dpp_m8(v); v += dpp_m16(v); v += __shfl_xor(v, 16); v += __shfl_xor(v, 32);
    return v;
}
DI float sigmoidf(float x) { return __builtin_amdgcn_rcpf(1.f + __builtin_amdgcn_exp2f(-1.4426950408889634f * x)); }
DI float siluf(float x) { return x * sigmoidf(x); }
#define LDS_WAIT() asm volatile("s_waitcnt lgkmcnt(0)" ::: "memory")
#define VM_WAIT() asm volatile("s_waitcnt vmcnt(0)" ::: "memory")

#define XB_TMO      128
#define XB_XCNT(j)  (256  + 64 * (j))
#define XB_XSUB(j)  (1280 + 64 * (j))
#define XB_XGEN(j)  (2304 + 64 * (j))
#define XB_TOP      3328
#define XB_TOPGEN   3392
#define XCD_BAR_WORDS 3456
#define XB_SPIN_CAP (1u << 18)
DI unsigned xb_ld(unsigned* p)              { return __hip_atomic_load(p, __ATOMIC_RELAXED, __HIP_MEMORY_SCOPE_AGENT); }
DI unsigned xb_add(unsigned* p, unsigned v) { return __hip_atomic_fetch_add(p, v, __ATOMIC_RELAXED, __HIP_MEMORY_SCOPE_AGENT); }
DI unsigned xb_xcc_id() { return (unsigned)__builtin_amdgcn_s_getreg((3 << 11) | 20) & 0xFu; }
#define XB_SPIN(cond, bar) do { unsigned _sp = 0; while (cond) { __builtin_amdgcn_s_sleep(1); \
    if ((++_sp & 255u) == 0u) { if (xb_ld(&(bar)[XB_TMO])) break; if (_sp > XB_SPIN_CAP) { atomicAdd(&(bar)[XB_TMO], 1u); break; } } } } while (0)
struct XcdBarrier { unsigned* bar; unsigned x; volatile LAS unsigned* st; };
DI XcdBarrier xcd_barrier_post(unsigned* bar, volatile LAS unsigned* st) {
    XcdBarrier b; b.bar = bar; b.x = xb_xcc_id(); b.st = st;
    if (tidx() == 0) (void)xb_add(&bar[XB_XCNT(b.x)], 1u);
    return b;
}
DI void xcd_barrier_complete(unsigned* bar, unsigned x, unsigned& nloc, unsigned& nx) {
    const unsigned G = gridDim.x * gridDim.y * gridDim.z;
    unsigned sum, cnt, mine, sp = 0u;
    for (;;) {
        sum = 0u; cnt = 0u; mine = 0u;
#pragma unroll
        for (unsigned j = 0; j < 16; ++j) { const unsigned c = xb_ld(&bar[XB_XCNT(j)]); sum += c; cnt += (c > 0u) ? 1u : 0u; mine = (j == x) ? c : mine; }
        if (sum == G) break;
        __builtin_amdgcn_s_sleep(1);
        if ((++sp & 255u) == 0u) { if (xb_ld(&bar[XB_TMO])) break; if (sp > XB_SPIN_CAP) { atomicAdd(&bar[XB_TMO], 1u); break; } }
    }
    nloc = mine > 0u ? mine : 1u; nx = cnt > 0u ? cnt : 1u;
}
DI void xcd_barrier(const XcdBarrier& b) {
    asm volatile("s_waitcnt vmcnt(0)" ::: "memory");
    __syncthreads();
    if (tidx() == 0) {
        unsigned* bar = b.bar;
        __builtin_amdgcn_s_waitcnt(0);
        unsigned nloc = b.st[0], nx = b.st[1];
        if (nloc == 0u) { xcd_barrier_complete(bar, b.x, nloc, nx); b.st[0] = nloc; b.st[1] = nx; }
        const unsigned old = xb_add(&bar[XB_XSUB(b.x)], 1u);
        const unsigned gen = old / nloc;
        if (old + 1u == (gen + 1u) * nloc) {
            __builtin_amdgcn_fence(__ATOMIC_RELEASE, "agent");
            asm volatile("s_waitcnt vmcnt(0)" ::: "memory");
            const unsigned og = xb_add(&bar[XB_TOP], 1u);
            const unsigned tg = og / nx;
            if (og + 1u == (tg + 1u) * nx) xb_add(&bar[XB_TOPGEN], 1u);
            else XB_SPIN(xb_ld(&bar[XB_TOPGEN]) == tg, bar);
            __builtin_amdgcn_fence(__ATOMIC_ACQUIRE, "agent");
            xb_add(&bar[XB_XGEN(b.x)], 1u);
            asm volatile("s_waitcnt vmcnt(0)" ::: "memory");
        } else {
            XB_SPIN(xb_ld(&bar[XB_XGEN(b.x)]) == gen, bar);
            __builtin_amdgcn_fence(__ATOMIC_ACQUIRE, "agent");
            asm volatile("s_waitcnt vmcnt(0)" ::: "memory");
        }
    }
    __syncthreads();
}

namespace pg8 {
constexpr int BM = 256, BK = 64, HALF = 128, HTB = HALF * BK * 2, STAGE_BYTES = 8 * HTB, NXCD = 8, WGM = 8;
__host__ __device__ __forceinline__ int lds_byte(int r, int c) { const int st = (r >> 4) * 2 + (c >> 5), rr = r & 15, cc = c & 31, ob = rr * 64 + cc * 2; return st * 1024 + (ob ^ (((ob >> 9) & 1) << 5)); }
__host__ __device__ __forceinline__ void stage_rc(int b, int& R, int& C) { const int st = b / 1024, sb = b % 1024, swz = sb ^ (((sb >> 9) & 1) << 5); R = (st >> 1) * 16 + swz / 64; C = (st & 1) * 32 + (swz % 64) / 2; }
__host__ __device__ __forceinline__ int perm32(int rho) { const int n = rho >> 4, i = rho & 15; return 8 * (i >> 2) + 4 * n + (i & 3); }

struct Unit { int pm, pn; const char* A; const char* B; int slot0, cnt, ex; };

DI bool static_tile(int i, int G, int c, int nM, int nN, int& pm, int& pn) {
    const int nwg = nM * nN; const long L = (long)i * G + c; if (L >= nwg) return false;
    int wgid = (int)L; { const int q = nwg / NXCD, r = nwg % NXCD, xcd = wgid % NXCD, off = wgid / NXCD; wgid = (xcd < r ? xcd * (q + 1) : r * (q + 1) + (xcd - r) * q) + off; }
    const int nig = WGM * nN, gid = wgid / nig, fm = gid * WGM, gsz = (nM - fm) < WGM ? (nM - fm) : WGM;
    pm = fm + ((wgid % nig) % gsz); pn = (wgid % nig) / gsz; return true;
}

typedef int i32x4 __attribute__((ext_vector_type(4)));
typedef int i32x8 __attribute__((ext_vector_type(8)));
template <class Epi, class Sched, bool GATHER, int ZROW, int I8 = 0>
DI void gemm_phase(LAS unsigned char* lds, const int K, const Sched& S, const Epi& E, const int* lists = nullptr, int lstride = 0) {
    int tid_ = tidx(); asm volatile("" : "+v"(tid_));
    const int tid = tid_, wid = __builtin_amdgcn_readfirstlane(tid >> 6), lane = tid & 63, wr = wid >> 2, wc = wid & 3, fr = lane & 15, fq = lane >> 4;
    const int nt = K / BK;
    unsigned voffA[2], voffB[2]; int sR[2], sC[2];
#pragma unroll
    for (int i = 0; i < 2; ++i) { int R, C; stage_rc(tid * 16 + i * 8192, R, C); const int Rb = Epi::PERM ? ((R & ~31) + perm32(R & 31)) : R;
        voffA[i] = (unsigned)(R * K + C) * 2u; voffB[i] = (unsigned)(Rb * K + C) * 2u; sR[i] = R; sC[i] = C; }
    const size_t kstep = (size_t)(BK * 2);
    const size_t hstep = (size_t)HALF * K * 2;
    const unsigned ldsw = (unsigned)wid * 1024u;
    const int aoff = lds_byte(wr * 64 + fr, fq * 8), boff = lds_byte(wc * 32 + fr, fq * 8);
    unsigned vAc[2][2], vAn[2][2];
#define PG8_SA(b, h) (((b) * 2 + (h)) * HTB)
#define PG8_SB(b, h) ((4 + (b) * 2 + (h)) * HTB)
#define PG8_STAGE2(bufoff, gbase, o0, o1) do { \
        __builtin_amdgcn_global_load_lds((const unsigned*)((const char*)(gbase) + (o0)), (LAS unsigned*)(lds + (bufoff) + ldsw), 16, 0, 0); \
        __builtin_amdgcn_global_load_lds((const unsigned*)((const char*)(gbase) + (o1)), (LAS unsigned*)(lds + (bufoff) + ldsw + 8192), 16, 0, 0); } while (0)
#define PG8_STAGE(bufoff, gbase, voff) PG8_STAGE2(bufoff, gbase, (voff)[0], (voff)[1])
#define PG8_STAGE_A(bufoff, p, h, NX) do { if constexpr (GATHER) { const unsigned _o0 = (NX) ? vAn[h][0] : vAc[h][0], _o1 = (NX) ? vAn[h][1] : vAc[h][1]; PG8_STAGE2(bufoff, p, _o0, _o1); } \
        else { PG8_STAGE(bufoff, (p) + (h) * hstep, voffA); } } while (0)
#define PG8_LD8(p) __builtin_shufflevector(*(const LAS i32x4*)(p), *(const LAS i32x4*)((p) + 1024), 0, 1, 2, 3, 4, 5, 6, 7)
#define PG8_LDA(dst, b, h) do { if constexpr (I8 == 2) { _Pragma("unroll") for (int m = 0; m < 4; ++m) dst##_8[m] = PG8_LD8(lds + PG8_SA(b, h) + aoff + m * 2048); } \
        else { _Pragma("unroll") for (int m = 0; m < 4; ++m) _Pragma("unroll") for (int k = 0; k < 2; ++k) dst[m][k] = *(const LAS bf16x8*)(lds + PG8_SA(b, h) + aoff + m * 2048 + k * 1024); } } while (0)
#define PG8_LDB(dst, b, h) do { if constexpr (I8 == 2) { _Pragma("unroll") for (int n = 0; n < 2; ++n) dst##_8[n] = PG8_LD8(lds + PG8_SB(b, h) + boff + n * 2048); } \
        else { _Pragma("unroll") for (int n = 0; n < 2; ++n) _Pragma("unroll") for (int k = 0; k < 2; ++k) dst[n][k] = *(const LAS bf16x8*)(lds + PG8_SB(b, h) + boff + n * 2048 + k * 1024); } } while (0)
#define PG8_MMA(ai, bj, At, Bt) do { __builtin_amdgcn_s_setprio(1); _Pragma("unroll") for (int m = 0; m < 4; ++m) _Pragma("unroll") for (int n = 0; n < 2; ++n) { \
        if constexpr (I8 == 2) asm volatile("v_mfma_f32_16x16x128_f8f6f4 %0, %1, %2, %0" : "+v"(acc[ai][bj][m][n]) : "v"(Bt##_8[n]), "v"(At##_8[m]));     \
        else { _Pragma("unroll") for (int k = 0; k < 2; ++k) \
        { if constexpr (I8 == 1) acc[ai][bj][m][n] = __builtin_bit_cast(f32x4, __builtin_amdgcn_mfma_i32_16x16x64_i8(__builtin_bit_cast(i32x4, Bt[n][k]), __builtin_bit_cast(i32x4, At[m][k]), __builtin_bit_cast(i32x4, acc[ai][bj][m][n]), 0, 0, 0)); \
          else acc[ai][bj][m][n] = __builtin_amdgcn_mfma_f32_16x16x32_bf16(Bt[n][k], At[m][k], acc[ai][bj][m][n], 0, 0, 0); } } } __builtin_amdgcn_s_setprio(0); } while (0)
#define PG8_WAIT_V(n) asm volatile("s_waitcnt vmcnt(" #n ")" ::: "memory")
#define PG8_WAIT_L(n) asm volatile("s_waitcnt lgkmcnt(" #n ")" ::: "memory")
#define PG8_BAR __builtin_amdgcn_s_barrier()
#define PG8_SCHED __builtin_amdgcn_sched_barrier(0)
#define PG8_ROWS(u, v) do { if constexpr (GATHER) { _Pragma("unroll") for (int _h = 0; _h < 2; ++_h) _Pragma("unroll") for (int _i = 0; _i < 2; ++_i) { \
        const int _slot = (u).slot0 + sR[_i] + 128 * _h; const int _cl = (_slot < (u).cnt) ? _slot : (u).cnt - 1; int _idx = ((u).ex >= 0) ? lists[(size_t)(u).ex * lstride + _cl] : _cl; if (_slot >= (u).cnt) _idx = ZROW; \
        v[_h][_i] = (unsigned)_idx * (unsigned)(K * 2) + (unsigned)(sC[_i] * 2); } } } while (0)
    Unit cur, nxt; int ui = 0;
    if (!S.next(0, cur)) return;
    f32x4 acc[2][2][4][2];
#pragma unroll
    for (int a = 0; a < 2; ++a)
#pragma unroll
        for (int b = 0; b < 2; ++b)
#pragma unroll
            for (int m = 0; m < 4; ++m)
#pragma unroll
                for (int n = 0; n < 2; ++n) acc[a][b][m][n] = (f32x4){0.f, 0.f, 0.f, 0.f};
    bf16x8 At[4][2], B0[2][2], B1[2][2]; i32x8 At_8[4], B0_8[2], B1_8[2];
    const char* cA = cur.A; const char* cB = cur.B;
    PG8_ROWS(cur, vAc);
    PG8_STAGE(PG8_SB(0, 0), cB, voffB); PG8_STAGE(PG8_SB(0, 1), cB + hstep, voffB); PG8_STAGE_A(PG8_SA(0, 0), cA, 0, false); PG8_STAGE_A(PG8_SA(0, 1), cA, 1, false);
    if (wr == 1) PG8_BAR;
    PG8_WAIT_V(2); PG8_BAR;
    PG8_STAGE(PG8_SB(1, 0), cB + kstep, voffB); PG8_STAGE_A(PG8_SA(1, 0), cA + kstep, 0, false); PG8_STAGE(PG8_SB(1, 1), cB + hstep + kstep, voffB);
    PG8_WAIT_V(6); PG8_BAR;
    for (;;) {
        const bool has_next = S.next(ui + 1, nxt);
        const char* nA = has_next ? nxt.A : cA; const char* nB = has_next ? nxt.B : cB;
        if constexpr (GATHER) { if (has_next) { PG8_ROWS(nxt, vAn); } else {
#pragma unroll
            for (int h = 0; h < 2; ++h) { vAn[h][0] = vAc[h][0]; vAn[h][1] = vAc[h][1]; } } }
#pragma unroll 1
        for (int t = 0; t < nt; t += 2) {
            const bool last = (t == nt - 2);
            const char* a1 = cA + (size_t)(t + 1) * kstep;
            const char* a2 = last ? nA : cA + (size_t)(t + 2) * kstep; const char* b2 = last ? nB : cB + (size_t)(t + 2) * kstep;
            const char* a3 = a2 + kstep; const char* b3 = b2 + kstep;
            PG8_LDB(B0, 0, 0); PG8_LDB(B1, 0, 1); PG8_SCHED; PG8_LDA(At, 0, 0); PG8_STAGE_A(PG8_SA(1, 1), a1, 1, false);
            PG8_WAIT_V(8); PG8_WAIT_L(0); PG8_BAR; PG8_MMA(0, 0, At, B0); PG8_MMA(0, 1, At, B1); PG8_BAR; PG8_SCHED;
            PG8_LDA(At, 0, 1); PG8_STAGE(PG8_SB(0, 0), b2, voffB); PG8_STAGE(PG8_SB(0, 1), b2 + hstep, voffB); PG8_STAGE_A(PG8_SA(0, 0), a2, 0, last);
            PG8_WAIT_V(8); PG8_WAIT_L(0); PG8_BAR; PG8_MMA(1, 0, At, B0); PG8_MMA(1, 1, At, B1); PG8_BAR; PG8_SCHED;
            PG8_LDB(B0, 1, 0); PG8_LDB(B1, 1, 1); PG8_SCHED; PG8_LDA(At, 1, 0); PG8_STAGE_A(PG8_SA(0, 1), a2, 1, last);
            PG8_WAIT_V(8); PG8_WAIT_L(0); PG8_BAR; PG8_MMA(0, 0, At, B0); PG8_MMA(0, 1, At, B1); PG8_BAR; PG8_SCHED;
            PG8_LDA(At, 1, 1); PG8_STAGE(PG8_SB(1, 0), b3, voffB); PG8_STAGE(PG8_SB(1, 1), b3 + hstep, voffB); PG8_STAGE_A(PG8_SA(1, 0), a3, 0, last);
            PG8_WAIT_V(8); PG8_WAIT_L(0); PG8_BAR; PG8_MMA(1, 0, At, B0); PG8_MMA(1, 1, At, B1); PG8_BAR; PG8_SCHED;
        }
        if constexpr (I8 == 2) asm volatile("s_nop 15\n\ts_nop 15" ::: "memory");
        if (wr == 0) PG8_BAR;
        E(acc, cur, wr, wc, fr, fq);
        if (!has_next) break;
#pragma unroll
        for (int a = 0; a < 2; ++a)
#pragma unroll
            for (int b = 0; b < 2; ++b)
#pragma unroll
                for (int m = 0; m < 4; ++m)
#pragma unroll
                    for (int n = 0; n < 2; ++n) acc[a][b][m][n] = (f32x4){0.f, 0.f, 0.f, 0.f};
        cur = nxt; cA = nA; cB = nB; ++ui;
        if constexpr (GATHER) {
#pragma unroll
            for (int h = 0; h < 2; ++h) { vAc[h][0] = vAn[h][0]; vAc[h][1] = vAn[h][1]; } }
        if (wr == 1) PG8_BAR;
    }
    PG8_WAIT_V(0);
    PG8_BAR;
#undef PG8_SA
#undef PG8_SB
#undef PG8_STAGE
#undef PG8_STAGE2
#undef PG8_STAGE_A
#undef PG8_LDA
#undef PG8_LD8
#undef PG8_LDB
#undef PG8_MMA
#undef PG8_WAIT_V
#undef PG8_WAIT_L
#undef PG8_BAR
#undef PG8_SCHED
#undef PG8_ROWS
}
}
namespace pg8 {
DI int rfl(int v) { return __builtin_amdgcn_readfirstlane(v); }
struct SchedDense {
    const char* A; const char* Bt; int K, nM, nN, G, c; bool lat_only;
    DI bool next(int i, Unit& u) const {
        int pm, pn; if (!static_tile(i, G, c, nM, nN, pm, pn)) return false;
        if (lat_only) pm = (pm >> 5) * 33 + 1 + (pm & 31);
        u.pm = pm; u.pn = pn; u.A = A + (size_t)pm * 256 * K * 2; u.B = Bt + (size_t)pn * 256 * K * 2; u.slot0 = 0; u.cnt = 0; u.ex = 0; return true;
    }
};
template <int NCOL> struct SchedMoE {
    const LAS int* tstart; const LAS int* ecnt;
    const char* A; const char* Bt; int K, G, c, browbytes;
    bool gather;
    DI bool next(int i, Unit& u) const {
        const int TT = rfl(tstart[65]); unsigned L = (unsigned)(i * G + c);
#if defined(G1_REP) || defined(G2_REP)
        { const unsigned rep_ = (NCOL == 3) ? G1_REP : G2_REP; if (L >= (unsigned)(TT * NCOL) * rep_) return false; L %= (unsigned)(TT * NCOL); }
#else
        if (L >= (unsigned)(TT * NCOL)) return false;
#endif
        const int rt = (int)(L / (unsigned)NCOL), pn = (int)(L % (unsigned)NCOL);
        int e = 0;
#pragma unroll
        for (int stp = 64; stp >= 1; stp >>= 1) { const int c = e + stp; if (c <= 64 && rfl(tstart[c <= 64 ? c : 64]) <= rt) e = c; }
        const int t0 = rfl(tstart[e]);
        u.pm = rt; u.pn = pn; u.ex = (e == 64) ? -1 : e; u.slot0 = (rt - t0) * 256; u.cnt = (e == 64) ? NT : rfl(ecnt[e]);
        u.A = gather ? A : A + (size_t)rt * 256 * K * 2;
        u.B = Bt + (size_t)e * browbytes + (size_t)pn * 256 * K * 2;
        return true;
    }
};

struct EpiP {
    static constexpr bool PERM = true;
    bf16_t* O; int ldc;
    DI void operator()(const f32x4 (&acc)[2][2][4][2], const Unit& u, int wr, int wc, int fr, int fq) const {
        const int row0 = u.pm * BM + wr * 64 + fr, col0 = u.pn * BM + wc * 32 + 8 * fq;
#pragma unroll
        for (int ai = 0; ai < 2; ++ai)
#pragma unroll
            for (int m = 0; m < 4; ++m) { bf16_t* rowp = O + (size_t)(row0 + ai * HALF + m * 16) * ldc + col0;
#pragma unroll
                for (int bj = 0; bj < 2; ++bj) { const f32x4 v0 = acc[ai][bj][m][0], v1 = acc[ai][bj][m][1];
                    u32x4 w; w.x = pk2(v0[0], v0[1]); w.y = pk2(v0[2], v0[3]); w.z = pk2(v1[0], v1[1]); w.w = pk2(v1[2], v1[3]);
                    *(u32x4*)(rowp + bj * HALF) = w; } }
    }
};
struct EpiPF8 {
    static constexpr bool PERM = true;
    bf16_t* O; int ldc; const float* colmax;
    DI void operator()(const f32x4 (&acc)[2][2][4][2], const Unit& u, int wr, int wc, int fr, int fq) const {
        const int row0 = u.pm * BM + wr * 64 + fr, col0 = u.pn * BM + wc * 32 + 8 * fq;
        const float* cm = colmax + (size_t)((u.ex >= 0) ? u.ex : 64) * DM;
        f32x4 sb[2][2];
#pragma unroll
        for (int bj = 0; bj < 2; ++bj) { sb[bj][0] = *(const f32x4*)(cm + col0 + bj * HALF) * (1.f / 448.f); sb[bj][1] = *(const f32x4*)(cm + col0 + bj * HALF + 4) * (1.f / 448.f); }
#pragma unroll
        for (int ai = 0; ai < 2; ++ai)
#pragma unroll
            for (int m = 0; m < 4; ++m) { bf16_t* rowp = O + (size_t)(row0 + ai * HALF + m * 16) * ldc + col0;
#pragma unroll
                for (int bj = 0; bj < 2; ++bj) { const f32x4 v0 = acc[ai][bj][m][0] * sb[bj][0], v1 = acc[ai][bj][m][1] * sb[bj][1];
                    u32x4 w; w.x = pk2(v0[0], v0[1]); w.y = pk2(v0[2], v0[3]); w.z = pk2(v1[0], v1[1]); w.w = pk2(v1[2], v1[3]);
                    *(u32x4*)(rowp + bj * HALF) = w; } }
    }
};
struct EpiPI8 {
    static constexpr bool PERM = true;
    bf16_t* O; int ldc; const float* sa; const unsigned* colmax;
    DI void operator()(const f32x4 (&acc)[2][2][4][2], const Unit& u, int wr, int wc, int fr, int fq) const {
        const int row0 = u.pm * BM + wr * 64 + fr, col0 = u.pn * BM + wc * 32 + 8 * fq;
        f32x4 sb[2][2];
#pragma unroll
        for (int bj = 0; bj < 2; ++bj) { const u32x4 c0 = *(const u32x4*)(colmax + col0 + bj * HALF), c1 = *(const u32x4*)(colmax + col0 + bj * HALF + 4);
            sb[bj][0] = (f32x4){__uint_as_float(c0.x), __uint_as_float(c0.y), __uint_as_float(c0.z), __uint_as_float(c0.w)} * (1.f / 127.f);
            sb[bj][1] = (f32x4){__uint_as_float(c1.x), __uint_as_float(c1.y), __uint_as_float(c1.z), __uint_as_float(c1.w)} * (1.f / 127.f); }
#pragma unroll
        for (int ai = 0; ai < 2; ++ai)
#pragma unroll
            for (int m = 0; m < 4; ++m) { const int row = row0 + ai * HALF + m * 16; const float s = sa[row]; bf16_t* rowp = O + (size_t)row * ldc + col0;
#pragma unroll
                for (int bj = 0; bj < 2; ++bj) { const i32x4 i0 = __builtin_bit_cast(i32x4, acc[ai][bj][m][0]), i1 = __builtin_bit_cast(i32x4, acc[ai][bj][m][1]);
                    const f32x4 v0 = (f32x4){(float)i0.x, (float)i0.y, (float)i0.z, (float)i0.w} * sb[bj][0] * s, v1 = (f32x4){(float)i1.x, (float)i1.y, (float)i1.z, (float)i1.w} * sb[bj][1] * s;
                    u32x4 w; w.x = pk2(v0[0], v0[1]); w.y = pk2(v0[2], v0[3]); w.z = pk2(v1[0], v1[1]); w.w = pk2(v1[2], v1[3]);
                    *(u32x4*)(rowp + bj * HALF) = w; } }
    }
};
struct EpiResid {
    static constexpr bool PERM = true;
    const float* xin; const float* cin; bf16_t* X; const float* mod;
    int layer0;
    DI void operator()(const f32x4 (&acc)[2][2][4][2], const Unit& u, int wr, int wc, int fr, int fq) const {
        const int b = u.pm / 33, j = u.pm % 33; const bool isctx = (j == 0);
        const float* rbase = isctx ? cin + (size_t)(b * 256) * DM : xin + (size_t)(b * 8192 + (j - 1) * 256) * DM;
        bf16_t* obase = X + (size_t)u.pm * 256 * DM;
        const float* gate = mod + (size_t)(isctx ? 4 : b) * 6144 + 2 * DM;
        const int r0 = wr * 64 + fr, col0 = u.pn * BM + wc * 32 + 8 * fq;
        f32x4 gv[2][2];
#pragma unroll
        for (int bj = 0; bj < 2; ++bj)
#pragma unroll
            for (int n = 0; n < 2; ++n) gv[bj][n] = *(const f32x4*)(gate + col0 + bj * HALF + 4 * n);
#pragma unroll
        for (int ai = 0; ai < 2; ++ai)
#pragma unroll
            for (int m = 0; m < 4; ++m) { const size_t off = (size_t)(r0 + ai * HALF + m * 16) * DM + col0;
#pragma unroll
                for (int bj = 0; bj < 2; ++bj) { f32x4 r0v, r1v;
                    if (layer0) { r0v = *(const f32x4*)(rbase + off + bj * HALF); r1v = *(const f32x4*)(rbase + off + bj * HALF + 4); }
                    else { const u32x4 w = *(const u32x4*)(obase + off + bj * HALF); r0v = (f32x4){bflo(w.x), bfhi(w.x), bflo(w.y), bfhi(w.y)}; r1v = (f32x4){bflo(w.z), bfhi(w.z), bflo(w.w), bfhi(w.w)}; }
                    const f32x4 o0 = r0v + gv[bj][0] * acc[ai][bj][m][0], o1 = r1v + gv[bj][1] * acc[ai][bj][m][1];
                    u32x4 ow; ow.x = pk2(o0[0], o0[1]); ow.y = pk2(o0[2], o0[3]); ow.z = pk2(o1[0], o1[1]); ow.w = pk2(o1[2], o1[3]);
                    *(u32x4*)(obase + off + bj * HALF) = ow; }
                if (m & 1) asm volatile("" ::: "memory"); }
    }
};
struct EpiResidF8 {
    static constexpr bool PERM = true;
    const float* xin; const float* cin; bf16_t* X; const float* mod;
    int layer0; const float* colmax;
    DI void operator()(const f32x4 (&acc)[2][2][4][2], const Unit& u, int wr, int wc, int fr, int fq) const {
        const int b = u.pm / 33, j = u.pm % 33; const bool isctx = (j == 0);
        const float* rbase = isctx ? cin + (size_t)(b * 256) * DM : xin + (size_t)(b * 8192 + (j - 1) * 256) * DM;
        bf16_t* obase = X + (size_t)u.pm * 256 * DM;
        const float* gate = mod + (size_t)(isctx ? 4 : b) * 6144 + 2 * DM;
        const int r0 = wr * 64 + fr, col0 = u.pn * BM + wc * 32 + 8 * fq;
        f32x4 gv[2][2];
#pragma unroll
        for (int bj = 0; bj < 2; ++bj)
#pragma unroll
            for (int n = 0; n < 2; ++n) gv[bj][n] = *(const f32x4*)(gate + col0 + bj * HALF + 4 * n) * *(const f32x4*)(colmax + col0 + bj * HALF + 4 * n) * (1.f / 448.f);
#pragma unroll
        for (int ai = 0; ai < 2; ++ai)
#pragma unroll
            for (int m = 0; m < 4; ++m) { const size_t off = (size_t)(r0 + ai * HALF + m * 16) * DM + col0;
#pragma unroll
                for (int bj = 0; bj < 2; ++bj) { f32x4 r0v, r1v;
                    if (layer0) { r0v = *(const f32x4*)(rbase + off + bj * HALF); r1v = *(const f32x4*)(rbase + off + bj * HALF + 4); }
                    else { const u32x4 w = *(const u32x4*)(obase + off + bj * HALF); r0v = (f32x4){bflo(w.x), bfhi(w.x), bflo(w.y), bfhi(w.y)}; r1v = (f32x4){bflo(w.z), bfhi(w.z), bflo(w.w), bfhi(w.w)}; }
                    const f32x4 o0 = r0v + gv[bj][0] * acc[ai][bj][m][0], o1 = r1v + gv[bj][1] * acc[ai][bj][m][1];
                    u32x4 ow; ow.x = pk2(o0[0], o0[1]); ow.y = pk2(o0[2], o0[3]); ow.z = pk2(o1[0], o1[1]); ow.w = pk2(o1[2], o1[3]);
                    *(u32x4*)(obase + off + bj * HALF) = ow; }
                if (m & 1) asm volatile("" ::: "memory"); }
    }
};
struct EpiRouter {
    static constexpr bool PERM = false;
    float* L;
    DI void operator()(const f32x4 (&acc)[2][2][4][2], const Unit& u, int wr, int wc, int fr, int fq) const {
        if (wc >= 2 || u.pn != 0) return;
        const int row0 = u.pm * BM + wr * 64 + fr, col0 = wc * 32 + 4 * fq;
#pragma unroll
        for (int ai = 0; ai < 2; ++ai)
#pragma unroll
            for (int m = 0; m < 4; ++m)
#pragma unroll
                for (int n = 0; n < 2; ++n) *(f32x4*)(L + (size_t)(row0 + ai * HALF + m * 16) * 64 + col0 + n * 16) = acc[ai][0][m][n];
    }
};
struct EpiSwiglu {
    static constexpr bool PERM = true;
    bf16_t* act;
    DI void operator()(const f32x4 (&acc)[2][2][4][2], const Unit& u, int wr, int wc, int fr, int fq) const {
        const int row0 = u.pm * BM + wr * 64 + fr, col0 = (u.pn * BM + wc * 32 + 8 * fq) >> 1;
#pragma unroll
        for (int ai = 0; ai < 2; ++ai)
#pragma unroll
            for (int m = 0; m < 4; ++m) { bf16_t* rowp = act + (size_t)(row0 + ai * HALF + m * 16) * DEXP + col0;
#pragma unroll
                for (int bj = 0; bj < 2; ++bj) { const f32x4 g = acc[ai][bj][m][0], uu = acc[ai][bj][m][1];
                    u32x2 w; w.x = pk2(siluf(g[0]) * uu[0], siluf(g[1]) * uu[1]); w.y = pk2(siluf(g[2]) * uu[2], siluf(g[3]) * uu[3]);
                    *(u32x2*)(rowp + bj * (HALF / 2)) = w; } }
    }
};
struct EpiSwigluI8 {
    static constexpr bool PERM = true;
    bf16_t* act; const float* sal; const float* satok; const unsigned* colmax;
    DI void operator()(const f32x4 (&acc)[2][2][4][2], const Unit& u, int wr, int wc, int fr, int fq) const {
        const int rl0 = wr * 64 + fr, gcol0 = u.pn * BM + wc * 32 + 8 * fq;
        const int e = (u.ex >= 0) ? u.ex : 64;
        f32x4 sbg[2], sbu[2];
#pragma unroll
        for (int bj = 0; bj < 2; ++bj) { const u32x4 c0 = *(const u32x4*)(colmax + e * 768 + gcol0 + bj * HALF), c1 = *(const u32x4*)(colmax + e * 768 + gcol0 + bj * HALF + 4);
            sbg[bj] = (f32x4){__uint_as_float(c0.x), __uint_as_float(c0.y), __uint_as_float(c0.z), __uint_as_float(c0.w)} * (1.f / 127.f);
            sbu[bj] = (f32x4){__uint_as_float(c1.x), __uint_as_float(c1.y), __uint_as_float(c1.z), __uint_as_float(c1.w)} * (1.f / 127.f); }
#pragma unroll
        for (int ai = 0; ai < 2; ++ai)
#pragma unroll
            for (int m = 0; m < 4; ++m) { const int rl = rl0 + ai * HALF + m * 16, slot = u.slot0 + rl;
                float sa = 0.f; if (slot < u.cnt) sa = (u.ex >= 0) ? sal[(size_t)u.ex * NT + slot] : satok[slot];
                bf16_t* rowp = act + (size_t)(u.pm * BM + rl) * DEXP + (gcol0 >> 1);
#pragma unroll
                for (int bj = 0; bj < 2; ++bj) { const i32x4 ig = __builtin_bit_cast(i32x4, acc[ai][bj][m][0]), iu = __builtin_bit_cast(i32x4, acc[ai][bj][m][1]);
                    const f32x4 g = (f32x4){(float)ig.x, (float)ig.y, (float)ig.z, (float)ig.w} * sbg[bj] * sa, uu = (f32x4){(float)iu.x, (float)iu.y, (float)iu.z, (float)iu.w} * sbu[bj] * sa;
                    u32x2 w; w.x = pk2(siluf(g[0]) * uu[0], siluf(g[1]) * uu[1]); w.y = pk2(siluf(g[2]) * uu[2], siluf(g[3]) * uu[3]);
                    *(u32x2*)(rowp + bj * (HALF / 2)) = w; } }
    }
};
struct EpiSwigluI8F8 {
    static constexpr bool PERM = true;
    unsigned char* act; const float* sal; const float* satok; const unsigned* colmax;
    DI void operator()(const f32x4 (&acc)[2][2][4][2], const Unit& u, int wr, int wc, int fr, int fq) const {
        const int rl0 = wr * 64 + fr, gcol0 = u.pn * BM + wc * 32 + 8 * fq;
        const int e = (u.ex >= 0) ? u.ex : 64;
        f32x4 sbg[2], sbu[2];
#pragma unroll
        for (int bj = 0; bj < 2; ++bj) { const u32x4 c0 = *(const u32x4*)(colmax + e * 768 + gcol0 + bj * HALF), c1 = *(const u32x4*)(colmax + e * 768 + gcol0 + bj * HALF + 4);
            sbg[bj] = (f32x4){__uint_as_float(c0.x), __uint_as_float(c0.y), __uint_as_float(c0.z), __uint_as_float(c0.w)} * (1.f / 127.f);
            sbu[bj] = (f32x4){__uint_as_float(c1.x), __uint_as_float(c1.y), __uint_as_float(c1.z), __uint_as_float(c1.w)} * (1.f / 127.f); }
#pragma unroll
        for (int ai = 0; ai < 2; ++ai)
#pragma unroll
            for (int m = 0; m < 4; ++m) { const int rl = rl0 + ai * HALF + m * 16, slot = u.slot0 + rl;
                float sa = 0.f; if (slot < u.cnt) sa = (u.ex >= 0) ? sal[(size_t)u.ex * NT + slot] : satok[slot];
                unsigned char* rowp = act + (size_t)(u.pm * BM + rl) * 512 + (gcol0 >> 1);
#pragma unroll
                for (int bj = 0; bj < 2; ++bj) { const i32x4 ig = __builtin_bit_cast(i32x4, acc[ai][bj][m][0]), iu = __builtin_bit_cast(i32x4, acc[ai][bj][m][1]);
                    const f32x4 g = (f32x4){(float)ig.x, (float)ig.y, (float)ig.z, (float)ig.w} * sbg[bj] * sa, uu = (f32x4){(float)iu.x, (float)iu.y, (float)iu.z, (float)iu.w} * sbu[bj] * sa;
                    const float a0 = __builtin_amdgcn_fmed3f(siluf(g[0]) * uu[0], -448.f, 448.f), a1 = __builtin_amdgcn_fmed3f(siluf(g[1]) * uu[1], -448.f, 448.f);
                    const float a2 = __builtin_amdgcn_fmed3f(siluf(g[2]) * uu[2], -448.f, 448.f), a3 = __builtin_amdgcn_fmed3f(siluf(g[3]) * uu[3], -448.f, 448.f);
                    unsigned w = 0u; w = __builtin_amdgcn_cvt_pk_fp8_f32(a0, a1, w, false); w = __builtin_amdgcn_cvt_pk_fp8_f32(a2, a3, w, true);
                    *(unsigned*)(rowp + bj * (HALF / 2)) = w; } }
    }
};
}
constexpr size_t MiB = 1u << 20;
constexpr size_t WS_CTL = 0, CTL_ZERO_BYTES = 1 * MiB;
constexpr size_t WS_TAB = 1 * MiB;
constexpr size_t WS_WIN = 2 * MiB, WIN_L = (size_t)NP * DM * 2;
constexpr size_t WS_WOUT = 16 * MiB, WOUT_L = (size_t)DM * DM * 2;
constexpr size_t WS_WR = 20 * MiB, WR_L = (size_t)256 * DM * 2;
constexpr size_t WS_WGU = 22 * MiB, WGU_E = (size_t)768 * DM * 2, WGU_L = 65 * WGU_E;
constexpr size_t WGU8_E = (size_t)768 * DM, WGU8_L = 65 * WGU8_E;
constexpr size_t WS_H8 = WS_WGU + 98 * MiB;
constexpr size_t WS_SA = WS_WGU + 132 * MiB;
constexpr size_t WS_SAL = WS_WGU + 133 * MiB;
constexpr size_t WS_WD = 217 * MiB, WD_E = (size_t)DM * 512, WD_L = 65 * WD_E;
constexpr size_t WS_SD = WS_WGU + 142 * MiB;
constexpr size_t WS_H = 315 * MiB;
constexpr size_t WS_X = 382 * MiB;
constexpr size_t WS_MIX = 514 * MiB;
constexpr size_t WS_LOG = 580 * MiB;
constexpr size_t WS_LIST = 589 * MiB;
constexpr size_t WS_GLIST = 598 * MiB;
constexpr size_t WS_POS = 607 * MiB;
constexpr int MAXTILES = 988;
constexpr size_t WS_ACT = 609 * MiB;
constexpr size_t WS_BIG = 795 * MiB;
constexpr size_t B_P = WS_BIG, B_QS = WS_BIG + 231 * MiB, B_QD = WS_BIG + 248 * MiB, B_QM = WS_BIG + 265 * MiB,
                 B_KS = WS_BIG + 290 * MiB, B_VS = WS_BIG + 299 * MiB, B_KD = WS_BIG + 308 * MiB, B_VD = WS_BIG + 317 * MiB, B_KM = WS_BIG + 326 * MiB, B_VM = WS_BIG + 360 * MiB,
                 B_GQ = WS_BIG + 377 * MiB, B_GK = WS_BIG + 394 * MiB, B_GV = WS_BIG + 411 * MiB, B_LA = WS_BIG + 428 * MiB, B_BE = WS_BIG + 430 * MiB,
                 B_G2 = WS_BIG + 432 * MiB, B_DEC = WS_BIG + 598 * MiB, B_OF = WS_BIG + 599 * MiB;
constexpr size_t WS_END = WS_BIG + 666 * MiB;
constexpr size_t WIN8_L = (size_t)NP * DM;
constexpr size_t WS_FT = WS_BIG;
constexpr size_t IMG64 = 8192, IMGM = 16384;
constexpr int CW_BAR = 4096, CW_QUEUE = 8192, CW_ECNT = 8448, CW_QUEUE2 = 12288, CW_MOD = 16384, CW_CMAX = 81920, CW_CMAXW = 184320, CW_CMAXO = 192512;
constexpr int RING_BYTES = 131072, MISC_OFF = RING_BYTES, LDS_BYTES = 147456;

struct Args { const float* in[28]; float* out; unsigned char* ws; int ph_lo, ph_hi; };

typedef const __attribute__((address_space(4))) Args* KArgs;
struct Frame {
    LAS unsigned char* lds; volatile LAS unsigned* MISC;
    unsigned* ctl; unsigned char* ws;
    int tid, lane, wave, vcu, G, bx;
};

template <class F>
DI void transpose_item(const float* W, int ldw, int K, bf16_t* WT, LAS float* scr, int kb, int n0, int lane, F srccol) {
    const int k0 = 64 * kb; const int sc = srccol(n0 + (lane & 31));
    float tv[32];
#pragma unroll
    for (int i = 0; i < 32; ++i) { const int kk = 2 * i + (lane >> 5); tv[i] = (sc >= 0) ? W[(size_t)(k0 + kk) * ldw + sc] : 0.f; }
#pragma unroll
    for (int i = 0; i < 32; ++i) { const int kk = 2 * i + (lane >> 5); scr[kk * 33 + (lane & 31)] = tv[i]; }
    LDS_WAIT(); asm volatile("" ::: "memory");
    const int c = lane & 7;
#pragma unroll
    for (int j = 0; j < 4; ++j) { const int n = (lane >> 3) + 8 * j; const LAS float* s = scr + (8 * c) * 33 + n;
        u32x4 o; o.x = pk2(s[0 * 33], s[1 * 33]); o.y = pk2(s[2 * 33], s[3 * 33]); o.z = pk2(s[4 * 33], s[5 * 33]); o.w = pk2(s[6 * 33], s[7 * 33]);
        *(u32x4*)(WT + (size_t)(n0 + n) * K + k0 + 8 * c) = o; }
    LDS_WAIT(); asm volatile("" ::: "memory");
}
DI int win_srccol(int n) {
    if (n < 1024) return n;
    if (n < 1536) return n - 1024 + R_SQ;
    if (n < 2048) return n - 1536 + R_DQ;
    if (n < C_CQ) return -1;
    if (n < C_CKV) return n - C_CQ + R_CQ;
    if (n < C_KR) return n - C_CKV + R_CKV;
    if (n < C_GA) return n - C_KR + R_KR;
    if (n < C_GB) return n - C_GA + R_GA;
    if (n < C_END) return n - C_GB + R_GB;
    return -1;
}
DI int gu_srccol(int n) { return (n & 4) ? 384 + 4 * (n >> 3) + (n & 3) : 4 * (n >> 3) + (n & 3); }

constexpr int I_WR = 16 * 8, I_L = I_WR, I_CONV = I_L + 128 * 14;
DI void convert_items(unsigned char* ws, KArgs a, LAS float* scr, int l, int it0, int it1, int step, int lane) {
    for (int it = it0; it < it1; it += step) {
        int r = it;
        if (r < I_WR) { transpose_item(a->in[22] + (size_t)l * DM * 64, 64, DM, (bf16_t*)(ws + WS_WR + l * WR_L), scr, r / 8, (r % 8) * 32, lane, [](int n) { return n < 64 ? n : -1; }); continue; }
        r -= I_WR;
        {
          const int kb = r / 112, nb = r % 112, np0 = 2048 + 8 * nb; const bool isq = nb < 48;
          int sc0; const float* U; const float* gn; int J, ldu, coff;
          if (isq) { J = 256; ldu = 384; U = a->in[15] + (size_t)l * 256 * 384; gn = a->in[13] + l * 256; coff = R_CQ;
              if (np0 < C_MQP) { const int h = (np0 - C_MQN) >> 6, d = (np0 - C_MQN) & 63; sc0 = h * 96 + d; } else { const int h = (np0 - C_MQP) >> 5, d = (np0 - C_MQP) & 31; sc0 = h * 96 + 64 + d; } }
          else { J = 128; ldu = 512; U = a->in[16] + (size_t)l * 128 * 512; gn = a->in[14] + l * 128; coff = R_CKV;
              if (np0 < C_MV) { const int h = (np0 - C_MKN) >> 6, d = (np0 - C_MKN) & 63; sc0 = h * 128 + d; } else { const int h = (np0 - C_MV) >> 6, d = (np0 - C_MV) & 63; sc0 = h * 128 + 64 + d; } }
          const float* wrow = a->in[8] + (size_t)l * DM * DIN + (size_t)(64 * kb + lane) * DIN + coff;
          float acc[8];
#pragma unroll
          for (int q = 0; q < 8; ++q) acc[q] = 0.f;
#pragma unroll 2
          for (int j = 0; j < J; j += 4) { const f32x4 w4 = *(const f32x4*)(wrow + j) * *(const f32x4*)(gn + j);
#pragma unroll
              for (int e = 0; e < 4; ++e) { const float w = w4[e]; const f32x4 u0 = *(const f32x4*)(U + (size_t)(j + e) * ldu + sc0), u1 = *(const f32x4*)(U + (size_t)(j + e) * ldu + sc0 + 4);
                  acc[0] += w * u0.x; acc[1] += w * u0.y; acc[2] += w * u0.z; acc[3] += w * u0.w; acc[4] += w * u1.x; acc[5] += w * u1.y; acc[6] += w * u1.z; acc[7] += w * u1.w; } }
          float* op = (float*)(ws + WS_FT) + ((size_t)l * 896 + (np0 - 2048)) * DM + 64 * kb + lane;
#pragma unroll
          for (int q = 0; q < 8; ++q) op[(size_t)q * DM] = acc[q]; }
    }
}
DI float wave_max(float v) { v = fmaxf(v, dpp_x1(v)); v = fmaxf(v, dpp_x2(v)); v = fmaxf(v, dpp_m8(v)); v = fmaxf(v, dpp_m16(v)); v = fmaxf(v, __shfl_xor(v, 16)); return fmaxf(v, __shfl_xor(v, 32)); }
DI unsigned q8pack(float a, float b, float c, float d, float inv) {
    const int qa = (int)rintf(a * inv), qb = (int)rintf(b * inv), qc = (int)rintf(c * inv), qd = (int)rintf(d * inv);
    return (unsigned)(qa & 255) | ((unsigned)(qb & 255) << 8) | ((unsigned)(qc & 255) << 16) | ((unsigned)qd << 24);
}
DI void wgu_quant_items(const Frame& F, KArgs a) {
    int tid_ = F.tid; asm volatile("" : "+v"(tid_)); const int tid = tid_, lane = tid & 63, wave = tid >> 6, c = tid & 31, kr = tid >> 5;
    LAS float* tile = (LAS float*)F.lds; unsigned char* ws = F.ws;
    constexpr int NWGU = 2 * 65 * 24, NWIN = NWGU + 2 * 84, NIT = NWIN + 2 * 32;
    float v[64];
#define WQ_ISSUE(it_) do { const float* src_; size_t st_; bool ok_ = true; \
        if ((it_) < NWGU) { const int le_ = (it_) / 24, q_ = (it_) % 24, l_ = le_ / 65, e_ = le_ % 65; st_ = 16 * 768; \
            src_ = ((e_ < 64) ? a->in[24] + ((size_t)l_ * 64 + e_) * DM * 768 : a->in[26] + (size_t)l_ * DM * 768) + 16 * q_ + gu_srccol(c) + (size_t)kr * 768; } \
        else if ((it_) < NWIN) { const int j_ = (it_) - NWGU, l_ = j_ / 84, k_ = j_ % 84, q_ = k_ < 64 ? k_ : k_ + 28, sc_ = win_srccol(32 * q_ + c); ok_ = sc_ >= 0; st_ = 16 * DIN; \
            src_ = a->in[8] + (size_t)l_ * DM * DIN + (ok_ ? sc_ : 0) + (size_t)kr * DIN; } \
        else { const int j_ = (it_) - NWIN, l_ = j_ / 32, q_ = j_ % 32; st_ = 16 * DM; src_ = a->in[21] + (size_t)l_ * DM * DM + 32 * q_ + c + (size_t)kr * DM; } \
        _Pragma("unroll") for (int i = 0; i < 64; ++i) v[i] = ok_ ? __builtin_nontemporal_load(src_ + (size_t)i * st_) : 0.f; } while (0)
    int it = F.vcu;
    if (it < NIT) WQ_ISSUE(it);
    for (; it < NIT; it += F.G) {
#pragma unroll
        for (int i = 0; i < 64; ++i) tile[(16 * i + kr) * 32 + (c ^ (i & 31))] = v[i];
        LDS_WAIT(); __syncthreads();
        const int nx = it + F.G; if (nx < NIT) WQ_ISSUE(nx);
        unsigned char* obase; float* cbase;
        if (it < NWGU) { const int r0 = (it / 24) * 768 + 32 * (it % 24); obase = ws + WS_WGU + (size_t)r0 * 1024; cbase = (float*)(F.ctl + CW_CMAX) + r0; }
        else if (it < NWIN) { const int j = it - NWGU, l = j / 84, k = j % 84, r0 = l * NP + 32 * (k < 64 ? k : k + 28); obase = ws + WS_WIN + (size_t)r0 * 1024; cbase = (float*)(F.ctl + CW_CMAXW) + r0; }
        else { const int r0 = (it - NWIN) * 32; obase = ws + WS_WOUT + (size_t)r0 * 1024; cbase = (float*)(F.ctl + CW_CMAXO) + r0; }
        const bool f8 = it >= NWIN;
#pragma unroll
        for (int cc = 0; cc < 4; ++cc) { const int col = 4 * wave + cc; float x[16]; float mx = 0.f;
#pragma unroll
            for (int j = 0; j < 16; ++j) { x[j] = tile[(16 * lane + j) * 32 + (col ^ (lane & 31))]; mx = fmaxf(mx, fabsf(x[j])); }
            mx = wave_max(mx); const float inv = mx > 0.f ? (f8 ? 448.f : 127.f) / mx : 0.f;
            u32x4 o;
            if (f8) { o.x = f8pack(x[0] * inv, x[1] * inv, x[2] * inv, x[3] * inv); o.y = f8pack(x[4] * inv, x[5] * inv, x[6] * inv, x[7] * inv); o.z = f8pack(x[8] * inv, x[9] * inv, x[10] * inv, x[11] * inv); o.w = f8pack(x[12] * inv, x[13] * inv, x[14] * inv, x[15] * inv); }
            else { o.x = q8pack(x[0], x[1], x[2], x[3], inv); o.y = q8pack(x[4], x[5], x[6], x[7], inv); o.z = q8pack(x[8], x[9], x[10], x[11], inv); o.w = q8pack(x[12], x[13], x[14], x[15], inv); }
            ((u32x4*)(obase + (size_t)col * 1024))[lane] = o;
            if (lane == 0) cbase[col] = mx; }
        LDS_WAIT(); __syncthreads();
    }
#undef WQ_ISSUE
}
DI void wd_quant_items(const Frame& F, KArgs a) {
    int tid_ = F.tid; asm volatile("" : "+v"(tid_)); const int tid = tid_, lane = tid & 63, wave = tid >> 6, c = tid & 31, kr = tid >> 5;
    LAS float* tile = (LAS float*)F.lds; unsigned char* ws = F.ws;
    constexpr int NIT = 2 * 65 * 32;
    float v[24];
#define WD_ISSUE(it_) do { const int le_ = (it_) / 32, q_ = (it_) % 32, l_ = le_ / 65, e_ = le_ % 65; \
        const float* src_ = ((e_ < 64) ? a->in[25] + ((size_t)l_ * 64 + e_) * DEXP * DM : a->in[27] + (size_t)l_ * DEXP * DM) + 32 * q_ + c + (size_t)kr * DM; \
        _Pragma("unroll") for (int i = 0; i < 24; ++i) v[i] = __builtin_nontemporal_load(src_ + (size_t)i * 16 * DM); } while (0)
    int it = F.vcu;
    if (it < NIT) WD_ISSUE(it);
    for (; it < NIT; it += F.G) {
#pragma unroll
        for (int i = 0; i < 24; ++i) tile[(16 * i + kr) * 32 + (c ^ ((2 * i + (kr >> 3)) & 31))] = v[i];
        LDS_WAIT(); __syncthreads();
        const int nx = it + F.G; if (nx < NIT) WD_ISSUE(nx);
        const int le = it / 32, q = it % 32;
#pragma unroll
        for (int cc = 0; cc < 4; ++cc) { const int col = 4 * wave + cc; float x[8]; float mx = 0.f; const int kl = lane < 48 ? lane : 0;
#pragma unroll
            for (int j = 0; j < 8; ++j) { x[j] = tile[(8 * kl + j) * 32 + (col ^ (kl & 31))]; mx = fmaxf(mx, fabsf(x[j])); }
            mx = wave_max(mx); const float inv = mx > 0.f ? 448.f / mx : 0.f;
            u32x2 o = {0u, 0u};
            if (lane < 48) {
                o.x = __builtin_amdgcn_cvt_pk_fp8_f32(__builtin_amdgcn_fmed3f(x[0] * inv, -448.f, 448.f), __builtin_amdgcn_fmed3f(x[1] * inv, -448.f, 448.f), o.x, false);
                o.x = __builtin_amdgcn_cvt_pk_fp8_f32(__builtin_amdgcn_fmed3f(x[2] * inv, -448.f, 448.f), __builtin_amdgcn_fmed3f(x[3] * inv, -448.f, 448.f), o.x, true);
                o.y = __builtin_amdgcn_cvt_pk_fp8_f32(__builtin_amdgcn_fmed3f(x[4] * inv, -448.f, 448.f), __builtin_amdgcn_fmed3f(x[5] * inv, -448.f, 448.f), o.y, false);
                o.y = __builtin_amdgcn_cvt_pk_fp8_f32(__builtin_amdgcn_fmed3f(x[6] * inv, -448.f, 448.f), __builtin_amdgcn_fmed3f(x[7] * inv, -448.f, 448.f), o.y, true); }
            const int n = 32 * q + col;
            ((u32x2*)(ws + WS_WD + (size_t)le * WD_E + (size_t)n * 512))[lane] = o;
            if (lane == 0) ((float*)(ws + WS_SD))[le * DM + n] = mx; }
        LDS_WAIT(); __syncthreads();
    }
#undef WD_ISSUE
}
DI void fold_quant_row(unsigned char* ws, unsigned* ctl, int r, int lane) {
    const int l = r / 896, n = r % 896; const f32x4* src = (const f32x4*)(ws + WS_FT + (size_t)r * 4096) + lane;
    f32x4 x[4]; float mx = 0.f;
#pragma unroll
    for (int j = 0; j < 4; ++j) { x[j] = src[64 * j]; mx = fmaxf(fmaxf(mx, fmaxf(fabsf(x[j].x), fabsf(x[j].y))), fmaxf(fabsf(x[j].z), fabsf(x[j].w))); }
    mx = wave_max(mx); const float inv = mx > 0.f ? 127.f / mx : 0.f;
    unsigned* dst = (unsigned*)(ws + WS_WIN + ((size_t)l * NP + 2048 + n) * 1024) + lane;
#pragma unroll
    for (int j = 0; j < 4; ++j) dst[64 * j] = q8pack(x[j].x, x[j].y, x[j].z, x[j].w, inv);
    if (lane == 0) ((float*)(ctl + CW_CMAXW))[l * NP + 2048 + n] = mx;
}
#ifndef CONV_BG
#define CONV_BG 0
#endif
DI void p0_prologue(const Frame& F, KArgs a) {
    LAS float* scr = (LAS float*)(F.lds + F.wave * 16384);
    int lane_ = F.lane; asm volatile("" : "+v"(lane_)); const int gw = F.vcu * 8 + F.wave, NGW = F.G * 8, lane = lane_;
    unsigned char* ws = F.ws;
#ifndef P0_DUP
#define P0_DUP 0
#endif
    for (int rp = 0; rp < ((P0_DUP & 1) ? 2 : 1); ++rp) { wgu_quant_items(F, a); wd_quant_items(F, a); }
    for (int rp = 0; rp < ((P0_DUP & 4) ? 2 : 1); ++rp)
    if (F.vcu < 2 * 96) {
        LAS float* sct = (LAS float*)F.lds; LAS float* red = (LAS float*)(F.lds + 32768); float* modacc = (float*)(F.ctl + CW_MOD);
        for (int i = F.tid; i < 5 * DM; i += 512) { const int bb = i / DM, k = i % DM; const float cv = (bb < 4) ? a->in[1][bb * DM + k] : a->in[3][k]; sct[k * 8 + bb] = siluf(cv); }
        LDS_WAIT(); __syncthreads();
        for (int it = F.vcu; it < 2 * 96; it += F.G) {
            const int l = it / 96, n = (it % 96) * 64 + lane, k0 = F.wave * 128;
            const float* W = a->in[4] + (size_t)l * DM * 6144 + (size_t)k0 * 6144 + n;
            float acc[5] = {0.f, 0.f, 0.f, 0.f, 0.f};
#pragma unroll 1
            for (int kb = 0; kb < 128; kb += 16) { float w[16];
#pragma unroll
                for (int j = 0; j < 16; ++j) w[j] = __builtin_nontemporal_load(W + (size_t)(kb + j) * 6144);
#pragma unroll
                for (int j = 0; j < 16; ++j) { const f32x4 s4 = *(const LAS f32x4*)(sct + (k0 + kb + j) * 8); const float s5 = sct[(k0 + kb + j) * 8 + 4];
                    acc[0] += s4.x * w[j]; acc[1] += s4.y * w[j]; acc[2] += s4.z * w[j]; acc[3] += s4.w * w[j]; acc[4] += s5 * w[j]; } }
#pragma unroll
            for (int bb = 0; bb < 5; ++bb) red[(F.wave * 5 + bb) * 64 + lane] = acc[bb];
            LDS_WAIT(); __syncthreads();
            if (F.tid < 320) { const int bb = F.tid >> 6, c = F.tid & 63; float sum = red[bb * 64 + c];
#pragma unroll
                for (int w8 = 1; w8 < 8; ++w8) sum += red[(w8 * 5 + bb) * 64 + c];
                const int nn = (it % 96) * 64 + c; modacc[((size_t)l * 5 + bb) * 6144 + nn] = sum + a->in[5][l * 6144 + nn]; }
            LDS_WAIT(); __syncthreads();
        }
    }
    __syncthreads();
    for (int rp = 0; rp < ((P0_DUP & 2) ? 2 : 1); ++rp) {
    convert_items(ws, a, scr, 0, gw, I_CONV, NGW, lane);
    if (!CONV_BG) convert_items(ws, a, scr, 1, gw, I_CONV, NGW, lane); }
    { float* tab = (float*)(ws + WS_TAB);
      for (int i = gw * 64 + lane; i < 3072; i += NGW * 64) {
          if (i < 2048) { const int pos = i >> 4, fi = i & 15; const float inv = powf(10000.f, -(float)(2 * fi) / 32.f), ang = (float)pos * inv; tab[i] = cosf(ang); tab[2048 + i] = sinf(ang); }
          else { const int q = i - 2048, pos = q >> 3, fi = q & 7; const float inv = powf(10000.f, -(float)(2 * fi) / 16.f), ang = (float)pos * inv; tab[4096 + q] = cosf(ang); tab[5120 + q] = sinf(ang); } } }
    if (gw == 0) { ((u32x4*)((bf16_t*)(ws + WS_H) + (size_t)NT * DM))[lane] = (u32x4){0u, 0u, 0u, 0u}; ((u32x4*)((bf16_t*)(ws + WS_H) + (size_t)NT * DM))[64 + lane] = (u32x4){0u, 0u, 0u, 0u};
                   ((u32x4*)(ws + WS_H8 + (size_t)NT * DM))[lane] = (u32x4){0u, 0u, 0u, 0u}; }
}

DI void norm_row(const float* xrow, const float* g, const float* shift, const float* scale, unsigned* qrow, float* sa, int lane) {
    const f32x4* xr = (const f32x4*)xrow + lane;
    f32x4 v[4]; float s = 0.f;
#pragma unroll
    for (int j = 0; j < 4; ++j) { v[j] = xr[64 * j]; s += (v[j].x * v[j].x + v[j].y * v[j].y) + (v[j].z * v[j].z + v[j].w * v[j].w); }
    const float r = rsqrtf(wave_sum(s) * (1.f / DM) + EPS);
    float mx = 0.f;
#pragma unroll
    for (int j = 0; j < 4; ++j) { const f32x4 gg = ((const f32x4*)g)[lane + 64 * j], sc = ((const f32x4*)scale)[lane + 64 * j], sh = ((const f32x4*)shift)[lane + 64 * j];
        const f32x4 o = v[j] * r * gg * (sc + 1.f) + sh; v[j] = o;
        mx = fmaxf(fmaxf(mx, fmaxf(fabsf(o.x), fabsf(o.y))), fmaxf(fabsf(o.z), fabsf(o.w))); }
    mx = wave_max(mx);
    const float inv = mx > 0.f ? 127.f / mx : 0.f;
#pragma unroll
    for (int j = 0; j < 4; ++j) qrow[lane + 64 * j] = q8pack(v[j].x, v[j].y, v[j].z, v[j].w, inv);
    if (lane == 0) *sa = mx * (1.f / 127.f);
}
DI void norm_row_b(const bf16_t* xrow, const float* g, const float* shift, const float* scale, bf16_t* orow, int lane) {
    const u32x2* xr = (const u32x2*)xrow + lane;
    f32x4 v[4]; float s = 0.f;
#pragma unroll
    for (int j = 0; j < 4; ++j) { const u32x2 w = __builtin_nontemporal_load(xr + 64 * j); v[j] = (f32x4){bflo(w.x), bfhi(w.x), bflo(w.y), bfhi(w.y)}; s += (v[j].x * v[j].x + v[j].y * v[j].y) + (v[j].z * v[j].z + v[j].w * v[j].w); }
    const float r = rsqrtf(wave_sum(s) * (1.f / DM) + EPS);
#pragma unroll
    for (int j = 0; j < 4; ++j) { const f32x4 gg = ((const f32x4*)g)[lane + 64 * j], sc = ((const f32x4*)scale)[lane + 64 * j], sh = ((const f32x4*)shift)[lane + 64 * j];
        const f32x4 o = v[j] * r * gg * (sc + 1.f) + sh;
        u32x2 w; w.x = pk2(o.x, o.y); w.y = pk2(o.z, o.w); ((u32x2*)orow)[lane + 64 * j] = w; }
}
DI void norm_row_q(const bf16_t* xrow, const float* g, const float* shift, const float* scale, bf16_t* orow, unsigned* qrow, float* sa, int lane) {
    const u32x2* xr = (const u32x2*)xrow + lane;
    f32x4 v[4]; float s = 0.f;
#pragma unroll
    for (int j = 0; j < 4; ++j) { const u32x2 w = __builtin_nontemporal_load(xr + 64 * j); v[j] = (f32x4){bflo(w.x), bfhi(w.x), bflo(w.y), bfhi(w.y)}; s += (v[j].x * v[j].x + v[j].y * v[j].y) + (v[j].z * v[j].z + v[j].w * v[j].w); }
    const float r = rsqrtf(wave_sum(s) * (1.f / DM) + EPS);
    float mx = 0.f;
#pragma unroll
    for (int j = 0; j < 4; ++j) { const f32x4 gg = ((const f32x4*)g)[lane + 64 * j], sc = ((const f32x4*)scale)[lane + 64 * j], sh = ((const f32x4*)shift)[lane + 64 * j];
        const f32x4 o = v[j] * r * gg * (sc + 1.f) + sh; v[j] = o;
        mx = fmaxf(fmaxf(mx, fmaxf(fabsf(o.x), fabsf(o.y))), fmaxf(fabsf(o.z), fabsf(o.w)));
        u32x2 w; w.x = pk2(o.x, o.y); w.y = pk2(o.z, o.w); ((u32x2*)orow)[lane + 64 * j] = w; }
    mx = wave_max(mx);
    const float inv = mx > 0.f ? 127.f / mx : 0.f;
#pragma unroll
    for (int j = 0; j < 4; ++j) qrow[lane + 64 * j] = q8pack(v[j].x, v[j].y, v[j].z, v[j].w, inv);
    if (lane == 0) *sa = mx * (1.f / 127.f);
}
DI const float* resid_row_l0(KArgs a, int row) { const int b = row / TPB, i = row % TPB; return (i < CTXL) ? a->in[2] + (size_t)(b * CTXL + i) * DM : a->in[0] + (size_t)(b * SEQ + i - CTXL) * DM; }

DI void load8(const bf16_t* p, float (&x)[8]) { const u32x4 w = *(const u32x4*)p; x[0] = bflo(w.x); x[1] = bfhi(w.x); x[2] = bflo(w.y); x[3] = bfhi(w.y); x[4] = bflo(w.z); x[5] = bfhi(w.z); x[6] = bflo(w.w); x[7] = bfhi(w.w); }
DI void unpack8(const u32x4 w, float (&x)[8]) { x[0] = bflo(w.x); x[1] = bfhi(w.x); x[2] = bflo(w.y); x[3] = bfhi(w.y); x[4] = bflo(w.z); x[5] = bfhi(w.z); x[6] = bflo(w.w); x[7] = bfhi(w.w); }
DI void store8(bf16_t* p, const float (&y)[8]) { u32x4 w; w.x = pk2(y[0], y[1]); w.y = pk2(y[2], y[3]); w.z = pk2(y[4], y[5]); w.w = pk2(y[6], y[7]); *(u32x4*)p = w; }
DI void loadf8(const float* p, float (&x)[8]) { const f32x4 a = ((const f32x4*)p)[0], b = ((const f32x4*)p)[1]; x[0] = a.x; x[1] = a.y; x[2] = a.z; x[3] = a.w; x[4] = b.x; x[5] = b.y; x[6] = b.z; x[7] = b.w; }
DI void loadl8(const LAS float* p, float (&x)[8]) { const f32x4 a = ((const LAS f32x4*)p)[0], b = ((const LAS f32x4*)p)[1]; x[0] = a.x; x[1] = a.y; x[2] = a.z; x[3] = a.w; x[4] = b.x; x[5] = b.y; x[6] = b.z; x[7] = b.w; }
template <int XM> DI void rope8(float (&y)[8], const LAS float* cs, const LAS float* sn, bool first, bool apply) {
    float c8[8], s8[8];
    if (apply) { loadl8(cs, c8); loadl8(sn, s8); } else {
#pragma unroll
        for (int j = 0; j < 8; ++j) { c8[j] = 1.f; s8[j] = 0.f; } }
#pragma unroll
    for (int j = 0; j < 8; ++j) { const float p = (XM == 1) ? dpp_x1(y[j]) : dpp_x2(y[j]); y[j] = first ? y[j] * c8[j] - p * s8[j] : y[j] * c8[j] + p * s8[j]; }
}
constexpr float LOG2E = 1.4426950408889634f;
constexpr float QSCALE64 = 0.125f * LOG2E;
constexpr float QSCALEM = 0.10206207261596575f * LOG2E;

DI void vstage8(LAS bf16_t* stage, int slot, int d0, int tau, const float (&y)[8]) {
    const int hi = (tau >> 2) & 1, jj = (tau & 3) + 4 * (tau >> 3);
#pragma unroll
    for (int j = 0; j < 8; ++j) stage[slot * 1024 + (d0 + j) * 16 + hi * 8 + jj] = (bf16_t)f2bf(y[j]);
}

template <int XM> DI void rope8l(float (&y)[8], const LAS float* cs, const LAS float* sn, bool first) {
    float c8[8], s8[8]; loadl8(cs, c8); loadl8(sn, s8);
#pragma unroll
    for (int j = 0; j < 8; ++j) { const float p = (XM == 1) ? dpp_x1(y[j]) : dpp_x2(y[j]); y[j] = first ? y[j] * c8[j] - p * s8[j] : y[j] * c8[j] + p * s8[j]; }
}
DI void prep_phase(const Frame& F, KArgs a, int l, int rep) {
    unsigned char* ws = F.ws; int lane_ = F.lane; const int wave = F.wave;
    const bf16_t* P = (const bf16_t*)(ws + B_P);
    const float* tab = (const float*)(ws + WS_TAB);
    LAS float* tl = (LAS float*)F.lds;
    const LAS float* cos64 = tl, *sin64 = tl + 2048, *cos32 = tl + 4096, *sin32 = tl + 5120;
    const LAS float* convw = tl + 6144;
    const LAS float* swa_q = tl + 9984, *swa_k = tl + 10048, *gqa_q = tl + 10112, *gqa_k = tl + 10176, *mla_q = tl + 10240  , *mla_k = tl + 10336  , *ones8 = tl + 10432, *zeros8 = tl + 10440;
    { const float* cwg = a->in[9] + (size_t)l * 5 * 768; const float* sg = a->in[18] + l * 128; const float* gg = a->in[20] + l * 128; const float* mg = a->in[17] + l * 192;
      for (int i = F.tid; i < 10448; i += 512) { float v;
          if (i < 6144) v = tab[i]; else if (i < 9984) v = cwg[i - 6144];
          else if (i < 10048) v = sg[i - 9984] * QSCALE64; else if (i < 10112) v = sg[i - 9984];
          else if (i < 10176) v = gg[i - 10112] * QSCALE64; else if (i < 10240) v = gg[i - 10112];
          else if (i < 10336) v = mg[i - 10240] * QSCALEM; else if (i < 10432) v = mg[i - 10240];
          else v = (i < 10440) ? 1.f : 0.f;
          tl[i] = v; }
      LDS_WAIT(); __syncthreads(); }
    const int gwv = F.vcu * 8 + wave, NGWV = F.G * 8;
    for (int g = gwv; g < NT / 2; g += NGWV) {
        const int row0 = g * 2, b = row0 / TPB, i0 = row0 % TPB; const bool isctx = i0 < CTXL; const bool lat = !isctx;
        asm volatile("" : "+v"(lane_)); const int lane = lane_, L = lane;
        float vt[3][8];
        unsigned vp[3][8];
        u32x4 RAW[2][5], CQ[6], CV[6];
        { const u32x4 z4 = (u32x4){0u, 0u, 0u, 0u}; const int seglo = isctx ? 0 : CTXL, seghi = isctx ? CTXL : TPB;
          const bf16_t* pA = P + (size_t)row0 * NP;
#define PREP_RAW(tk) do { const bf16_t* pr = pA + (size_t)(tk) * NP; \
              RAW[tk][0] = (L < 54) ? __builtin_nontemporal_load((const u32x4*)(pr + C_CQ + 8 * L)) : z4; RAW[tk][1] = __builtin_nontemporal_load((const u32x4*)(pr + C_SQ + 8 * L)); RAW[tk][2] = __builtin_nontemporal_load((const u32x4*)(pr + C_DQ + 8 * L)); \
              RAW[tk][3] = __builtin_nontemporal_load((const u32x4*)(pr + C_MQN + 8 * L)); RAW[tk][4] = (L < 48) ? __builtin_nontemporal_load((const u32x4*)(pr + 2560 + 8 * L)) : z4; } while (0)
          PREP_RAW(0);
#pragma unroll
          for (int jj = 0; jj < 6; ++jj) { const int ii = i0 + jj - 2; const bool ok = (ii >= seglo && ii < seghi);
              CQ[jj] = ok ? *(const u32x4*)(pA + (ptrdiff_t)(jj - 2) * NP + 8 * L) : z4; CV[jj] = (ok && L < 32) ? *(const u32x4*)(pA + (ptrdiff_t)(jj - 2) * NP + 512 + 8 * L) : z4; } }
        __builtin_amdgcn_sched_barrier(0);
#pragma unroll
        for (int tk = 0; tk < 2; ++tk) {
            const int row = row0 + tk, i = i0 + tk, kt = i >> 6, kv = i & 63;
            const int t = i - CTXL, rpos = lat ? (t >> 6) : 0, cpos = lat ? (t & 63) : 0;
            float x[8], y[8];
#pragma unroll
            for (int s = 0; s < 2; ++s) {
                const int c = (s == 0) ? 8 * L : 512 + 8 * (L & 31);
                float accv[8];
#pragma unroll
                for (int j = 0; j < 8; ++j) accv[j] = 0.f;
#pragma unroll
                for (int jj = 0; jj < 5; ++jj) { unpack8(s ? CV[tk + jj] : CQ[tk + jj], x); float w8[8]; loadl8(convw + jj * 768 + c, w8);
#pragma unroll
                    for (int j = 0; j < 8; ++j) accv[j] += x[j] * w8[j]; }
                float ss = 0.f;
#pragma unroll
                for (int j = 0; j < 8; ++j) { accv[j] = siluf(accv[j]); ss += accv[j] * accv[j]; }
                ss += dpp_x1(ss); ss += dpp_x2(ss); ss += dpp_m8(ss);
                if (s == 0) { const float nr = __builtin_amdgcn_rsqf(ss + EPS) * ((L < 32) ? 0.125f : 1.f);
#pragma unroll
                    for (int j = 0; j < 8; ++j) y[j] = accv[j] * nr;
                    store8((bf16_t*)(ws + (L < 32 ? B_GQ : B_GK)) + (size_t)row * 256 + 8 * (L & 31), y); }
                else if (L < 32) store8((bf16_t*)(ws + B_GV) + (size_t)row * 256 + 8 * L, accv);
            }
            if (tk == 0) { const u32x4 z4 = (u32x4){0u, 0u, 0u, 0u}; const bf16_t* pA = P + (size_t)row0 * NP; PREP_RAW(1); }
            float r_q, r_kv;
            {
                float ss = 0.f;
                unpack8(RAW[tk][0], x);
#pragma unroll
                for (int j = 0; j < 8; ++j) ss += x[j] * x[j];
                const float p1 = ss + dpp_x1(ss), p2 = p1 + dpp_x2(p1), p3 = p2 + dpp_m8(p2), p4 = p3 + dpp_m16(p3), p5 = p4 + __shfl_xor(p4, 16);
                r_q = __builtin_amdgcn_rsqf(__shfl(p5, 0) * (1.f / 256.f) + EPS); r_kv = __builtin_amdgcn_rsqf(__shfl(p4, 32) * (1.f / 128.f) + EPS);
                const int q = (L - 48) & 3; const float nr = __builtin_amdgcn_rsqf(p2 * (1.f / 32.f) + EPS);
                float g8[8]; loadl8(mla_k + 64 + 8 * q, g8);
#pragma unroll
                for (int j = 0; j < 8; ++j) y[j] = x[j] * nr * g8[j];
                { const int pos = (q & 2) ? cpos : rpos; rope8l<1>(y, lat ? cos32 + pos * 8 : ones8, lat ? sin32 + pos * 8 : zeros8, (q & 1) == 0); }
                if (L >= 48 && L < 52) {
#pragma unroll
                    for (int h = 0; h < 4; ++h) { bf16_t* img = (bf16_t*)(ws + B_KM + ((size_t)((b * 4 + h) * KT_PER_B + kt)) * IMGM); store8(img + 4096 + kv * 32 + ((q ^ ((kv >> 2) & 3)) << 3), y); } }
                { const int gsel = L & 15; const float gv = bf2f(P[(size_t)row * NP + C_GA + gsel]);
                  const float z = gv + a->in[11][l * 8 + (gsel & 7)]; const float sp = (z > 20.f) ? z : __logf(1.f + __expf(z));
                  const float la = -__expf(a->in[10][l * 8 + (gsel & 7)]) * sp, be = sigmoidf(gv);
                  if (L < 16) ((float*)(ws + (gsel < 8 ? B_LA : B_BE)))[((size_t)((gsel >> 2) & 1) * NT + row) * 4 + (gsel & 3)] = (gsel < 8) ? la : be; }
            }
#pragma unroll
            for (int s = 0; s < 2; ++s) {
                unpack8(RAW[tk][1 + s], x);
                float ss = 0.f;
#pragma unroll
                for (int j = 0; j < 8; ++j) ss += x[j] * x[j];
                ss += dpp_x1(ss); ss += dpp_x2(ss); ss += dpp_m8(ss);
                const bool isq = L < 32, isv = L >= 48;
                const float nr = isv ? 1.f : __builtin_amdgcn_rsqf(ss * (1.f / 64.f) + EPS);
                const LAS float* gp = isv ? ones8 : (isq ? (s ? gqa_q : swa_q) : (s ? gqa_k : swa_k)) + 8 * (L & 7);
                float g8[8]; loadl8(gp, g8);
#pragma unroll
                for (int j = 0; j < 8; ++j) y[j] = x[j] * nr * g8[j];
                { const int pos = (L & 4) ? cpos : rpos; const bool rp = lat && !isv;
                  rope8l<2>(y, rp ? cos64 + pos * 16 + 8 * (L & 1) : ones8, rp ? sin64 + pos * 16 + 8 * (L & 1) : zeros8, (L & 2) == 0); }
                const int hk = (L - 32) >> 3;
                bf16_t* qd = (bf16_t*)(ws + (s ? B_QD : B_QS)) + (size_t)row * 256 + 8 * L;
                bf16_t* kd = (bf16_t*)(ws + (s ? B_KD : B_KS) + ((size_t)((b * 2 + (hk & 1)) * KT_PER_B + kt)) * IMG64) + kv * 64 + (((L & 7) ^ ((kv >> 1) & 7)) << 3);
                if (!isv) store8(isq ? qd : kd, y);
#pragma unroll
                for (int j = 0; j < 8; ++j) { if (tk == 0) vt[s][j] = y[j]; else vp[s][j] = pk2(vt[s][j], y[j]); }
            }
            {
                unpack8(RAW[tk][3], x);
                const float pre = (L < 48) ? r_q : r_kv; float ss = 0.f;
#pragma unroll
                for (int j = 0; j < 8; ++j) { x[j] *= pre; ss += x[j] * x[j]; }
                const float p1 = ss + dpp_x1(ss), p2 = p1 + dpp_x2(p1), p3 = p2 + dpp_m8(p2);
                const bool ispe = (L >= 32 && L < 48);
                const float nr = ispe ? __builtin_amdgcn_rsqf(p2 * (1.f / 32.f) + EPS) : __builtin_amdgcn_rsqf(p3 * (1.f / 64.f) + EPS);
                const LAS float* gp = (L < 32) ? mla_q + 8 * (L & 7) : ispe ? mla_q + 64 + 8 * (L & 3) : mla_k + 8 * (L & 7);
                float g8[8]; loadl8(gp, g8);
#pragma unroll
                for (int j = 0; j < 8; ++j) y[j] = x[j] * nr * g8[j];
                { const int pos = (L & 2) ? cpos : rpos; const bool rp = lat && ispe; rope8l<1>(y, rp ? cos32 + pos * 8 : ones8, rp ? sin32 + pos * 8 : zeros8, (L & 1) == 0); }
                const int qoff = (L < 32) ? (L >> 3) * 96 + 8 * (L & 7) : ((L - 32) >> 2) * 96 + 64 + 8 * (L & 3);
                bf16_t* qd = (bf16_t*)(ws + B_QM) + (size_t)row * 384 + qoff;
                bf16_t* kd = (bf16_t*)(ws + B_KM + ((size_t)((b * 4 + (((L - 48) >> 3) & 1)) * KT_PER_B + kt)) * IMGM) + kv * 64 + (((L & 7) ^ ((kv >> 1) & 7)) << 3);
                store8((L < 48) ? qd : kd, y);
            }
            {
                unpack8(RAW[tk][4], x);
                float ss = 0.f;
#pragma unroll
                for (int j = 0; j < 8; ++j) { x[j] *= r_kv; ss += x[j] * x[j]; }
                ss += dpp_x1(ss); ss += dpp_x2(ss); ss += dpp_m8(ss);
                const bool isk = L < 16;
                const float nr = isk ? __builtin_amdgcn_rsqf(ss * (1.f / 64.f) + EPS) : 1.f;
                float g8[8]; loadl8(isk ? mla_k + 8 * (L & 7) : ones8, g8);
#pragma unroll
                for (int j = 0; j < 8; ++j) y[j] = x[j] * nr * g8[j];
                bf16_t* kd = (bf16_t*)(ws + B_KM + ((size_t)((b * 4 + 2 + ((L >> 3) & 1)) * KT_PER_B + kt)) * IMGM) + kv * 64 + (((L & 7) ^ ((kv >> 1) & 7)) << 3);
                if (isk) store8(kd, y);
#pragma unroll
                for (int j = 0; j < 8; ++j) { if (tk == 0) vt[2][j] = y[j]; else vp[2][j] = pk2(vt[2][j], y[j]); }
            }
        }
        { const int kt = i0 >> 6, kv0 = i0 & 63, G = (kv0 >> 4) & 3, hq = (kv0 >> 2) & 1, b4 = ((kv0 & 3) + 4 * ((kv0 & 15) >> 3)) * 2;
          if (L >= 48) { const int hv = (L - 48) >> 3;
#pragma unroll
              for (int s = 0; s < 2; ++s) { unsigned char* img = ws + (s ? B_VD : B_VS) + ((size_t)((b * 2 + hv) * KT_PER_B + kt)) * IMG64;
#pragma unroll
                  for (int j = 0; j < 8; ++j) { const int d = 8 * (L & 7) + j; *(unsigned*)(img + d * 128 + (((2 * G + hq) ^ ((d >> 1) & 7)) << 4) + b4) = vp[s][j]; } } }
          if (L >= 16 && L < 48) { const int h = (L - 16) >> 3; unsigned char* img = ws + B_VM + ((size_t)((b * 4 + h) * KT_PER_B + kt)) * IMG64;
#pragma unroll
              for (int j = 0; j < 8; ++j) { const int d = 8 * (L & 7) + j; *(unsigned*)(img + d * 128 + (((2 * G + hq) ^ ((d >> 1) & 7)) << 4) + b4) = vp[2][j]; } } }
    }
}
constexpr int ATT_SLOT = 24576, ATT_VOFF = 16384;
#define MFMA32(a, b, c) __builtin_amdgcn_mfma_f32_32x32x16_bf16((a), (b), (c), 0, 0, 0)
DI int crow(int r, int hi) { return (r & 3) + 8 * (r >> 2) + 4 * hi; }

constexpr size_t G2_ITEM = 40960;
DI int permpos(int x) { return (2 * (x >> 4) + ((x >> 2) & 1)) * 8 + (x & 3) + 4 * ((x & 15) >> 3); }
DI int fragoff(int row, int ch) { return (((row >> 5) * 4 + (ch >> 1)) * 64 + (ch & 1) * 32 + (row & 31)) * 8; }
DI size_t g2_index(int b, int h, int dir, int c) { return (size_t)(((b * 4 + h) * 2 + dir) * KT_PER_B + c); }

DI void gdn_chunk_phase(const Frame& F, KArgs a, int l) {
    unsigned char* ws = F.ws; int tid_ = F.tid; const int wave = F.wave;
    constexpr int LP = 68;
    LAS float* qs = (LAS float*)F.lds; LAS float* ks = qs + 64 * LP; LAS float* vs = ks + 64 * LP;
    LAS float* KK = vs + 64 * LP; LAS float* QK = KK + 64 * LP; LAS float* AT = QK + 64 * LP;
    LAS float* gl = AT + 2 * 64 * LP; LAS float* bl = gl + 128;
    LAS bf16_t* WS_ = (LAS bf16_t*)KK; LAS bf16_t* US_ = WS_ + 2 * 64 * 64;
    const float* LA = (const float*)(ws + B_LA); const float* BE = (const float*)(ws + B_BE);
    u32x4 pq = {0u, 0u, 0u, 0u}, pk = pq, pv = pq; bf16x8 fa[4], fb[4]; float pla = 0.f, pbe = 0.f;
#pragma unroll
    for (int q = 0; q < 4; ++q) { fa[q] = (bf16x8){0, 0, 0, 0, 0, 0, 0, 0}; fb[q] = fa[q]; }
#define G2_FETCH(it) do { if ((it) < NB * 4 * KT_PER_B) { const int _t = tid_, _ln = _t & 63; const int _b = (it) / (4 * KT_PER_B), _r0 = (it) % (4 * KT_PER_B), _h = _r0 / KT_PER_B, _c = _r0 % KT_PER_B; const int _row0 = _b * TPB + 64 * _c; \
        const size_t _o = (size_t)(_row0 + (_t >> 3)) * 256 + _h * 64 + 8 * (_t & 7); \
        pq = *(const u32x4*)((const bf16_t*)(ws + B_GQ) + _o); pk = *(const u32x4*)((const bf16_t*)(ws + B_GK) + _o); pv = *(const u32x4*)((const bf16_t*)(ws + B_GV) + _o); \
        if (wave < 2) { const int _tok = wave ? 63 - _ln : _ln; pla = LA[((size_t)wave * NT + _row0 + _tok) * 4 + _h]; pbe = BE[((size_t)wave * NT + _row0 + _tok) * 4 + _h]; } \
        { const int _mat = wave >> 2, _mi = (wave >> 1) & 1, _nj = wave & 1, _n = _ln & 31, _hi = _ln >> 5; \
          const bf16_t* _ar = (const bf16_t*)(ws + (_mat ? B_GQ : B_GK)) + (size_t)(_row0 + 32 * _mi + _n) * 256 + _h * 64 + 8 * _hi; \
          const bf16_t* _br = (const bf16_t*)(ws + B_GK) + (size_t)(_row0 + 32 * _nj + _n) * 256 + _h * 64 + 8 * _hi; \
          _Pragma("unroll") for (int _q = 0; _q < 4; ++_q) { fa[_q] = *(const bf16x8*)(_ar + 16 * _q); fb[_q] = *(const bf16x8*)(_br + 16 * _q); } } } } while (0)
    asm volatile("" : "+v"(tid_));
    G2_FETCH(F.vcu);
    for (int item = F.vcu; item < NB * 4 * KT_PER_B; item += F.G) {
        asm volatile("" : "+v"(tid_));
        const int tid = tid_, lane = tid & 63;
        const int b = item / (4 * KT_PER_B), r0 = item % (4 * KT_PER_B), h = r0 / KT_PER_B, c = r0 % KT_PER_B;
        { const int i = tid >> 3, ch = tid & 7;
          float x[8];
          unpack8(pq, x);
#pragma unroll
          for (int j = 0; j < 8; ++j) qs[i * LP + 8 * ch + j] = x[j];
          unpack8(pk, x);
#pragma unroll
          for (int j = 0; j < 8; ++j) ks[i * LP + 8 * ch + j] = x[j];
          unpack8(pv, x);
#pragma unroll
          for (int j = 0; j < 8; ++j) vs[i * LP + 8 * ch + j] = x[j]; }
        if (wave < 2) { const int d = wave;
            float g = pla;
#pragma unroll
            for (int o = 1; o < 64; o <<= 1) { const float t = __shfl_up(g, o); if (lane >= o) g += t; }
            gl[d * 64 + lane] = g; bl[d * 64 + lane] = pbe; }
        {
          const int mat = wave >> 2, mi = (wave >> 1) & 1, nj = wave & 1, n = lane & 31, hi = lane >> 5;
          f32x16 acc;
#pragma unroll
          for (int r = 0; r < 16; ++r) acc[r] = 0.f;
#pragma unroll
          for (int ks4 = 0; ks4 < 4; ++ks4) acc = MFMA32(fa[ks4], fb[ks4], acc);
          LAS float* M = mat ? QK : KK;
#pragma unroll
          for (int r = 0; r < 16; ++r) M[(32 * mi + crow(r, hi)) * LP + 32 * nj + n] = acc[r]; }
        G2_FETCH(item + F.G);
        LDS_WAIT(); __syncthreads();
        { const int d = tid >> 8, t2 = tid & 255, i = t2 >> 2, jq = (t2 & 3) * 16;
          const float gi = gl[d * 64 + i], bi = bl[d * 64 + i];
          const int ti = d ? 63 - i : i;
          bf16_t* qkm = (bf16_t*)(ws + B_G2 + g2_index(b, h, d, c) * G2_ITEM + 2 * 8192);
          float qv[16];
#pragma unroll
          for (int jj = 0; jj < 16; ++jj) { const int j = jq + jj, tj = d ? 63 - j : j;
              const float e = (i >= j) ? __expf(gi - gl[d * 64 + j]) : 0.f;
              AT[(d * 64 + j) * LP + (i & 1) * 32 + (i >> 1)] = (i > j) ? bi * KK[ti * LP + tj] * e : 0.f;
              qv[jj] = QK[ti * LP + tj] * e; }
          { float y0[8] = {qv[0], qv[1], qv[2], qv[3], qv[8], qv[9], qv[10], qv[11]}, y1[8] = {qv[4], qv[5], qv[6], qv[7], qv[12], qv[13], qv[14], qv[15]};
            store8(qkm + fragoff(i, 2 * (jq >> 4)), y0); store8(qkm + fragoff(i, 2 * (jq >> 4) + 1), y1); } }
        LDS_WAIT(); __syncthreads();
        { const int par = tid & 1, col = tid >> 1, d = col >> 7, cc2 = col & 127; const bool isu = cc2 < 64; const int cc = cc2 & 63;
          float r[32];
#pragma unroll
          for (int i2 = 0; i2 < 32; ++i2) { const int i = 2 * i2 + par; const int ti = d ? 63 - i : i; const float bi = bl[d * 64 + i];
              r[i2] = isu ? bi * vs[ti * LP + cc] : bi * __expf(gl[d * 64 + i]) * ks[ti * LP + cc]; }
#pragma clang loop unroll(full)
          for (int j = 0; j < 63; ++j) { const float mine = r[j >> 1], other = dpp_x1(mine); const float xj = ((j & 1) == par) ? mine : other;
              const LAS f32x4* ap = (const LAS f32x4*)(AT + (d * 64 + j) * LP + par * 32);
              const int ib = (j >> 1) >> 2;
#pragma clang loop unroll(full)
              for (int g4 = ib; g4 < 8; ++g4) { const f32x4 av = ap[g4];
#pragma clang loop unroll(full)
                  for (int e4 = 0; e4 < 4; ++e4) { const int i2 = 4 * g4 + e4;
                      if (i2 > (j >> 1)) r[i2] -= av[e4] * xj;
                      else if (i2 == (j >> 1)) { const float a0 = (2 * i2 + par > j) ? av[e4] : 0.f; r[i2] -= a0 * xj; } } }
              if ((j & 3) == 3) asm volatile("" ::: "memory"); }
          LAS bf16_t* dst = (isu ? US_ : WS_) + d * 4096 + cc;
#pragma unroll
          for (int i2 = 0; i2 < 32; ++i2) dst[(2 * i2 + par) * 64] = (bf16_t)f2bf(isu ? r[i2] : -r[i2]); }
#pragma unroll
        for (int q = 0; q < 4; ++q) { const int id = tid + 512 * q, d = id >> 10, mat = (id >> 9) & 1, rowm = (id >> 3) & 63, ch = id & 7;
            float y[8];
            const float glast = gl[d * 64 + 63];
#pragma unroll
            for (int e = 0; e < 8; ++e) { const int x = 16 * (ch >> 1) + 8 * (e >> 2) + 4 * (ch & 1) + (e & 3);
                if (mat == 0) { const int ti = d ? 63 - rowm : rowm; y[e] = qs[ti * LP + x] * __expf(gl[d * 64 + rowm]); }
                else { const int tj = d ? 63 - x : x; y[e] = ks[tj * LP + rowm] * __expf(glast - gl[d * 64 + x]); } }
            store8((bf16_t*)(ws + B_G2 + g2_index(b, h, d, c) * G2_ITEM + (mat ? 3 : 1) * 8192) + fragoff(rowm, ch), y); }
        if (tid < 2) ((float*)(ws + B_DEC))[g2_index(b, h, tid, c)] = __expf(gl[tid * 64 + 63]);
        LDS_WAIT(); __syncthreads();
#pragma unroll
        for (int q = 0; q < 2; ++q) { const int id = tid + 512 * q, d = id >> 9, i = (id >> 3) & 63, ch = id & 7; u32x4 w;
            unsigned hv[8];
#pragma unroll
            for (int e = 0; e < 8; ++e) { const int x = 16 * (ch >> 1) + 8 * (e >> 2) + 4 * (ch & 1) + (e & 3); hv[e] = WS_[d * 4096 + i * 64 + x]; }
            w.x = hv[0] | (hv[1] << 16); w.y = hv[2] | (hv[3] << 16); w.z = hv[4] | (hv[5] << 16); w.w = hv[6] | (hv[7] << 16);
            *(u32x4*)((bf16_t*)(ws + B_G2 + g2_index(b, h, d, c) * G2_ITEM) + fragoff(i, ch)) = w; }
#pragma unroll
        for (int q = 0; q < 2; ++q) { const int id = tid + 512 * q, d = id >> 9, dv = (id >> 3) & 63, qq = id & 7; u32x4 w;
            unsigned hv[8];
#pragma unroll
            for (int e = 0; e < 8; ++e) { const int rr = 8 * (qq & 1) + e, i = 32 * (qq >> 2) + (rr & 3) + 8 * (rr >> 2) + 4 * ((qq >> 1) & 1); hv[e] = US_[d * 4096 + i * 64 + dv]; }
            w.x = hv[0] | (hv[1] << 16); w.y = hv[2] | (hv[3] << 16); w.z = hv[4] | (hv[5] << 16); w.w = hv[6] | (hv[7] << 16);
            *(u32x4*)((bf16_t*)(ws + B_G2 + g2_index(b, h, d, c) * G2_ITEM + 4 * 8192) + (dv >> 5) * 2048 + ((((qq >> 2) * 2 + (qq & 1)) * 64 + ((qq >> 1) & 1) * 32 + (dv & 31)) * 8)) = w; }
        LDS_WAIT(); __syncthreads();
    }
}

#undef G2_FETCH
DI bf16x8 pack8(const f32x16& v, int s8) {
    u32x4 w; w.x = pk2(v[s8 + 0], v[s8 + 1]); w.y = pk2(v[s8 + 2], v[s8 + 3]); w.z = pk2(v[s8 + 4], v[s8 + 5]); w.w = pk2(v[s8 + 6], v[s8 + 7]); return __builtin_bit_cast(bf16x8, w);
}
DI void gdn_scan_wave(unsigned char* ws, int chain, int lane_in) {
    int lane = lane_in; asm volatile("" : "+v"(lane));
    const int hh = chain & 1, dir = (chain >> 1) & 1, h = (chain >> 2) & 3, b = chain >> 4;
    const int n = lane & 31, hi = lane >> 5;
    f32x16 S0, S1;
#pragma unroll
    for (int r = 0; r < 16; ++r) { S0[r] = 0.f; S1[r] = 0.f; }
    float* OD = (float*)(ws + B_OF) + (size_t)dir * NT * 256;
#pragma unroll 1
    for (int s = 0; s < KT_PER_B; ++s) {
        const int c = dir ? (s < 4 ? 3 - s : 135 - s) : s;
        const unsigned char* base = ws + B_G2 + g2_index(b, h, dir, c) * G2_ITEM;
        const float dl = ((const float*)(ws + B_DEC))[g2_index(b, h, dir, c)];
        const unsigned char* ap = base + lane * 16;
        bf16x8 fa[2][8]; u32x4 ut[4];
        { const u32x4* up = (const u32x4*)(base + 4 * 8192 + hh * 4096) + lane;
#pragma unroll
          for (int q = 0; q < 4; ++q) ut[q] = up[q * 64]; }
#pragma unroll
        for (int X = 0; X < 2; ++X)
#pragma unroll
            for (int f = 0; f < 8; ++f) fa[X][f] = *(const bf16x8*)(ap + X * 8192 + f * 1024);
        __builtin_amdgcn_sched_barrier(0);
        bf16x8 sb[4]; sb[0] = pack8(S0, 0); sb[1] = pack8(S0, 8); sb[2] = pack8(S1, 0); sb[3] = pack8(S1, 8);
        f32x16 vn0, vn1, o0, o1;
#pragma unroll
        for (int q = 0; q < 2; ++q) { const u32x4 w = ut[q];
            vn0[8 * q + 0] = bflo(w.x); vn0[8 * q + 1] = bfhi(w.x); vn0[8 * q + 2] = bflo(w.y); vn0[8 * q + 3] = bfhi(w.y); vn0[8 * q + 4] = bflo(w.z); vn0[8 * q + 5] = bfhi(w.z); vn0[8 * q + 6] = bflo(w.w); vn0[8 * q + 7] = bfhi(w.w);
            const u32x4 w1 = ut[2 + q];
            vn1[8 * q + 0] = bflo(w1.x); vn1[8 * q + 1] = bfhi(w1.x); vn1[8 * q + 2] = bflo(w1.y); vn1[8 * q + 3] = bfhi(w1.y); vn1[8 * q + 4] = bflo(w1.z); vn1[8 * q + 5] = bfhi(w1.z); vn1[8 * q + 6] = bflo(w1.w); vn1[8 * q + 7] = bfhi(w1.w); }
#pragma unroll
        for (int r = 0; r < 16; ++r) { o0[r] = 0.f; o1[r] = 0.f; }
#pragma unroll
        for (int G = 0; G < 4; ++G) {
            vn0 = MFMA32(fa[0][G], sb[G], vn0); vn1 = MFMA32(fa[0][4 + G], sb[G], vn1);
            o0 = MFMA32(fa[1][G], sb[G], o0);   o1 = MFMA32(fa[1][4 + G], sb[G], o1); }
        __builtin_amdgcn_sched_barrier(0);
        bf16x8 fb[2][8];
#pragma unroll
        for (int X = 0; X < 2; ++X)
#pragma unroll
            for (int f = 0; f < 8; ++f) fb[X][f] = *(const bf16x8*)(ap + (2 + X) * 8192 + f * 1024);
        __builtin_amdgcn_sched_barrier(0);
        bf16x8 vb[4]; vb[0] = pack8(vn0, 0); vb[1] = pack8(vn0, 8); vb[2] = pack8(vn1, 0); vb[3] = pack8(vn1, 8);
#pragma unroll
        for (int r = 0; r < 16; ++r) { S0[r] *= dl; S1[r] *= dl; }
#pragma unroll
        for (int G = 0; G < 4; ++G) {
            o0 = MFMA32(fb[0][G], vb[G], o0);   o1 = MFMA32(fb[0][4 + G], vb[G], o1);
            S0 = MFMA32(fb[1][G], vb[G], S0);   S1 = MFMA32(fb[1][4 + G], vb[G], S1); }
        { const int rowc = b * TPB + 64 * c; const long sd = dir ? -256 : 256;
          float* p = OD + (size_t)(rowc + (dir ? 63 : 0)) * 256 + h * 64 + 32 * hh + n + sd * 4 * hi;
#pragma unroll
          for (int r = 0; r < 16; ++r) { const int i0 = (r & 3) + 8 * (r >> 2); p[sd * i0] = o0[r]; p[sd * (32 + i0)] = o1[r]; } }
    }
}

DI void gdn_out_bh(unsigned char* ws, KArgs a, int l, int b, int h, int wave, int lane_in) {
    int lane = lane_in; asm volatile("" : "+v"(lane));
    unsigned char* mix = ws + WS_MIX; const bf16_t* P = (const bf16_t*)(ws + B_P); const float* OF = (const float*)(ws + B_OF);
    const int sub = lane >> 4, c4 = h * 64 + 4 * (lane & 15);
    const f32x4 g4 = *(const f32x4*)(a->in[12] + l * 64 + 4 * (lane & 15));
    const int r0 = b * TPB + wave * 4 + sub;
    for (int k = 0; k < TPB / 32; k += 4) {
        f32x4 of[4], ob[4]; u32x2 zw[4];
#pragma unroll
        for (int q = 0; q < 4; ++q) { const size_t row = (size_t)(r0 + 32 * (k + q));
            of[q] = __builtin_nontemporal_load((const f32x4*)(OF + row * 256 + c4)); ob[q] = __builtin_nontemporal_load((const f32x4*)(OF + (size_t)NT * 256 + row * 256 + c4)); zw[q] = __builtin_nontemporal_load((const u32x2*)(P + row * NP + C_GZ + c4)); }
#pragma unroll
        for (int q = 0; q < 4; ++q) { const size_t row = (size_t)(r0 + 32 * (k + q)); const f32x4 o = of[q] + ob[q];
            float ss = o.x * o.x + o.y * o.y + o.z * o.z + o.w * o.w;
            ss += dpp_x1(ss); ss += dpp_x2(ss); ss += dpp_m8(ss); ss += dpp_m16(ss);
            const float r = rsqrtf(ss * (1.f / 64.f) + EPS);
            const float z0 = bflo(zw[q].x), z1 = bfhi(zw[q].x), z2 = bflo(zw[q].y), z3 = bfhi(zw[q].y);
            *(unsigned*)(mix + row * DM + c4) = f8pack(o.x * r * g4.x * siluf(z0), o.y * r * g4.y * siluf(z1), o.z * r * g4.z * siluf(z2), o.w * r * g4.w * siluf(z3)); }
    }
}
DI void gdn_out_phase(const Frame& F, KArgs a, int l) {
    unsigned char* ws = F.ws; int lane_ = F.lane; asm volatile("" : "+v"(lane_)); const int lane = lane_;
    unsigned char* mix = ws + WS_MIX; const bf16_t* P = (const bf16_t*)(ws + B_P);
    const float* OF = (const float*)(ws + B_OF); const float* gg = a->in[12] + l * 64;
    const int gw = F.vcu * 8 + F.wave, NGW = F.G * 8;
    const f32x4 g4 = *(const f32x4*)(gg + 4 * (lane & 15));
    f32x4 nof, nob; u32x2 nz;
#define G4_FETCH(r) do { const int _r = ((r) < NT) ? (r) : gw; nof = *(const f32x4*)(OF + (size_t)_r * 256 + 4 * lane); nob = *(const f32x4*)(OF + (size_t)NT * 256 + (size_t)_r * 256 + 4 * lane); \
        nz = *(const u32x2*)(P + (size_t)_r * NP + C_GZ + 4 * lane); } while (0)
    G4_FETCH(gw);
    for (int row = gw; row < NT; row += NGW) {
        const f32x4 o = nof + nob; const u32x2 zw = nz;
        G4_FETCH(row + NGW);
        float ss = o.x * o.x + o.y * o.y + o.z * o.z + o.w * o.w;
        ss += dpp_x1(ss); ss += dpp_x2(ss); ss += dpp_m8(ss); ss += dpp_m16(ss);
        const float r = rsqrtf(ss * (1.f / 64.f) + EPS);
        const float z0 = bflo(zw.x), z1 = bfhi(zw.x), z2 = bflo(zw.y), z3 = bfhi(zw.y);
        *(unsigned*)(mix + (size_t)row * DM + 4 * lane) = f8pack(o.x * r * g4.x * siluf(z0), o.y * r * g4.y * siluf(z1), o.z * r * g4.z * siluf(z2), o.w * r * g4.w * siluf(z3));
    }
#undef G4_FETCH
}
#ifndef SCAN_REPS
#define SCAN_REPS 1
#endif
struct AttnDesc {
    const bf16_t* Q; int qpitch;
    const unsigned char* Kimg; const unsigned char* Vimg; int kstride;
    int ntiles, nA, base2;
    int mask; int qpos0;
    int has_sink; float sink;
    unsigned char* O;
};

template <int DK, bool NOMAX>
DI void attn_unit(LAS unsigned char* lds, const AttnDesc& D) {
    constexpr int NKS = DK / 16, KP = (DK == 96) ? 2 : 1;
    int tid_ = tidx(); asm volatile("" : "+v"(tid_));
    const int tid = tid_, lane = tid & 63, r32 = lane & 31, hi = lane >> 5; const int wid = __builtin_amdgcn_readfirstlane(tid >> 6);
    bf16x8 qf[NKS];
    { const bf16_t* qp = D.Q + (size_t)(wid * 32 + r32) * D.qpitch + 8 * hi;
#pragma unroll
      for (int ks = 0; ks < NKS; ++ks) qf[ks] = *(const bf16x8*)(qp + 16 * ks); }
    const unsigned lane16 = (unsigned)lane * 16u;
#define ATT_TILE(t) ((t) < D.nA ? (t) : D.base2 + ((t) - D.nA))
#define ATT_DMA_K(t, ksl) do { const unsigned char* _k = D.Kimg + (size_t)ATT_TILE(t) * D.kstride + wid * 1024 + lane16; \
        __builtin_amdgcn_global_load_lds((const unsigned*)_k, (LAS unsigned*)(lds + (ksl) * 16384 + wid * 1024), 16, 0, 0); \
        if (KP == 2) __builtin_amdgcn_global_load_lds((const unsigned*)(_k + 8192), (LAS unsigned*)(lds + (ksl) * 16384 + 8192 + wid * 1024), 16, 0, 0); } while (0)
#define ATT_DMA_V(t, vsl) do { const unsigned char* _v = D.Vimg + (size_t)ATT_TILE(t) * 8192 + wid * 1024 + lane16; \
        __builtin_amdgcn_global_load_lds((const unsigned*)_v, (LAS unsigned*)(lds + 32768 + (vsl) * 8192 + wid * 1024), 16, 0, 0); } while (0)
    const int NTL = D.ntiles;
    const int kswz = (r32 >> 1) & 7, pswz = (r32 >> 2) & 3;
    const int koff0 = r32 * 128, koffp = 8192 + r32 * 64;
    const int qpos = D.qpos0 + wid * 32 + r32;
    f32x16 o0, o1, zero16, S0, S1, N0, N1;
#pragma unroll
    for (int r = 0; r < 16; ++r) { o0[r] = 0.f; o1[r] = 0.f; zero16[r] = 0.f; }
    float m_used = 0.f, lsum = 0.f;
    bf16x8 pf[4];
#pragma unroll
    for (int G = 0; G < 4; ++G) pf[G] = (bf16x8){0, 0, 0, 0, 0, 0, 0, 0};
#define ATT_QK(X0, X1, ksl) do { const LAS unsigned char* _kb = lds + (ksl) * 16384; bf16x8 _a0[NKS], _a1[NKS]; \
        _Pragma("unroll") for (int ks = 0; ks < 4; ++ks) { _a0[ks] = *(const LAS bf16x8*)(_kb + koff0 + (((2 * ks + hi) ^ kswz) << 4)); _a1[ks] = *(const LAS bf16x8*)(_kb + 4096 + koff0 + (((2 * ks + hi) ^ kswz) << 4)); } \
        if (DK == 96) { _Pragma("unroll") for (int ks = 0; ks < 2; ++ks) { _a0[NKS - 2 + ks] = *(const LAS bf16x8*)(_kb + koffp + (((2 * ks + hi) ^ pswz) << 4)); _a1[NKS - 2 + ks] = *(const LAS bf16x8*)(_kb + 2048 + koffp + (((2 * ks + hi) ^ pswz) << 4)); } } \
        if (ATT_PROBE & 1) { _Pragma("unroll") for (int ks = 0; ks < 4; ++ks) { const bf16x8 _e0 = *(const volatile LAS bf16x8*)(_kb + koff0 + (((2 * ks + hi) ^ kswz) << 4)), _e1 = *(const volatile LAS bf16x8*)(_kb + 4096 + koff0 + (((2 * ks + hi) ^ kswz) << 4)); asm volatile("" :: "v"(_e0), "v"(_e1)); } } \
        X0 = MFMA32(_a0[0], qf[0], zero16); X1 = MFMA32(_a1[0], qf[0], zero16); \
        _Pragma("unroll") for (int ks = 1; ks < NKS; ++ks) { X0 = MFMA32(_a0[ks], qf[ks], X0); X1 = MFMA32(_a1[ks], qf[ks], X1); } } while (0)
#define ATT_PV(vsl) do { const LAS unsigned char* _vb = lds + 32768 + (vsl) * 8192; \
        _Pragma("unroll") for (int G = 0; G < 4; ++G) { const bf16x8 _v0 = *(const LAS bf16x8*)(_vb + koff0 + (((2 * G + hi) ^ kswz) << 4)); const bf16x8 _v1 = *(const LAS bf16x8*)(_vb + 4096 + koff0 + (((2 * G + hi) ^ kswz) << 4)); \
            if (ATT_PROBE & 1) { const bf16x8 _e0 = *(const volatile LAS bf16x8*)(_vb + koff0 + (((2 * G + hi) ^ kswz) << 4)), _e1 = *(const volatile LAS bf16x8*)(_vb + 4096 + koff0 + (((2 * G + hi) ^ kswz) << 4)); asm volatile("" :: "v"(_e0), "v"(_e1)); } \
            o0 = MFMA32(_v0, pf[G], o0); o1 = MFMA32(_v1, pf[G], o1); } } while (0)
#define ATT_MAX(t, S0, S1) do { \
        if (D.mask && (t) >= D.nA) { const int _kv0 = (ATT_TILE(t) - 4) * 64; \
            _Pragma("unroll") for (int r = 0; r < 16; ++r) { const int _d0 = qpos - (_kv0 + crow(r, hi)); const int _d1 = _d0 - 32; \
                if (_d0 > 128 || _d0 < -128) S0[r] = -INFINITY; if (_d1 > 128 || _d1 < -128) S1[r] = -INFINITY; } } \
        if constexpr (!NOMAX) { \
        float _mt = fmaxf(S0[0], S1[0]); \
        _Pragma("unroll") for (int r = 1; r < 16; ++r) _mt = fmaxf(_mt, fmaxf(S0[r], S1[r])); \
        { auto _rr = __builtin_amdgcn_permlane32_swap(__float_as_uint(_mt), __float_as_uint(_mt), false, false); _mt = fmaxf(__uint_as_float(_rr[0]), __uint_as_float(_rr[1])); } \
        _mt -= m_used; \
        if (__builtin_expect(__any(_mt > 8.f || m_used != 0.f), 0)) { const float _d = (_mt > 8.f) ? _mt : 0.f; const float _al = __builtin_amdgcn_exp2f(-_d); m_used += _d; lsum *= _al; \
            _Pragma("unroll") for (int r = 0; r < 16; ++r) { S0[r] -= m_used; S1[r] -= m_used; o0[r] *= _al; o1[r] *= _al; } \
            _Pragma("unroll") for (int G = 0; G < 4; ++G) { u32x4 _w = __builtin_bit_cast(u32x4, pf[G]); \
                _w.x = pk2(bflo(_w.x) * _al, bfhi(_w.x) * _al); _w.y = pk2(bflo(_w.y) * _al, bfhi(_w.y) * _al); _w.z = pk2(bflo(_w.z) * _al, bfhi(_w.z) * _al); _w.w = pk2(bflo(_w.w) * _al, bfhi(_w.w) * _al); \
                pf[G] = __builtin_bit_cast(bf16x8, _w); } } } } while (0)
#ifndef ATT_PROBE
#define ATT_PROBE 0
#endif
#define ATT_EXP(S0, S1) do { float _ps = 0.f; \
        if (ATT_PROBE & 2) { _Pragma("unroll") for (int r = 0; r < 16; ++r) { float _d0, _d1; asm volatile("v_exp_f32 %0, %2\n\tv_exp_f32 %1, %3" : "=v"(_d0), "=v"(_d1) : "v"(S0[r]), "v"(S1[r])); } } \
        _Pragma("unroll") for (int r = 0; r < 16; ++r) { S0[r] = __builtin_amdgcn_exp2f(S0[r]); S1[r] = __builtin_amdgcn_exp2f(S1[r]); _ps += S0[r] + S1[r]; } \
        lsum += _ps; pf[0] = pack8(S0, 0); pf[1] = pack8(S0, 8); pf[2] = pack8(S1, 0); pf[3] = pack8(S1, 8); } while (0)
    ATT_DMA_K(0, 0); ATT_DMA_V(0, 0); ATT_DMA_K(1, 1);
    if (KP == 2) asm volatile("s_waitcnt vmcnt(3)\n\ts_barrier" ::: "memory"); else asm volatile("s_waitcnt vmcnt(2)\n\ts_barrier" ::: "memory");
    ATT_QK(S0, S1, 0);
    asm volatile("s_waitcnt vmcnt(0)\n\ts_barrier" ::: "memory");
    ATT_DMA_K(2, 0); ATT_DMA_V(1, 1);
    if constexpr (NOMAX) ATT_DMA_V(2, 2);
    ATT_MAX(0, S0, S1);
    ATT_QK(N0, N1, 1);
    ATT_EXP(S0, S1);
    S0 = N0; S1 = N1;
    constexpr int VR = NOMAX ? 4 : 3;
    int vprev = 0, vnext = VR - 1;
#define ATT_BODY(t, C0, C1, X0, X1) do { \
        if (ATT_PROBE & 4) asm volatile("s_barrier" ::: "memory"); \
        asm volatile("s_waitcnt vmcnt(1)\n\ts_barrier" ::: "memory"); \
        if ((t) + 2 < NTL) ATT_DMA_K((t) + 2, (t) & 1); \
        ATT_DMA_V((t) + 1, vnext); \
        ATT_MAX(t, C0, C1); \
        ATT_PV(vprev); \
        ATT_QK(X0, X1, ((t) + 1) & 1); \
        ATT_EXP(C0, C1); \
        vprev = (vprev == 2) ? 0 : vprev + 1; vnext = (vnext == 2) ? 0 : vnext + 1; } while (0)
    constexpr int MF = 8 + 2 * NKS;
    const unsigned lbase = (unsigned)(size_t)lds;
    unsigned xo[4], xp[2];
#pragma unroll
    for (int G = 0; G < 4; ++G) xo[G] = lbase + koff0 + (((2 * G + hi) ^ kswz) << 4);
#pragma unroll
    for (int ks = 0; ks < 2; ++ks) xp[ks] = lbase + koffp + (((2 * ks + hi) ^ pswz) << 4);
#define ATT_RD(i, KSL, VSL) do { if ((i) < 8) asm volatile("ds_read_b128 %0, %1 offset:%2" : "=v"(_f[(i) < MF ? (i) : 0]) : "v"(xo[((i) >> 1) & 3]), "n"(32768 + (VSL) * 8192 + ((i) & 1) * 4096)); \
        else if ((i) < 16) asm volatile("ds_read_b128 %0, %1 offset:%2" : "=v"(_f[(i) < MF ? (i) : 0]) : "v"(xo[(((i) - 8) >> 1) & 3]), "n"((KSL) * 16384 + ((i) & 1) * 4096)); \
        else if ((i) < MF) asm volatile("ds_read_b128 %0, %1 offset:%2" : "=v"(_f[(i) < MF ? (i) : 0]) : "v"(xp[(((i) - 16) >> 1) & 1]), "n"((KSL) * 16384 + ((i) & 1) * 2048)); } while (0)
#define ATT_CVT(c_, C0, C1) do { const int _G = (c_) >> 2, _p = (c_) & 3, _b = 8 * (_G & 1) + 2 * _p; \
        unsigned _w = (_G < 2) ? pk2(C0[_b], C0[_b + 1]) : pk2(C1[_b], C1[_b + 1]); asm volatile("" : "+v"(_w)); \
        u32x4 _q = __builtin_bit_cast(u32x4, pf[_G]); _q[_p] = _w; pf[_G] = __builtin_bit_cast(bf16x8, _q); } while (0)
#define ATT_G(i, KSL, VP, C0, C1, X0, X1) do { if ((i) < MF) { \
            if ((i) + 3 < MF) ATT_RD((i) + 3, KSL, VP); \
            asm volatile("s_waitcnt lgkmcnt(%1)" : "+v"(_f[(i) < MF ? (i) : 0]) : "n"(((i) + 3 < MF) ? 3 : ((MF - 1 - (i)) > 0 ? (MF - 1 - (i)) : 0))); \
            if ((i) < 8) { if ((i) & 1) { o1 = MFMA32(_f[(i) < MF ? (i) : 0], pf[((i) >> 1) & 3], o1); asm volatile("" : "+v"(o1)); } else { o0 = MFMA32(_f[(i) < MF ? (i) : 0], pf[((i) >> 1) & 3], o0); asm volatile("" : "+v"(o0)); } } \
            else { constexpr int _ks = ((i) - 8) >> 1; if ((i) & 1) { X1 = MFMA32(_f[(i) < MF ? (i) : 0], qf[(_ks >= 0 && _ks < NKS) ? _ks : 0], _ks == 0 ? zero16 : X1); asm volatile("" : "+v"(X1)); } \
                   else { X0 = MFMA32(_f[(i) < MF ? (i) : 0], qf[(_ks >= 0 && _ks < NKS) ? _ks : 0], _ks == 0 ? zero16 : X0); asm volatile("" : "+v"(X0)); } } } \
        if ((i) < 16) { float _e0 = __builtin_amdgcn_exp2f((i) < 8 ? C0[(2 * (i)) & 15] : C1[(2 * (i)) & 15]), _e1 = __builtin_amdgcn_exp2f((i) < 8 ? C0[(2 * (i) + 1) & 15] : C1[(2 * (i) + 1) & 15]); \
            asm volatile("" : "+v"(_e0), "+v"(_e1)); \
            if ((i) < 8) { C0[(2 * (i)) & 15] = _e0; C0[(2 * (i) + 1) & 15] = _e1; } else { C1[(2 * (i)) & 15] = _e0; C1[(2 * (i) + 1) & 15] = _e1; } \
            } \
        if ((i) >= 1 && (i) <= 16) { constexpr int _j = (i) - 1;        \
            _ps0 += (_j < 8 ? C0[(2 * _j) & 15] : C1[(2 * _j) & 15]); _ps1 += (_j < 8 ? C0[(2 * _j + 1) & 15] : C1[(2 * _j + 1) & 15]); asm volatile("" : "+v"(_ps0), "+v"(_ps1)); } \
        if ((i) >= 4) ATT_CVT((i) - 4, C0, C1); \
        __builtin_amdgcn_sched_barrier(0); } while (0)
#define ATT_BODY_F(t, KSL, VP, C0, C1, X0, X1) do {        \
        asm volatile("s_waitcnt vmcnt(1)\n\ts_barrier" ::: "memory"); \
        if ((t) + 2 < NTL) { ATT_DMA_K((t) + 2, (t) & 1); ATT_DMA_V((t) + 2, ((VP) + 3) & 3); } \
        if (D.mask && (t) >= D.nA) { const int _kv0 = (ATT_TILE(t) - 4) * 64; \
            _Pragma("unroll") for (int r = 0; r < 16; ++r) { const int _d0 = qpos - (_kv0 + crow(r, hi)); const int _d1 = _d0 - 32; \
                if (_d0 > 128 || _d0 < -128) C0[r] = -INFINITY; if (_d1 > 128 || _d1 < -128) C1[r] = -INFINITY; } } \
        float _ps0 = 0.f, _ps1 = 0.f; \
        __builtin_amdgcn_sched_barrier(0); \
        ATT_G(0, KSL, VP, C0, C1, X0, X1); ATT_G(1, KSL, VP, C0, C1, X0, X1); ATT_G(2, KSL, VP, C0, C1, X0, X1); ATT_G(3, KSL, VP, C0, C1, X0, X1); ATT_G(4, KSL, VP, C0, C1, X0, X1); \
        ATT_G(5, KSL, VP, C0, C1, X0, X1); ATT_G(6, KSL, VP, C0, C1, X0, X1); ATT_G(7, KSL, VP, C0, C1, X0, X1); ATT_G(8, KSL, VP, C0, C1, X0, X1); ATT_G(9, KSL, VP, C0, C1, X0, X1); \
        ATT_G(10, KSL, VP, C0, C1, X0, X1); ATT_G(11, KSL, VP, C0, C1, X0, X1); ATT_G(12, KSL, VP, C0, C1, X0, X1); ATT_G(13, KSL, VP, C0, C1, X0, X1); ATT_G(14, KSL, VP, C0, C1, X0, X1); \
        ATT_G(15, KSL, VP, C0, C1, X0, X1); ATT_G(16, KSL, VP, C0, C1, X0, X1); ATT_G(17, KSL, VP, C0, C1, X0, X1); ATT_G(18, KSL, VP, C0, C1, X0, X1); ATT_G(19, KSL, VP, C0, C1, X0, X1); \
        lsum += _ps0 + _ps1; \
        ATT_RD(0, KSL, ((VP) + 1) & 3); ATT_RD(1, KSL, ((VP) + 1) & 3); ATT_RD(2, KSL, ((VP) + 1) & 3);        \
        __builtin_amdgcn_sched_barrier(0); } while (0)
    int t = 1;
    bf16x8 _f[MF];
    if constexpr (NOMAX) {
        ATT_RD(0, 0, 0); ATT_RD(1, 0, 0); ATT_RD(2, 0, 0);
        __builtin_amdgcn_sched_barrier(0);
#pragma unroll 1
        for (; t + 3 < NTL - 1; t += 4) { ATT_BODY_F(t, 0, 0, S0, S1, N0, N1); ATT_BODY_F(t + 1, 1, 1, N0, N1, S0, S1); ATT_BODY_F(t + 2, 0, 2, S0, S1, N0, N1); ATT_BODY_F(t + 3, 1, 3, N0, N1, S0, S1); }
        if (t < NTL - 1) { ATT_BODY_F(t, 0, 0, S0, S1, N0, N1); ++t;
            if (t < NTL - 1) { ATT_BODY_F(t, 1, 1, N0, N1, S0, S1); ++t;
                if (t < NTL - 1) { ATT_BODY_F(t, 0, 2, S0, S1, N0, N1); ++t; S0 = N0; S1 = N1; } }
            else { S0 = N0; S1 = N1; } }
        vprev = (NTL - 2) & 3;
        asm volatile("s_waitcnt lgkmcnt(0)" : "+v"(_f[0]), "+v"(_f[1]), "+v"(_f[2]));
    } else {
#pragma unroll 1
        for (; t + 1 < NTL - 1; t += 2) { ATT_BODY(t, S0, S1, N0, N1); ATT_BODY(t + 1, N0, N1, S0, S1); }
        if (t < NTL - 1) { ATT_BODY(t, S0, S1, N0, N1); S0 = N0; S1 = N1; }
    }
    asm volatile("s_waitcnt vmcnt(1)\n\ts_barrier" ::: "memory");
    ATT_MAX(NTL - 1, S0, S1);
    ATT_PV(vprev);
    ATT_EXP(S0, S1);
    vprev = (vprev == VR - 1) ? 0 : vprev + 1;
    asm volatile("s_waitcnt vmcnt(0)\n\ts_barrier" ::: "memory");
    ATT_PV(vprev);
    float lt = lsum;
    { auto rr = __builtin_amdgcn_permlane32_swap(__float_as_uint(lt), __float_as_uint(lt), false, false); lt = __uint_as_float(rr[0]) + __uint_as_float(rr[1]); }
    if (D.has_sink) lt += __builtin_amdgcn_exp2f(D.sink * LOG2E - m_used);
    const float inv = 1.f / lt;
    unsigned char* op = D.O + (size_t)(wid * 32 + r32) * DM + 4 * hi;
#pragma unroll
    for (int rr = 0; rr < 4; ++rr) {
        *(unsigned*)(op + 8 * rr) = f8pack(o0[4 * rr] * inv, o0[4 * rr + 1] * inv, o0[4 * rr + 2] * inv, o0[4 * rr + 3] * inv);
        *(unsigned*)(op + 32 + 8 * rr) = f8pack(o1[4 * rr] * inv, o1[4 * rr + 1] * inv, o1[4 * rr + 2] * inv, o1[4 * rr + 3] * inv); }
    asm volatile("s_waitcnt lgkmcnt(0)\n\ts_barrier" ::: "memory");
#undef ATT_TILE
#undef ATT_DMA_K
#undef ATT_DMA_V
#undef ATT_QK
#undef ATT_PV
#undef ATT_MAX
#undef ATT_EXP
#undef ATT_BODY
#undef ATT_BODY_F
#undef ATT_RD
#undef ATT_G
#undef ATT_CVT
}

DI void attn_phase(const Frame& F, KArgs a, int l, int rep) {
    unsigned char* ws = F.ws; LAS unsigned char* lds = F.lds;
    const int NUNITS = 16 + ((l == 0) ? 1584 : 1536);
    unsigned* queue = F.ctl + CW_QUEUE + 64 * l + 32 * rep;
    unsigned char* mix = ws + WS_MIX;
    if (F.wave == 0) { const float* sg = a->in[18] + l * 128; const float* gg = a->in[20] + l * 128; const float* mg = a->in[17] + l * 192; const int ln = F.lane;
        const float sq = wave_max(fabsf(sg[ln])), sk = wave_max(fabsf(sg[64 + ln])), gq = wave_max(fabsf(gg[ln])), gk = wave_max(fabsf(gg[64 + ln]));
        const float mqn = wave_max(fabsf(mg[ln])), mqp = wave_max(fabsf(mg[64 + (ln & 31)])), mkn = wave_max(fabsf(mg[96 + ln])), mkp = wave_max(fabsf(mg[160 + (ln & 31)]));
        const float bs = 65.f * sq * sk * QSCALE64, bg = 65.f * gq * gk * QSCALE64, bm = 1.02f * sqrtf(64.f * mqn * mqn + 32.f * mqp * mqp) * sqrtf(64.f * mkn * mkn + 32.f * mkp * mkp) * QSCALEM;
        const float smax = fmaxf(fmaxf(fabsf(a->in[19][l * 4 + 0]), fabsf(a->in[19][l * 4 + 1])), fmaxf(fabsf(a->in[19][l * 4 + 2]), fabsf(a->in[19][l * 4 + 3]))) * LOG2E;
        if (ln == 0) F.MISC[193] = ((bs <= 64.f && smax <= 64.f) ? 1u : 0u) | ((bg <= 64.f) ? 2u : 0u) | ((bm <= 64.f) ? 4u : 0u); }
    __syncthreads();
    const unsigned fastf = (unsigned)__builtin_amdgcn_readfirstlane((int)F.MISC[193]);
    for (;;) {
        if (F.tid == 0) F.MISC[192] = __hip_atomic_fetch_add(queue, 1u, __ATOMIC_RELAXED, __HIP_MEMORY_SCOPE_AGENT);
        __syncthreads();
        int u = __builtin_amdgcn_readfirstlane((int)F.MISC[192]);
        __syncthreads();
        if (u >= NUNITS) break;
        if (u < 16) { if (F.wave < 4) { for (int rp = 0; rp < SCAN_REPS; ++rp) gdn_scan_wave(ws, u * 4 + F.wave, F.lane); }
            __threadfence(); __syncthreads(); __threadfence();
            gdn_out_bh(ws, a, l, u >> 2, u & 3, F.wave, F.lane); continue; }
        u -= 16;
        int type, b, h, qt; bool ctxq = false;
        if (u < 1536) { type = u >> 9; const int v = u & 511; b = v >> 7; h = (v >> 5) & 3; qt = v & 31; if (type == 1) type = 2; else if (type == 2) type = 1; }
        else { const int v = u - 1536; type = v >> 4; b = (v >> 2) & 3; h = v & 3; qt = 0; ctxq = true; }
        const int row0 = b * TPB + (ctxq ? 0 : CTXL + qt * 256);
        AttnDesc D;
        D.ntiles = ctxq ? 4 : KT_PER_B; D.nA = D.ntiles; D.base2 = 0; D.mask = 0; D.qpos0 = qt * 256; D.has_sink = 0; D.sink = 0.f;
        if (type == 0) {
            D.Q = (const bf16_t*)(ws + B_QM) + (size_t)row0 * 384 + h * 96; D.qpitch = 384;
            D.Kimg = ws + B_KM + (size_t)((b * 4 + h) * KT_PER_B) * IMGM; D.kstride = (int)IMGM; D.Vimg = ws + B_VM + (size_t)((b * 4 + h) * KT_PER_B) * IMG64;
            D.O = mix + (size_t)row0 * DM + 256 + h * 64;
            if (fastf & 4u) attn_unit<96, true>(lds, D); else attn_unit<96, false>(lds, D);
        } else {
            const int hk = h >> 1;
            D.Q = (const bf16_t*)(ws + (type == 1 ? B_QS : B_QD)) + (size_t)row0 * 256 + h * 64; D.qpitch = 256;
            D.Kimg = ws + (type == 1 ? B_KS : B_KD) + (size_t)((b * 2 + hk) * KT_PER_B) * IMG64; D.kstride = (int)IMG64;
            D.Vimg = ws + (type == 1 ? B_VS : B_VD) + (size_t)((b * 2 + hk) * KT_PER_B) * IMG64;
            D.O = mix + (size_t)row0 * DM + (type == 1 ? 512 : 768) + h * 64;
            if (type == 1) { D.has_sink = 1; D.sink = a->in[19][l * 4 + h];
                if (!ctxq) { const int lo = (qt * 256 - 128 < 0) ? 0 : qt * 256 - 128, hiq = (qt * 256 + 383 > SEQ - 1) ? SEQ - 1 : qt * 256 + 383;
                    D.nA = 4; D.base2 = 4 + (lo >> 6); D.ntiles = 4 + ((hiq >> 6) - (lo >> 6) + 1); D.mask = 1; } }
            if (fastf & (type == 1 ? 1u : 2u)) attn_unit<64, true>(lds, D); else attn_unit<64, false>(lds, D);
        }
    }
}
DI void moe_tables(const Frame& F, int l) {
    LAS int* tstart = (LAS int*)(F.MISC + 16); LAS int* ecnt = (LAS int*)(F.MISC + 96);
    if (F.tid < 64) ecnt[F.tid] = (int)__hip_atomic_load(F.ctl + CW_ECNT + l * 64 + F.tid, __ATOMIC_RELAXED, __HIP_MEMORY_SCOPE_AGENT);
    LDS_WAIT(); __syncthreads();
    if (F.tid < 64) {
        const int tiles = (ecnt[F.tid] + 255) >> 8; int incl = tiles;
#pragma unroll
        for (int o = 1; o < 64; o <<= 1) { const int t = __shfl_up(incl, o); if ((int)F.tid >= o) incl += t; }
        tstart[F.tid] = incl - tiles;
        if (F.tid == 63) { tstart[64] = incl; tstart[65] = incl + NT / 256; } }
    LDS_WAIT(); __syncthreads();
}

DI void topk_phase(const Frame& F, KArgs a, int l) {
    unsigned char* ws = F.ws; int tid_ = F.tid; asm volatile("" : "+v"(tid_)); const int tid = tid_, lane = tid & 63, wave = F.wave;
    constexpr int TPI = 132;
    LAS int* hist = (LAS int*)F.lds; LAS int* base = hist + 64; LAS int* selL = hist + 128; LAS float* gateL = (LAS float*)(hist + 128 + TPI * 6);
    const float* LOGI = (const float*)(ws + WS_LOG); const float bias = a->in[23][l * 64 + lane];
    int* LIST = (int*)(ws + WS_LIST); float* GATES = (float*)(ws + WS_GLIST); int* POS = (int*)(ws + WS_POS);
    unsigned* ecnt = F.ctl + CW_ECNT + l * 64;
    for (int item = F.vcu; item < NT / TPI; item += F.G) {
        if (tid < 64) hist[tid] = 0;
        LDS_WAIT(); __syncthreads();
        const int t0 = (wave < 4) ? wave * 17 : 68 + (wave - 4) * 16, nt = (wave < 4) ? 17 : 16;
        float lg[17];
#pragma unroll
        for (int tl = 0; tl < 17; ++tl) { const int tokl = t0 + ((tl < nt) ? tl : 0); lg[tl] = LOGI[(size_t)(item * TPI + tokl) * 64 + lane]; }
#pragma unroll
        for (int tl = 0; tl < 17; ++tl) {
            if (tl < nt) {
            const int tokl = t0 + tl;
            const float score = sigmoidf(lg[tl]);
            float val = score + bias; int mye = 0; float mys = 0.f, ssum = 0.f;
#pragma unroll
            for (int k = 0; k < TOPK; ++k) {
                float v = val; int i = lane;
#pragma unroll
                for (int st = 0; st < 6; ++st) { float ov; int oi;
                    if (st == 0) { ov = dpp_x1(v); oi = dpp_x1i(i); } else if (st == 1) { ov = dpp_x2(v); oi = dpp_x2i(i); } else if (st == 2) { ov = dpp_m8(v); oi = dpp_m8i(i); }
                    else if (st == 3) { ov = dpp_m16(v); oi = dpp_m16i(i); } else if (st == 4) { ov = __shfl_xor(v, 16); oi = __shfl_xor(i, 16); } else { ov = __shfl_xor(v, 32); oi = __shfl_xor(i, 32); }
                    if (ov > v || (ov == v && oi < i)) { v = ov; i = oi; } }
                const float sk = __shfl(score, i); ssum += sk;
                if (lane == k) { mye = i; mys = sk; }
                if (lane == i) val = -INFINITY;
            }
            if (lane < TOPK) { const int rank = __hip_atomic_fetch_add(&hist[mye], 1, __ATOMIC_RELAXED, __HIP_MEMORY_SCOPE_WORKGROUP); selL[tokl * 6 + lane] = mye | (rank << 8); gateL[tokl * 6 + lane] = mys / ssum * 2.5f; }
            }
        }
        LDS_WAIT(); __syncthreads();
        if (tid < 64) { const int hcnt = hist[tid]; base[tid] = hcnt ? (int)__hip_atomic_fetch_add(ecnt + tid, (unsigned)hcnt, __ATOMIC_RELAXED, __HIP_MEMORY_SCOPE_AGENT) : 0; }
        LDS_WAIT(); __syncthreads();
        for (int idx = tid; idx < TPI * 6; idx += 512) { const int tokl = idx / 6, k = idx % 6, sv = selL[idx], e = sv & 0xff, slot = base[e] + (sv >> 8), row = item * TPI + tokl;
            LIST[(size_t)e * NT + slot] = row; ((float*)(ws + WS_SAL))[(size_t)e * NT + slot] = ((const float*)(ws + WS_SA))[row]; GATES[(size_t)row * 8 + k] = gateL[idx]; POS[(size_t)row * 8 + k] = (e << 16) | slot; }
        LDS_WAIT(); __syncthreads();
    }
}

DI void combine_phase(const Frame& F, KArgs a, int l) {
    unsigned char* ws = F.ws; int lane_ = F.lane; asm volatile("" : "+v"(lane_)); const int lane = lane_;
    const LAS int* tstart = (const LAS int*)(F.MISC + 16);
    const bf16_t* Y = (const bf16_t*)(ws + WS_BIG); const int* POS = (const int*)(ws + WS_POS); const float* GATES = (const float*)(ws + WS_GLIST);
    bf16_t* X = (bf16_t*)(ws + WS_X); const float* mod = (const float*)(F.ctl + CW_MOD) + (size_t)l * 5 * 6144;
    const int gw = F.vcu * 8 + F.wave, NGW = F.G * 8;
    const int sbase = tstart[64] * 256;
    u32x4 pw0, pw1, gw0, gw1;
    if (gw < NT) { pw0 = *(const u32x4*)(POS + (size_t)gw * 8); pw1 = *(const u32x4*)(POS + (size_t)gw * 8 + 4); gw0 = *(const u32x4*)(GATES + (size_t)gw * 8); gw1 = *(const u32x4*)(GATES + (size_t)gw * 8 + 4); }
    for (int row = gw; row < NT; row += NGW) {
        const int b = row / TPB, i = row % TPB; const bool isctx = i < CTXL;
        const u32x4 cp0 = pw0, cp1 = pw1, cg0 = gw0, cg1 = gw1;
        { const int nrow = (row + NGW < NT) ? row + NGW : row;
          pw0 = *(const u32x4*)(POS + (size_t)nrow * 8); pw1 = *(const u32x4*)(POS + (size_t)nrow * 8 + 4); gw0 = *(const u32x4*)(GATES + (size_t)nrow * 8); gw1 = *(const u32x4*)(GATES + (size_t)nrow * 8 + 4); }
        if (l == 1 && isctx) continue;
        const float* md = mod + (size_t)(isctx ? 4 : b) * 6144;
        int pr[7]; float gt[7];
        { const unsigned pv[6] = {cp0.x, cp0.y, cp0.z, cp0.w, cp1.x, cp1.y}; const unsigned gvv[6] = {cg0.x, cg0.y, cg0.z, cg0.w, cg1.x, cg1.y};
#pragma unroll
          for (int k = 0; k < 6; ++k) { const int p = (int)pv[k]; pr[k] = tstart[p >> 16] * 256 + (p & 0xffff); gt[k] = __builtin_bit_cast(float, gvv[k]); } }
        pr[6] = sbase + row; gt[6] = 1.f;
        float xo[2][8];
#pragma unroll
        for (int j = 0; j < 2; ++j) { const int col = 8 * lane + 512 * j; float acc[8];
#pragma unroll
            for (int q = 0; q < 8; ++q) acc[q] = 0.f;
#pragma unroll
            for (int k = 0; k < 7; ++k) { float y[8]; unpack8(__builtin_nontemporal_load((const u32x4*)(Y + (size_t)pr[k] * DM + col)), y);
#pragma unroll
                for (int q = 0; q < 8; ++q) acc[q] += gt[k] * y[q]; }
            float xr[8], g5[8]; unpack8(__builtin_nontemporal_load((const u32x4*)(X + (size_t)row * DM + col)), xr); loadf8(md + 5 * DM + col, g5);
#pragma unroll
            for (int q = 0; q < 8; ++q) xo[j][q] = xr[q] + g5[q] * acc[q]; }
        if (l == 0) {
            float ss = 0.f;
#pragma unroll
            for (int j = 0; j < 2; ++j) { store8(X + (size_t)row * DM + 8 * lane + 512 * j, xo[j]);
#pragma unroll
                for (int q = 0; q < 8; ++q) ss += xo[j][q] * xo[j][q]; }
            const float r = rsqrtf(wave_sum(ss) * (1.f / DM) + EPS);
            const float* md1 = (const float*)(F.ctl + CW_MOD) + (size_t)5 * 6144 + (size_t)(isctx ? 4 : b) * 6144; const float* g1 = a->in[6] + DM;
            float mxo = 0.f;
#pragma unroll
            for (int j = 0; j < 2; ++j) { const int col = 8 * lane + 512 * j; float gg[8], sh[8], sc[8]; loadf8(g1 + col, gg); loadf8(md1 + col, sh); loadf8(md1 + DM + col, sc);
#pragma unroll
                for (int q = 0; q < 8; ++q) { xo[j][q] = xo[j][q] * r * gg[q] * (1.f + sc[q]) + sh[q]; mxo = fmaxf(mxo, fabsf(xo[j][q])); } }
            mxo = wave_max(mxo); const float inv = mxo > 0.f ? 127.f / mxo : 0.f;
#pragma unroll
            for (int j = 0; j < 2; ++j) { u32x2 w; w.x = q8pack(xo[j][0], xo[j][1], xo[j][2], xo[j][3], inv); w.y = q8pack(xo[j][4], xo[j][5], xo[j][6], xo[j][7], inv);
                *(u32x2*)(ws + WS_H8 + (size_t)row * DM + 8 * lane + 512 * j) = w; }
            if (lane == 0) ((float*)(ws + WS_SA))[row] = mxo * (1.f / 127.f);
        } else {
            float* op = a->out + ((size_t)b * SEQ + (i - CTXL)) * DM;
#pragma unroll
            for (int j = 0; j < 2; ++j) { f32x4* xp = (f32x4*)(op + 8 * lane + 512 * j); xp[0] = (f32x4){xo[j][0], xo[j][1], xo[j][2], xo[j][3]}; xp[1] = (f32x4){xo[j][4], xo[j][5], xo[j][6], xo[j][7]}; }
        }
    }
}
#ifndef DBG_PHASES
#define DBG_PHASES 0
#endif
constexpr int NPHASES = 2 + 24;
DI KArgs kargs() { KArgs ap = (KArgs)__builtin_amdgcn_kernarg_segment_ptr(); asm volatile("" : "+s"(ap)); return ap; }
DI Frame make_frame() {
    Frame F; int tid = tidx(); asm volatile("" : "+v"(tid)); int bx = blockIdx.x, G = gridDim.x; asm volatile("" : "+s"(bx), "+s"(G));
    F.lds = (LAS unsigned char*)lds_raw; F.MISC = (volatile LAS unsigned*)(F.lds + MISC_OFF);
    F.tid = tid; F.lane = tid & 63; F.wave = __builtin_amdgcn_readfirstlane(tid >> 6);
    F.G = G; F.vcu = (G % 8 == 0) ? (bx % 8) * (G / 8) + bx / 8 : bx; F.bx = bx;
    F.ws = kargs()->ws; F.ctl = (unsigned*)(F.ws + WS_CTL);
    return F;
}
#ifndef PH_MASK
#define PH_MASK 0xFFFFFFFFu
#endif
#define PHON(j) (((PH_MASK) >> (j)) & 1u)
#ifndef DUP_MASK
#define DUP_MASK 0u
#endif
#ifndef DUP_L
#define DUP_L 0
#endif
#define NREP(j) ((((DUP_MASK) >> (j)) & 1u) && l == DUP_L ? 2 : 1)
__global__ void __launch_bounds__(512, 2) mega_fwd(Args args) {
    { LAS unsigned* m = (LAS unsigned*)(lds_raw + MISC_OFF); for (int u = threadIdx.x; u < (LDS_BYTES - MISC_OFF) / 4; u += 512) m[u] = 0u; }
    __syncthreads();
    if ((threadIdx.x & 63) == 0) *(volatile LAS int*)(lds_raw + TIDTAB_OFF + 4 * hw_wave_slot()) = (int)(threadIdx.x >> 6);
    __syncthreads();
    const int lo = args.ph_lo, hi = args.ph_hi;
    if (hi - lo > 1) { const Frame F = make_frame(); (void)xcd_barrier_post(F.ctl + CW_BAR, F.MISC); }
#define IN(k) (lo <= (k) && (k) < hi)
#define SEAM(k) do { if (IN(k) && IN((k) + 1)) { const Frame Fb = make_frame(); XcdBarrier bar; bar.bar = Fb.ctl + CW_BAR; bar.x = xb_xcc_id(); bar.st = Fb.MISC; xcd_barrier(bar); } } while (0)
#define SEAMX() do { const Frame Fb = make_frame(); XcdBarrier bar; bar.bar = Fb.ctl + CW_BAR; bar.x = xb_xcc_id(); bar.st = Fb.MISC; xcd_barrier(bar); } while (0)
    if (PHON(0) && IN(0)) { for (int rep = 0; rep < ((DUP_MASK & 1u) ? 2 : 1); ++rep) { if (rep) SEAMX(); const Frame F = make_frame(); p0_prologue(F, kargs()); } } SEAM(0);
    if (PHON(1) && IN(1)) {
        const Frame F = make_frame(); KArgs A_ = kargs(); const int gw = F.vcu * 8 + F.wave, NGW = F.G * 8; bf16_t* H = (bf16_t*)(F.ws + WS_H); const float* modall = (const float*)(F.ctl + CW_MOD);
        for (int row = gw; row < NT; row += NGW) { const int b = row / TPB, i = row % TPB; const float* md = modall + (size_t)(i < CTXL ? 4 : b) * 6144;
            norm_row(resid_row_l0(A_, row), A_->in[6], md, md + DM, (unsigned*)(F.ws + WS_H8 + (size_t)row * DM), (float*)(F.ws + WS_SA) + row, F.lane); }
        for (int r = gw; r < 2 * 896; r += NGW) fold_quant_row(F.ws, F.ctl, r, F.lane);
    } SEAM(1);
#pragma unroll
    for (int l = 0; l < 2; ++l) {
        const int pb = 2 + 12 * l;
        if (PHON(2) && IN(pb + 0)) { for (int rep = 0; rep < NREP(2); ++rep) { if (rep) SEAMX();
            const Frame F = make_frame(); unsigned char* ws = F.ws;
            pg8::SchedDense S{(const char*)(ws + WS_H8), (const char*)(ws + WS_WIN + l * WIN8_L), DM / 2, NT / 256, NP / 256, F.G, F.bx, false};
            pg8::EpiPI8 E{(bf16_t*)(ws + B_P), NP, (const float*)(ws + WS_SA), (const unsigned*)(F.ctl + CW_CMAXW) + l * NP};
            pg8::gemm_phase<pg8::EpiPI8, pg8::SchedDense, false, 0, true>(F.lds, DM / 2, S, E);
        } } SEAM(pb + 0);
        if (PHON(3) && IN(pb + 1)) { for (int rep = 0; rep < NREP(3); ++rep) { if (rep) SEAMX(); const Frame F = make_frame(); prep_phase(F, kargs(), l, rep); } } SEAM(pb + 1);
        if (PHON(4) && IN(pb + 2)) { for (int rep = 0; rep < NREP(4); ++rep) { if (rep) SEAMX(); const Frame F = make_frame(); gdn_chunk_phase(F, kargs(), l); } } SEAM(pb + 2);
        if (PHON(5) && IN(pb + 3)) { for (int rep = 0; rep < NREP(5); ++rep) { if (rep) SEAMX(); const Frame F = make_frame(); attn_phase(F, kargs(), l, rep); } } SEAM(pb + 3);
#ifdef EXTRA_BARS
        if (l == 0 && IN(pb + 5)) { for (int xb = 0; xb < EXTRA_BARS; ++xb) SEAMX(); }
#endif
        if (PHON(7) && IN(pb + 5)) { for (int rep = 0; rep < NREP(7); ++rep) { if (rep) SEAMX();
            const Frame F = make_frame(); unsigned char* ws = F.ws; KArgs A_ = kargs();
            pg8::SchedDense S{(const char*)(ws + WS_MIX), (const char*)(ws + WS_WOUT + l * (size_t)DM * DM), DM / 2, (l == 0) ? NT / 256 : 128, 4, F.G, F.bx, l == 1};
            pg8::EpiResidF8 E{A_->in[0], A_->in[2], (bf16_t*)(ws + WS_X), (const float*)(F.ctl + CW_MOD) + (size_t)l * 5 * 6144, l == 0 ? 1 : 0, (const float*)(F.ctl + CW_CMAXO) + l * DM};
            pg8::gemm_phase<pg8::EpiResidF8, pg8::SchedDense, false, 0, 2>(F.lds, DM / 2, S, E);
        } } SEAM(pb + 5);
        if (PHON(8) && IN(pb + 6)) { for (int rep = 0; rep < NREP(8); ++rep) { if (rep) SEAMX();
            const Frame F = make_frame(); const int gw = F.vcu * 8 + F.wave, NGW = F.G * 8; const float* g2 = kargs()->in[7] + l * DM;
            const bf16_t* X = (const bf16_t*)(F.ws + WS_X); bf16_t* H = (bf16_t*)(F.ws + WS_H); const float* mod = (const float*)(F.ctl + CW_MOD) + (size_t)l * 5 * 6144;
            for (int row = gw; row < NT; row += NGW) { const int b = row / TPB, i = row % TPB; const float* md = mod + (size_t)(i < CTXL ? 4 : b) * 6144;
                norm_row_q(X + (size_t)row * DM, g2, md + 3 * DM, md + 4 * DM, H + (size_t)row * DM, (unsigned*)(F.ws + WS_H8 + (size_t)row * DM), (float*)(F.ws + WS_SA) + row, F.lane); }
        } } SEAM(pb + 6);
        if (PHON(9) && IN(pb + 7)) { for (int rep = 0; rep < NREP(9); ++rep) { if (rep) SEAMX();
            const Frame F = make_frame(); unsigned char* ws = F.ws;
            pg8::SchedDense S{(const char*)(ws + WS_H), (const char*)(ws + WS_WR + l * WR_L), DM, NT / 256, 1, F.G, F.bx, false};
            pg8::EpiRouter E{(float*)(ws + WS_LOG)};
            pg8::gemm_phase<pg8::EpiRouter, pg8::SchedDense, false, 0>(F.lds, DM, S, E);
        } } SEAM(pb + 7);
        if (PHON(10) && IN(pb + 8)) { for (int rep = 0; rep < NREP(10); ++rep) { if (rep) SEAMX(); const Frame F = make_frame(); topk_phase(F, kargs(), l); } } SEAM(pb + 8);
        if (PHON(11) && IN(pb + 9)) { for (int rep = 0; rep < NREP(11); ++rep) { if (rep) SEAMX();
            const Frame F = make_frame(); unsigned char* ws = F.ws;
            moe_tables(F, l);
            pg8::SchedMoE<3> S{(const LAS int*)(F.MISC + 16), (const LAS int*)(F.MISC + 96), (const char*)(ws + WS_H8), (const char*)(ws + WS_WGU + l * WGU8_L), DM / 2, F.G, F.vcu, (int)WGU8_E, true};
            pg8::EpiSwigluI8F8 E{(unsigned char*)(ws + WS_ACT), (const float*)(ws + WS_SAL), (const float*)(ws + WS_SA), (const unsigned*)(F.ctl + CW_CMAX) + l * 65 * 768};
            pg8::gemm_phase<pg8::EpiSwigluI8F8, pg8::SchedMoE<3>, true, NT, 1>(F.lds, DM / 2, S, E, (const int*)(ws + WS_LIST), NT);
        } } SEAM(pb + 9);
        if (PHON(12) && IN(pb + 10)) { for (int rep = 0; rep < NREP(12); ++rep) { if (rep) SEAMX();
            const Frame F = make_frame(); unsigned char* ws = F.ws;
            moe_tables(F, l);
            pg8::SchedMoE<4> S{(const LAS int*)(F.MISC + 16), (const LAS int*)(F.MISC + 96), (const char*)(ws + WS_ACT), (const char*)(ws + WS_WD + l * WD_L), 256, F.G, F.vcu, (int)WD_E, false};
            pg8::EpiPF8 E{(bf16_t*)(ws + WS_BIG), DM, (const float*)(ws + WS_SD) + (size_t)l * 65 * DM};
            pg8::gemm_phase<pg8::EpiPF8, pg8::SchedMoE<4>, false, 0, 2>(F.lds, 256, S, E);
        } } SEAM(pb + 10);
        if (PHON(13) && IN(pb + 11)) { for (int rep = 0; rep < NREP(13); ++rep) { if (rep) SEAMX(); const Frame F = make_frame(); moe_tables(F, l); combine_phase(F, kargs(), l); } } SEAM(pb + 11);
    }
    if (IN(NPHASES)) {
        const Frame F = make_frame(); const int gw = F.vcu * 8 + F.wave, NGW = F.G * 8; const bf16_t* X = (const bf16_t*)(F.ws + WS_X); float* out = kargs()->out;
        for (int row = gw; row < NT; row += NGW) { const int b = row / TPB, i = row % TPB; if (i < CTXL) continue;
            const u32x2* s = (const u32x2*)(X + (size_t)row * DM); f32x4* d = (f32x4*)(out + ((size_t)b * SEQ + i - CTXL) * DM);
#pragma unroll
            for (int j = 0; j < 4; ++j) { const u32x2 w = s[F.lane + 64 * j]; d[F.lane + 64 * j] = (f32x4){bflo(w.x), bfhi(w.x), bflo(w.y), bfhi(w.y)}; } }
    }
#undef IN
#undef SEAM
}

#ifndef N_LAUNCH_MODE
#define N_LAUNCH_MODE 0
#endif
extern "C" void kernel_launch(void* const* d_in, const int* in_sizes, int n_in, void* d_out, int out_size, void* d_ws, size_t ws_size, hipStream_t stream) {
    static int grid = 0;
    if (grid == 0) {
        if (n_in != 28 || ws_size < WS_END) { fprintf(stderr, "kernel_launch: need 28 inputs and %zu bytes of workspace (got %d, %zu)\n", (size_t)WS_END, n_in, ws_size); grid = -1; return; }
        int dev = 0, cus = 0, per_cu = 0;
        if (hipGetDevice(&dev) != hipSuccess || hipDeviceGetAttribute(&cus, hipDeviceAttributeMultiprocessorCount, dev) != hipSuccess) { grid = -1; return; }
        if (hipFuncSetAttribute((const void*)mega_fwd, hipFuncAttributeMaxDynamicSharedMemorySize, LDS_BYTES) != hipSuccess) { fprintf(stderr, "kernel_launch: hipFuncSetAttribute failed\n"); grid = -1; return; }
        if (hipOccupancyMaxActiveBlocksPerMultiprocessor(&per_cu, (const void*)mega_fwd, 512, LDS_BYTES) != hipSuccess || per_cu < 1) { fprintf(stderr, "kernel_launch: occupancy query says %d\n", per_cu); }
        (void)hipGetLastError();
        grid = cus;
    }
    if (grid < 0) return;
    (void)hipMemsetAsync((char*)d_ws + WS_CTL, 0, CTL_ZERO_BYTES, stream);
    Args a{};
    for (int i = 0; i < 28; ++i) a.in[i] = (const float*)d_in[i];
    a.out = (float*)d_out; a.ws = (unsigned char*)d_ws;
#if N_LAUNCH_MODE == 0
    a.ph_lo = 0; a.ph_hi = NPHASES;
    hipLaunchKernelGGL(mega_fwd, dim3(grid), dim3(512), LDS_BYTES, stream, a);
#else
    const int np = DBG_PHASES > 0 ? DBG_PHASES : NPHASES;
    for (int p = 0; p < np; ++p) { a.ph_lo = p; a.ph_hi = p + 1; hipLaunchKernelGGL(mega_fwd, dim3(grid), dim3(512), LDS_BYTES, stream, a); }
    if (DBG_PHASES > 0) { a.ph_lo = NPHASES; a.ph_hi = NPHASES + 1; hipLaunchKernelGGL(mega_fwd, dim3(grid), dim3(512), LDS_BYTES, stream, a); }
#endif
}
```

```cpp
#define N_LAUNCH_MODE 0
#include <hip/hip_runtime.h>
#include <cstdio>
#include <cstdint>
#define LAS __attribute__((address_space(3)))
#define GAS __attribute__((address_space(1)))
typedef unsigned short bf16_t;
typedef short bf16x8 __attribute__((ext_vector_type(8)));
typedef float f32x4 __attribute__((ext_vector_type(4)));
typedef float f32x2 __attribute__((ext_vector_type(2)));
typedef float f32x16 __attribute__((ext_vector_type(16)));
typedef unsigned u32x4 __attribute__((ext_vector_type(4)));
typedef unsigned u32x2 __attribute__((ext_vector_type(2)));
typedef __bf16 bf16x2_t __attribute__((ext_vector_type(2)));
#define DI __device__ __forceinline__
extern __shared__ __attribute__((aligned(16))) unsigned char lds_raw[];
constexpr int TIDTAB_OFF = 131072 + 1024;
DI int hw_wave_slot() { return (int)__builtin_amdgcn_s_getreg(((6 - 1) << 11) | 4) & 63; }
DI int tidx() { int w = *(const LAS int*)(lds_raw + TIDTAB_OFF + 4 * hw_wave_slot()); asm volatile("" : "+v"(w)); w = __builtin_amdgcn_readfirstlane(w);
    return (w << 6) | (int)__builtin_amdgcn_mbcnt_hi(~0u, __builtin_amdgcn_mbcnt_lo(~0u, 0u)); }

constexpr int NB = 4, SEQ = 8192, CTXL = 256, DM = 1024, TPB = SEQ + CTXL  , NT = NB * TPB  ;
constexpr int NP = 3584;
constexpr int NEXP = 64, TOPK = 6, DEXP = 384;
constexpr float EPS = 1e-6f;
constexpr int KT_PER_B = TPB / 64;
constexpr int C_GQ = 0, C_GK = 256, C_GV = 512, C_GZ = 768, C_SQ = 1024, C_SK = 1280, C_SV = 1408, C_DQ = 1536, C_DK = 1792, C_DV = 1920,
              C_MQN = 2048, C_MQP = 2304, C_MKN = 2432, C_MV = 2688, C_CQ = 2944, C_CKV = 3200, C_KR = 3328, C_GA = 3360, C_GB = 3368, C_END = 3376;
constexpr int R_GQ = 0, R_GK = 256, R_GV = 512, R_GZ = 768, R_GA = 1024, R_GB = 1032, R_CQ = 1040, R_CKV = 1296, R_KR = 1424, R_SQ = 1456, R_SK = 1712, R_SV = 1840,
              R_DQ = 1968, R_DK = 2224, R_DV = 2352, DIN = 2480;

DI unsigned f2bf(float f) { unsigned u = __builtin_bit_cast(unsigned, f); return (u + 0x7fffu + ((u >> 16) & 1u)) >> 16; }
DI unsigned pk2(float lo, float hi) { f32x2 v = {lo, hi}; bf16x2_t b = __builtin_convertvector(v, bf16x2_t); return __builtin_bit_cast(unsigned, b); }
DI float bf2f(unsigned short h) { return __builtin_bit_cast(float, (unsigned)h << 16); }
DI unsigned f8pack(float a, float b, float c, float d) {
    unsigned w = 0u;
    w = __builtin_amdgcn_cvt_pk_fp8_f32(__builtin_amdgcn_fmed3f(a, -448.f, 448.f), __builtin_amdgcn_fmed3f(b, -448.f, 448.f), w, false);
    return __builtin_amdgcn_cvt_pk_fp8_f32(__builtin_amdgcn_fmed3f(c, -448.f, 448.f), __builtin_amdgcn_fmed3f(d, -448.f, 448.f), w, true);
}
DI float bflo(unsigned w) { return __builtin_bit_cast(float, w << 16); }
DI float bfhi(unsigned w) { return __builtin_bit_cast(float, w & 0xffff0000u); }
DI float dpp_x1(float v) { return __builtin_bit_cast(float, __builtin_amdgcn_update_dpp(0, __builtin_bit_cast(int, v), 0xB1, 0xF, 0xF, true)); }
DI float dpp_x2(float v) { return __builtin_bit_cast(float, __builtin_amdgcn_update_dpp(0, __builtin_bit_cast(int, v), 0x4E, 0xF, 0xF, true)); }
DI float dpp_m8(float v) { return __builtin_bit_cast(float, __builtin_amdgcn_update_dpp(0, __builtin_bit_cast(int, v), 0x141, 0xF, 0xF, true)); }
DI float dpp_m16(float v) { return __builtin_bit_cast(float, __builtin_amdgcn_update_dpp(0, __builtin_bit_cast(int, v), 0x140, 0xF, 0xF, true)); }
DI int dpp_x1i(int v) { return __builtin_amdgcn_update_dpp(0, v, 0xB1, 0xF, 0xF, true); }
DI int dpp_x2i(int v) { return __builtin_amdgcn_update_dpp(0, v, 0x4E, 0xF, 0xF, true); }
DI int dpp_m8i(int v) { return __builtin_amdgcn_update_dpp(0, v, 0x141, 0xF, 0xF, true); }
DI int dpp_m16i(int v) { return __builtin_amdgcn_update_dpp(0, v, 0x140, 0xF, 0xF, true); }
DI float wave_sum(float v) {
    v += dpp_x1(v); v += dpp_x2(v); v += dpp_m8(v); v += dpp_m16(v); v += __shfl_xor(v, 16); v += __shfl_xor(v, 32);
    return v;
}
DI float sigmoidf(float x) { return __builtin_amdgcn_rcpf(1.f + __builtin_amdgcn_exp2f(-1.4426950408889634f * x)); }
DI float siluf(float x) { return x * sigmoidf(x); }
#define LDS_WAIT() asm volatile("s_waitcnt lgkmcnt(0)" ::: "memory")
#define VM_WAIT() asm volatile("s_waitcnt vmcnt(0)" ::: "memory")

#define XB_TMO      128
#define XB_XCNT(j)  (256  + 64 * (j))
#define XB_XSUB(j)  (1280 + 64 * (j))
#define XB_XGEN(j)  (2304 + 64 * (j))
#define XB_TOP      3328
#define XB_TOPGEN   3392
#define XCD_BAR_WORDS 3456
#define XB_SPIN_CAP (1u << 18)
DI unsigned xb_ld(unsigned* p)              { return __hip_atomic_load(p, __ATOMIC_RELAXED, __HIP_MEMORY_SCOPE_AGENT); }
DI unsigned xb_add(unsigned* p, unsigned v) { return __hip_atomic_fetch_add(p, v, __ATOMIC_RELAXED, __HIP_MEMORY_SCOPE_AGENT); }
DI unsigned xb_xcc_id() { return (unsigned)__builtin_amdgcn_s_getreg((3 << 11) | 20) & 0xFu; }
#define XB_SPIN(cond, bar) do { unsigned _sp = 0; while (cond) { __builtin_amdgcn_s_sleep(1); \
    if ((++_sp & 255u) == 0u) { if (xb_ld(&(bar)[XB_TMO])) break; if (_sp > XB_SPIN_CAP) { atomicAdd(&(bar)[XB_TMO], 1u); break; } } } } while (0)
struct XcdBarrier { unsigned* bar; unsigned x; volatile LAS unsigned* st; };
DI XcdBarrier xcd_barrier_post(unsigned* bar, volatile LAS unsigned* st) {
    XcdBarrier b; b.bar = bar; b.x = xb_xcc_id(); b.st = st;
    if (tidx() == 0) (void)xb_add(&bar[XB_XCNT(b.x)], 1u);
    return b;
}
DI void xcd_barrier_complete(unsigned* bar, unsigned x, unsigned& nloc, unsigned& nx) {
    const unsigned G = gridDim.x * gridDim.y * gridDim.z;
    unsigned sum, cnt, mine, sp = 0u;
    for (;;) {
        sum = 0u; cnt = 0u; mine = 0u;
#pragma unroll
        for (unsigned j = 0; j < 16; ++j) { const unsigned c = xb_ld(&bar[XB_XCNT(j)]); sum += c; cnt += (c > 0u) ? 1u : 0u; mine = (j == x) ? c : mine; }
        if (sum == G) break;
        __builtin_amdgcn_s_sleep(1);
        if ((++sp & 255u) == 0u) { if (xb_ld(&bar[XB_TMO])) break; if (sp > XB_SPIN_CAP) { atomicAdd(&bar[XB_TMO], 1u); break; } }
    }
    nloc = mine > 0u ? mine : 1u; nx = cnt > 0u ? cnt : 1u;
}
DI void xcd_barrier(const XcdBarrier& b) {
    asm volatile("s_waitcnt vmcnt(0)" ::: "memory");
    __syncthreads();
    if (tidx() == 0) {
        unsigned* bar = b.bar;
        __builtin_amdgcn_s_waitcnt(0);
        unsigned nloc = b.st[0], nx = b.st[1];
        if (nloc == 0u) { xcd_barrier_complete(bar, b.x, nloc, nx); b.st[0] = nloc; b.st[1] = nx; }
        const unsigned old = xb_add(&bar[XB_XSUB(b.x)], 1u);
        const unsigned gen = old / nloc;
        if (old + 1u == (gen + 1u) * nloc) {
            __builtin_amdgcn_fence(__ATOMIC_RELEASE, "agent");
            asm volatile("s_waitcnt vmcnt(0)" ::: "memory");
            const unsigned og = xb_add(&bar[XB_TOP], 1u);
            const unsigned tg = og / nx;
            if (og + 1u == (tg + 1u) * nx) xb_add(&bar[XB_TOPGEN], 1u);
            else XB_SPIN(xb_ld(&bar[XB_TOPGEN]) == tg, bar);
            __builtin_amdgcn_fence(__ATOMIC_ACQUIRE, "agent");
            xb_add(&bar[XB_XGEN(b.x)], 1u);
            asm volatile("s_waitcnt vmcnt(0)" ::: "memory");
        } else {
            XB_SPIN(xb_ld(&bar[XB_XGEN(b.x)]) == gen, bar);
            __builtin_amdgcn_fence(__ATOMIC_ACQUIRE, "agent");
            asm volatile("s_waitcnt vmcnt(0)" ::: "memory");
        }
    }
    __syncthreads();
}

namespace pg8 {
constexpr int BM = 256, BK = 64, HALF = 128, HTB = HALF * BK * 2, STAGE_BYTES = 8 * HTB, NXCD = 8, WGM = 8;
__host__ __device__ __forceinline__ int lds_byte(int r, int c) { const int st = (r >> 4) * 2 + (c >> 5), rr = r & 15, cc = c & 31, ob = rr * 64 + cc * 2; return st * 1024 + (ob ^ (((ob >> 9) & 1) << 5)); }
__host__ __device__ __forceinline__ void stage_rc(int b, int& R, int& C) { const int st = b / 1024, sb = b % 1024, swz = sb ^ (((sb >> 9) & 1) << 5); R = (st >> 1) * 16 + swz / 64; C = (st & 1) * 32 + (swz % 64) / 2; }
__host__ __device__ __forceinline__ int perm32(int rho) { const int n = rho >> 4, i = rho & 15; return 8 * (i >> 2) + 4 * n + (i & 3); }

struct Unit { int pm, pn; const char* A; const char* B; int slot0, cnt, ex; };

DI bool static_tile(int i, int G, int c, int nM, int nN, int& pm, int& pn) {
    const int nwg = nM * nN; const long L = (long)i * G + c; if (L >= nwg) return false;
    int wgid = (int)L; { const int q = nwg / NXCD, r = nwg % NXCD, xcd = wgid % NXCD, off = wgid / NXCD; wgid = (xcd < r ? xcd * (q + 1) : r * (q + 1) + (xcd - r) * q) + off; }
    const int nig = WGM * nN, gid = wgid / nig, fm = gid * WGM, gsz = (nM - fm) < WGM ? (nM - fm) : WGM;
    pm = fm + ((wgid % nig) % gsz); pn = (wgid % nig) / gsz; return true;
}

typedef int i32x4 __attribute__((ext_vector_type(4)));
typedef int i32x8 __attribute__((ext_vector_type(8)));
template <class Epi, class Sched, bool GATHER, int ZROW, int I8 = 0>
DI void gemm_phase(LAS unsigned char* lds, const int K, const Sched& S, const Epi& E, const int* lists = nullptr, int lstride = 0) {
    int tid_ = tidx(); asm volatile("" : "+v"(tid_));
    const int tid = tid_, wid = __builtin_amdgcn_readfirstlane(tid >> 6), lane = tid & 63, wr = wid >> 2, wc = wid & 3, fr = lane & 15, fq = lane >> 4;
    const int nt = K / BK;
    unsigned voffA[2], voffB[2]; int sR[2], sC[2];
#pragma unroll
    for (int i = 0; i < 2; ++i) { int R, C; stage_rc(tid * 16 + i * 8192, R, C); const int Rb = Epi::PERM ? ((R & ~31) + perm32(R & 31)) : R;
        voffA[i] = (unsigned)(R * K + C) * 2u; voffB[i] = (unsigned)(Rb * K + C) * 2u; sR[i] = R; sC[i] = C; }
    const size_t kstep = (size_t)(BK * 2);
    const size_t hstep = (size_t)HALF * K * 2;
    const unsigned ldsw = (unsigned)wid * 1024u;
    const int aoff = lds_byte(wr * 64 + fr, fq * 8), boff = lds_byte(wc * 32 + fr, fq * 8);
    unsigned vAc[2][2], vAn[2][2];
#define PG8_SA(b, h) (((b) * 2 + (h)) * HTB)
#define PG8_SB(b, h) ((4 + (b) * 2 + (h)) * HTB)
#define PG8_STAGE2(bufoff, gbase, o0, o1) do { \
        __builtin_amdgcn_global_load_lds((const unsigned*)((const char*)(gbase) + (o0)), (LAS unsigned*)(lds + (bufoff) + ldsw), 16, 0, 0); \
        __builtin_amdgcn_global_load_lds((const unsigned*)((const char*)(gbase) + (o1)), (LAS unsigned*)(lds + (bufoff) + ldsw + 8192), 16, 0, 0); } while (0)
#define PG8_STAGE(bufoff, gbase, voff) PG8_STAGE2(bufoff, gbase, (voff)[0], (voff)[1])
#define PG8_STAGE_A(bufoff, p, h, NX) do { if constexpr (GATHER) { const unsigned _o0 = (NX) ? vAn[h][0] : vAc[h][0], _o1 = (NX) ? vAn[h][1] : vAc[h][1]; PG8_STAGE2(bufoff, p, _o0, _o1); } \
        else { PG8_STAGE(bufoff, (p) + (h) * hstep, voffA); } } while (0)
#define PG8_LD8(p) __builtin_shufflevector(*(const LAS i32x4*)(p), *(const LAS i32x4*)((p) + 1024), 0, 1, 2, 3, 4, 5, 6, 7)
#define PG8_LDA(dst, b, h) do { if constexpr (I8 == 2) { _Pragma("unroll") for (int m = 0; m < 4; ++m) dst##_8[m] = PG8_LD8(lds + PG8_SA(b, h) + aoff + m * 2048); } \
        else { _Pragma("unroll") for (int m = 0; m < 4; ++m) _Pragma("unroll") for (int k = 0; k < 2; ++k) dst[m][k] = *(const LAS bf16x8*)(lds + PG8_SA(b, h) + aoff + m * 2048 + k * 1024); } } while (0)
#define PG8_LDB(dst, b, h) do { if constexpr (I8 == 2) { _Pragma("unroll") for (int n = 0; n < 2; ++n) dst##_8[n] = PG8_LD8(lds + PG8_SB(b, h) + boff + n * 2048); } \
        else { _Pragma("unroll") for (int n = 0; n < 2; ++n) _Pragma("unroll") for (int k = 0; k < 2; ++k) dst[n][k] = *(const LAS bf16x8*)(lds + PG8_SB(b, h) + boff + n * 2048 + k * 1024); } } while (0)
#define PG8_MMA(ai, bj, At, Bt) do { __builtin_amdgcn_s_setprio(1); _Pragma("unroll") for (int m = 0; m < 4; ++m) _Pragma("unroll") for (int n = 0; n < 2; ++n) { \
        if constexpr (I8 == 2) asm volatile("v_mfma_f32_16x16x128_f8f6f4 %0, %1, %2, %0" : "+v"(acc[ai][bj][m][n]) : "v"(Bt##_8[n]), "v"(At##_8[m]));     \
        else { _Pragma("unroll") for (int k = 0; k < 2; ++k) \
        { if constexpr (I8 == 1) acc[ai][bj][m][n] = __builtin_bit_cast(f32x4, __builtin_amdgcn_mfma_i32_16x16x64_i8(__builtin_bit_cast(i32x4, Bt[n][k]), __builtin_bit_cast(i32x4, At[m][k]), __builtin_bit_cast(i32x4, acc[ai][bj][m][n]), 0, 0, 0)); \
          else acc[ai][bj][m][n] = __builtin_amdgcn_mfma_f32_16x16x32_bf16(Bt[n][k], At[m][k], acc[ai][bj][m][n], 0, 0, 0); } } } __builtin_amdgcn_s_setprio(0); } while (0)
#define PG8_WAIT_V(n) asm volatile("s_waitcnt vmcnt(" #n ")" ::: "memory")
#define PG8_WAIT_L(n) asm volatile("s_waitcnt lgkmcnt(" #n ")" ::: "memory")
#define PG8_BAR __builtin_amdgcn_s_barrier()
#define PG8_SCHED __builtin_amdgcn_sched_barrier(0)
#define PG8_ROWS(u, v) do { if constexpr (GATHER) { _Pragma("unroll") for (int _h = 0; _h < 2; ++_h) _Pragma("unroll") for (int _i = 0; _i < 2; ++_i) { \
        const int _slot = (u).slot0 + sR[_i] + 128 * _h; const int _cl = (_slot < (u).cnt) ? _slot : (u).cnt - 1; int _idx = ((u).ex >= 0) ? lists[(size_t)(u).ex * lstride + _cl] : _cl; if (_slot >= (u).cnt) _idx = ZROW; \
        v[_h][_i] = (unsigned)_idx * (unsigned)(K * 2) + (unsigned)(sC[_i] * 2); } } } while (0)
    Unit cur, nxt; int ui = 0;
    if (!S.next(0, cur)) return;
    f32x4 acc[2][2][4][2];
#pragma unroll
    for (int a = 0; a < 2; ++a)
#pragma unroll
        for (int b = 0; b < 2; ++b)
#pragma unroll
            for (int m = 0; m < 4; ++m)
#pragma unroll
                for (int n = 0; n < 2; ++n) acc[a][b][m][n] = (f32x4){0.f, 0.f, 0.f, 0.f};
    bf16x8 At[4][2], B0[2][2], B1[2][2]; i32x8 At_8[4], B0_8[2], B1_8[2];
    const char* cA = cur.A; const char* cB = cur.B;
    PG8_ROWS(cur, vAc);
    PG8_STAGE(PG8_SB(0, 0), cB, voffB); PG8_STAGE(PG8_SB(0, 1), cB + hstep, voffB); PG8_STAGE_A(PG8_SA(0, 0), cA, 0, false); PG8_STAGE_A(PG8_SA(0, 1), cA, 1, false);
    if (wr == 1) PG8_BAR;
    PG8_WAIT_V(2); PG8_BAR;
    PG8_STAGE(PG8_SB(1, 0), cB + kstep, voffB); PG8_STAGE_A(PG8_SA(1, 0), cA + kstep, 0, false); PG8_STAGE(PG8_SB(1, 1), cB + hstep + kstep, voffB);
    PG8_WAIT_V(6); PG8_BAR;
    for (;;) {
        const bool has_next = S.next(ui + 1, nxt);
        const char* nA = has_next ? nxt.A : cA; const char* nB = has_next ? nxt.B : cB;
        if constexpr (GATHER) { if (has_next) { PG8_ROWS(nxt, vAn); } else {
#pragma unroll
            for (int h = 0; h < 2; ++h) { vAn[h][0] = vAc[h][0]; vAn[h][1] = vAc[h][1]; } } }
#pragma unroll 1
        for (int t = 0; t < nt; t += 2) {
            const bool last = (t == nt - 2);
            const char* a1 = cA + (size_t)(t + 1) * kstep;
            const char* a2 = last ? nA : cA + (size_t)(t + 2) * kstep; const char* b2 = last ? nB : cB + (size_t)(t + 2) * kstep;
            const char* a3 = a2 + kstep; const char* b3 = b2 + kstep;
            PG8_LDB(B0, 0, 0); PG8_LDB(B1, 0, 1); PG8_SCHED; PG8_LDA(At, 0, 0); PG8_STAGE_A(PG8_SA(1, 1), a1, 1, false);
            PG8_WAIT_V(8); PG8_WAIT_L(0); PG8_BAR; PG8_MMA(0, 0, At, B0); PG8_MMA(0, 1, At, B1); PG8_BAR; PG8_SCHED;
            PG8_LDA(At, 0, 1); PG8_STAGE(PG8_SB(0, 0), b2, voffB); PG8_STAGE(PG8_SB(0, 1), b2 + hstep, voffB); PG8_STAGE_A(PG8_SA(0, 0), a2, 0, last);
            PG8_WAIT_V(8); PG8_WAIT_L(0); PG8_BAR; PG8_MMA(1, 0, At, B0); PG8_MMA(1, 1, At, B1); PG8_BAR; PG8_SCHED;
            PG8_LDB(B0, 1, 0); PG8_LDB(B1, 1, 1); PG8_SCHED; PG8_LDA(At, 1, 0); PG8_STAGE_A(PG8_SA(0, 1), a2, 1, last);
            PG8_WAIT_V(8); PG8_WAIT_L(0); PG8_BAR; PG8_MMA(0, 0, At, B0); PG8_MMA(0, 1, At, B1); PG8_BAR; PG8_SCHED;
            PG8_LDA(At, 1, 1); PG8_STAGE(PG8_SB(1, 0), b3, voffB); PG8_STAGE(PG8_SB(1, 1), b3 + hstep, voffB); PG8_STAGE_A(PG8_SA(1, 0), a3, 0, last);
            PG8_WAIT_V(8); PG8_WAIT_L(0); PG8_BAR; PG8_MMA(1, 0, At, B0); PG8_MMA(1, 1, At, B1); PG8_BAR; PG8_SCHED;
        }
        if constexpr (I8 == 2) asm volatile("s_nop 15\n\ts_nop 15" ::: "memory");
        if (wr == 0) PG8_BAR;
        E(acc, cur, wr, wc, fr, fq);
        if (!has_next) break;
#pragma unroll
        for (int a = 0; a < 2; ++a)
#pragma unroll
            for (int b = 0; b < 2; ++b)
#pragma unroll
                for (int m = 0; m < 4; ++m)
#pragma unroll
                    for (int n = 0; n < 2; ++n) acc[a][b][m][n] = (f32x4){0.f, 0.f, 0.f, 0.f};
        cur = nxt; cA = nA; cB = nB; ++ui;
        if constexpr (GATHER) {
#pragma unroll
            for (int h = 0; h < 2; ++h) { vAc[h][0] = vAn[h][0]; vAc[h][1] = vAn[h][1]; } }
        if (wr == 1) PG8_BAR;
    }
    PG8_WAIT_V(0);
    PG8_BAR;
#undef PG8_SA
#undef PG8_SB
#undef PG8_STAGE
#undef PG8_STAGE2
#undef PG8_STAGE_A
#undef PG8_LDA
#undef PG8_LD8
#undef PG8_LDB
#undef PG8_MMA
#undef PG8_WAIT_V
#undef PG8_WAIT_L
#undef PG8_BAR
#undef PG8_SCHED
#undef PG8_ROWS
}
}
namespace pg8 {
DI int rfl(int v) { return __builtin_amdgcn_readfirstlane(v); }
struct SchedDense {
    const char* A; const char* Bt; int K, nM, nN, G, c; bool lat_only;
    DI bool next(int i, Unit& u) const {
        int pm, pn; if (!static_tile(i, G, c, nM, nN, pm, pn)) return false;
        if (lat_only) pm = (pm >> 5) * 33 + 1 + (pm & 31);
        u.pm = pm; u.pn = pn; u.A = A + (size_t)pm * 256 * K * 2; u.B = Bt + (size_t)pn * 256 * K * 2; u.slot0 = 0; u.cnt = 0; u.ex = 0; return true;
    }
};
template <int NCOL> struct SchedMoE {
    const LAS int* tstart; const LAS int* ecnt;
    const char* A; const char* Bt; int K, G, c, browbytes;
    bool gather;
    DI bool next(int i, Unit& u) const {
        const int TT = rfl(tstart[65]); unsigned L = (unsigned)(i * G + c);
#if defined(G1_REP) || defined(G2_REP)
        { const unsigned rep_ = (NCOL == 3) ? G1_REP : G2_REP; if (L >= (unsigned)(TT * NCOL) * rep_) return false; L %= (unsigned)(TT * NCOL); }
#else
        if (L >= (unsigned)(TT * NCOL)) return false;
#endif
        const int rt = (int)(L / (unsigned)NCOL), pn = (int)(L % (unsigned)NCOL);
        int e = 0;
#pragma unroll
        for (int stp = 64; stp >= 1; stp >>= 1) { const int c = e + stp; if (c <= 64 && rfl(tstart[c <= 64 ? c : 64]) <= rt) e = c; }
        const int t0 = rfl(tstart[e]);
        u.pm = rt; u.pn = pn; u.ex = (e == 64) ? -1 : e; u.slot0 = (rt - t0) * 256; u.cnt = (e == 64) ? NT : rfl(ecnt[e]);
        u.A = gather ? A : A + (size_t)rt * 256 * K * 2;
        u.B = Bt + (size_t)e * browbytes + (size_t)pn * 256 * K * 2;
        return true;
    }
};

struct EpiP {
    static constexpr bool PERM = true;
    bf16_t* O; int ldc;
    DI void operator()(const f32x4 (&acc)[2][2][4][2], const Unit& u, int wr, int wc, int fr, int fq) const {
        const int row0 = u.pm * BM + wr * 64 + fr, col0 = u.pn * BM + wc * 32 + 8 * fq;
#pragma unroll
        for (int ai = 0; ai < 2; ++ai)
#pragma unroll
            for (int m = 0; m < 4; ++m) { bf16_t* rowp = O + (size_t)(row0 + ai * HALF + m * 16) * ldc + col0;
#pragma unroll
                for (int bj = 0; bj < 2; ++bj) { const f32x4 v0 = acc[ai][bj][m][0], v1 = acc[ai][bj][m][1];
                    u32x4 w; w.x = pk2(v0[0], v0[1]); w.y = pk2(v0[2], v0[3]); w.z = pk2(v1[0], v1[1]); w.w = pk2(v1[2], v1[3]);
                    *(u32x4*)(rowp + bj * HALF) = w; } }
    }
};
struct EpiPF8 {
    static constexpr bool PERM = true;
    bf16_t* O; int ldc; const float* colmax;
    DI void operator()(const f32x4 (&acc)[2][2][4][2], const Unit& u, int wr, int wc, int fr, int fq) const {
        const int row0 = u.pm * BM + wr * 64 + fr, col0 = u.pn * BM + wc * 32 + 8 * fq;
        const float* cm = colmax + (size_t)((u.ex >= 0) ? u.ex : 64) * DM;
        f32x4 sb[2][2];
#pragma unroll
        for (int bj = 0; bj < 2; ++bj) { sb[bj][0] = *(const f32x4*)(cm + col0 + bj * HALF) * (1.f / 448.f); sb[bj][1] = *(const f32x4*)(cm + col0 + bj * HALF + 4) * (1.f / 448.f); }
#pragma unroll
        for (int ai = 0; ai < 2; ++ai)
#pragma unroll
            for (int m = 0; m < 4; ++m) { bf16_t* rowp = O + (size_t)(row0 + ai * HALF + m * 16) * ldc + col0;
#pragma unroll
                for (int bj = 0; bj < 2; ++bj) { const f32x4 v0 = acc[ai][bj][m][0] * sb[bj][0], v1 = acc[ai][bj][m][1] * sb[bj][1];
                    u32x4 w; w.x = pk2(v0[0], v0[1]); w.y = pk2(v0[2], v0[3]); w.z = pk2(v1[0], v1[1]); w.w = pk2(v1[2], v1[3]);
                    *(u32x4*)(rowp + bj * HALF) = w; } }
    }
};
struct EpiPI8 {
    static constexpr bool PERM = true;
    bf16_t* O; int ldc; const float* sa; const unsigned* colmax;
    DI void operator()(const f32x4 (&acc)[2][2][4][2], const Unit& u, int wr, int wc, int fr, int fq) const {
        const int row0 = u.pm * BM + wr * 64 + fr, col0 = u.pn * BM + wc * 32 + 8 * fq;
        f32x4 sb[2][2];
#pragma unroll
        for (int bj = 0; bj < 2; ++bj) { const u32x4 c0 = *(const u32x4*)(colmax + col0 + bj * HALF), c1 = *(const u32x4*)(colmax + col0 + bj * HALF + 4);
            sb[bj][0] = (f32x4){__uint_as_float(c0.x), __uint_as_float(c0.y), __uint_as_float(c0.z), __uint_as_float(c0.w)} * (1.f / 127.f);
            sb[bj][1] = (f32x4){__uint_as_float(c1.x), __uint_as_float(c1.y), __uint_as_float(c1.z), __uint_as_float(c1.w)} * (1.f / 127.f); }
#pragma unroll
        for (int ai = 0; ai < 2; ++ai)
#pragma unroll
            for (int m = 0; m < 4; ++m) { const int row = row0 + ai * HALF + m * 16; const float s = sa[row]; bf16_t* rowp = O + (size_t)row * ldc + col0;
#pragma unroll
                for (int bj = 0; bj < 2; ++bj) { const i32x4 i0 = __builtin_bit_cast(i32x4, acc[ai][bj][m][0]), i1 = __builtin_bit_cast(i32x4, acc[ai][bj][m][1]);
                    const f32x4 v0 = (f32x4){(float)i0.x, (float)i0.y, (float)i0.z, (float)i0.w} * sb[bj][0] * s, v1 = (f32x4){(float)i1.x, (float)i1.y, (float)i1.z, (float)i1.w} * sb[bj][1] * s;
                    u32x4 w; w.x = pk2(v0[0], v0[1]); w.y = pk2(v0[2], v0[3]); w.z = pk2(v1[0], v1[1]); w.w = pk2(v1[2], v1[3]);
                    *(u32x4*)(rowp + bj * HALF) = w; } }
    }
};
struct EpiResid {
    static constexpr bool PERM = true;
    const float* xin; const float* cin; bf16_t* X; const float* mod;
    int layer0;
    DI void operator()(const f32x4 (&acc)[2][2][4][2], const Unit& u, int wr, int wc, int fr, int fq) const {
        const int b = u.pm / 33, j = u.pm % 33; const bool isctx = (j == 0);
        const float* rbase = isctx ? cin + (size_t)(b * 256) * DM : xin + (size_t)(b * 8192 + (j - 1) * 256) * DM;
        bf16_t* obase = X + (size_t)u.pm * 256 * DM;
        const float* gate = mod + (size_t)(isctx ? 4 : b) * 6144 + 2 * DM;
        const int r0 = wr * 64 + fr, col0 = u.pn * BM + wc * 32 + 8 * fq;
        f32x4 gv[2][2];
#pragma unroll
        for (int bj = 0; bj < 2; ++bj)
#pragma unroll
            for (int n = 0; n < 2; ++n) gv[bj][n] = *(const f32x4*)(gate + col0 + bj * HALF + 4 * n);
#pragma unroll
        for (int ai = 0; ai < 2; ++ai)
#pragma unroll
            for (int m = 0; m < 4; ++m) { const size_t off = (size_t)(r0 + ai * HALF + m * 16) * DM + col0;
#pragma unroll
                for (int bj = 0; bj < 2; ++bj) { f32x4 r0v, r1v;
                    if (layer0) { r0v = *(const f32x4*)(rbase + off + bj * HALF); r1v = *(const f32x4*)(rbase + off + bj * HALF + 4); }
                    else { const u32x4 w = *(const u32x4*)(obase + off + bj * HALF); r0v = (f32x4){bflo(w.x), bfhi(w.x), bflo(w.y), bfhi(w.y)}; r1v = (f32x4){bflo(w.z), bfhi(w.z), bflo(w.w), bfhi(w.w)}; }
                    const f32x4 o0 = r0v + gv[bj][0] * acc[ai][bj][m][0], o1 = r1v + gv[bj][1] * acc[ai][bj][m][1];
                    u32x4 ow; ow.x = pk2(o0[0], o0[1]); ow.y = pk2(o0[2], o0[3]); ow.z = pk2(o1[0], o1[1]); ow.w = pk2(o1[2], o1[3]);
                    *(u32x4*)(obase + off + bj * HALF) = ow; }
                if (m & 1) asm volatile("" ::: "memory"); }
    }
};
struct EpiResidF8 {
    static constexpr bool PERM = true;
    const float* xin; const float* cin; bf16_t* X; const float* mod;
    int layer0; const float* colmax;
    DI void operator()(const f32x4 (&acc)[2][2][4][2], const Unit& u, int wr, int wc, int fr, int fq) const {
        const int b = u.pm / 33, j = u.pm % 33; const bool isctx = (j == 0);
        const float* rbase = isctx ? cin + (size_t)(b * 256) * DM : xin + (size_t)(b * 8192 + (j - 1) * 256) * DM;
        bf16_t* obase = X + (size_t)u.pm * 256 * DM;
        const float* gate = mod + (size_t)(isctx ? 4 : b) * 6144 + 2 * DM;
        const int r0 = wr * 64 + fr, col0 = u.pn * BM + wc * 32 + 8 * fq;
        f32x4 gv[2][2];
#pragma unroll
        for (int bj = 0; bj < 2; ++bj)
#pragma unroll
            for (int n = 0; n < 2; ++n) gv[bj][n] = *(const f32x4*)(gate + col0 + bj * HALF + 4 * n) * *(const f32x4*)(colmax + col0 + bj * HALF + 4 * n) * (1.f / 448.f);
#pragma unroll
        for (int ai = 0; ai < 2; ++ai)
#pragma unroll
            for (int m = 0; m < 4; ++m) { const size_t off = (size_t)(r0 + ai * HALF + m * 16) * DM + col0;
#pragma unroll
                for (int bj = 0; bj < 2; ++bj) { f32x4 r0v, r1v;
                    if (layer0) { r0v = *(const f32x4*)(rbase + off + bj * HALF); r1v = *(const f32x4*)(rbase + off + bj * HALF + 4); }
                    else { const u32x4 w = *(const u32x4*)(obase + off + bj * HALF); r0v = (f32x4){bflo(w.x), bfhi(w.x), bflo(w.y), bfhi(w.y)}; r1v = (f32x4){bflo(w.z), bfhi(w.z), bflo(w.w), bfhi(w.w)}; }
                    const f32x4 o0 = r0v + gv[bj][0] * acc[ai][bj][m][0], o1 = r1v + gv[bj][1] * acc[ai][bj][m][1];
                    u32x4 ow; ow.x = pk2(o0[0], o0[1]); ow.y = pk2(o0[2], o0[3]); ow.z = pk2(o1[0], o1[1]); ow.w = pk2(o1[2], o1[3]);
                    *(u32x4*)(obase + off + bj * HALF) = ow; }
                if (m & 1) asm volatile("" ::: "memory"); }
    }
};
struct EpiRouter {
    static constexpr bool PERM = false;
    float* L;
    DI void operator()(const f32x4 (&acc)[2][2][4][2], const Unit& u, int wr, int wc, int fr, int fq) const {
        if (wc >= 2 || u.pn != 0) return;
        const int row0 = u.pm * BM + wr * 64 + fr, col0 = wc * 32 + 4 * fq;
#pragma unroll
        for (int ai = 0; ai < 2; ++ai)
#pragma unroll
            for (int m = 0; m < 4; ++m)
#pragma unroll
                for (int n = 0; n < 2; ++n) *(f32x4*)(L + (size_t)(row0 + ai * HALF + m * 16) * 64 + col0 + n * 16) = acc[ai][0][m][n];
    }
};
struct EpiSwiglu {
    static constexpr bool PERM = true;
    bf16_t* act;
    DI void operator()(const f32x4 (&acc)[2][2][4][2], const Unit& u, int wr, int wc, int fr, int fq) const {
        const int row0 = u.pm * BM + wr * 64 + fr, col0 = (u.pn * BM + wc * 32 + 8 * fq) >> 1;
#pragma unroll
        for (int ai = 0; ai < 2; ++ai)
#pragma unroll
            for (int m = 0; m < 4; ++m) { bf16_t* rowp = act + (size_t)(row0 + ai * HALF + m * 16) * DEXP + col0;
#pragma unroll
                for (int bj = 0; bj < 2; ++bj) { const f32x4 g = acc[ai][bj][m][0], uu = acc[ai][bj][m][1];
                    u32x2 w; w.x = pk2(siluf(g[0]) * uu[0], siluf(g[1]) * uu[1]); w.y = pk2(siluf(g[2]) * uu[2], siluf(g[3]) * uu[3]);
                    *(u32x2*)(rowp + bj * (HALF / 2)) = w; } }
    }
};
struct EpiSwigluI8 {
    static constexpr bool PERM = true;
    bf16_t* act; const float* sal; const float* satok; const unsigned* colmax;
    DI void operator()(const f32x4 (&acc)[2][2][4][2], const Unit& u, int wr, int wc, int fr, int fq) const {
        const int rl0 = wr * 64 + fr, gcol0 = u.pn * BM + wc * 32 + 8 * fq;
        const int e = (u.ex >= 0) ? u.ex : 64;
        f32x4 sbg[2], sbu[2];
#pragma unroll
        for (int bj = 0; bj < 2; ++bj) { const u32x4 c0 = *(const u32x4*)(colmax + e * 768 + gcol0 + bj * HALF), c1 = *(const u32x4*)(colmax + e * 768 + gcol0 + bj * HALF + 4);
            sbg[bj] = (f32x4){__uint_as_float(c0.x), __uint_as_float(c0.y), __uint_as_float(c0.z), __uint_as_float(c0.w)} * (1.f / 127.f);
            sbu[bj] = (f32x4){__uint_as_float(c1.x), __uint_as_float(c1.y), __uint_as_float(c1.z), __uint_as_float(c1.w)} * (1.f / 127.f); }
#pragma unroll
        for (int ai = 0; ai < 2; ++ai)
#pragma unroll
            for (int m = 0; m < 4; ++m) { const int rl = rl0 + ai * HALF + m * 16, slot = u.slot0 + rl;
                float sa = 0.f; if (slot < u.cnt) sa = (u.ex >= 0) ? sal[(size_t)u.ex * NT + slot] : satok[slot];
                bf16_t* rowp = act + (size_t)(u.pm * BM + rl) * DEXP + (gcol0 >> 1);
#pragma unroll
                for (int bj = 0; bj < 2; ++bj) { const i32x4 ig = __builtin_bit_cast(i32x4, acc[ai][bj][m][0]), iu = __builtin_bit_cast(i32x4, acc[ai][bj][m][1]);
                    const f32x4 g = (f32x4){(float)ig.x, (float)ig.y, (float)ig.z, (float)ig.w} * sbg[bj] * sa, uu = (f32x4){(float)iu.x, (float)iu.y, (float)iu.z, (float)iu.w} * sbu[bj] * sa;
                    u32x2 w; w.x = pk2(siluf(g[0]) * uu[0], siluf(g[1]) * uu[1]); w.y = pk2(siluf(g[2]) * uu[2], siluf(g[3]) * uu[3]);
                    *(u32x2*)(rowp + bj * (HALF / 2)) = w; } }
    }
};
struct EpiSwigluI8F8 {
    static constexpr bool PERM = true;
    unsigned char* act; const float* sal; const float* satok; const unsigned* colmax;
    DI void operator()(const f32x4 (&acc)[2][2][4][2], const Unit& u, int wr, int wc, int fr, int fq) const {
        const int rl0 = wr * 64 + fr, gcol0 = u.pn * BM + wc * 32 + 8 * fq;
        const int e = (u.ex >= 0) ? u.ex : 64;
        f32x4 sbg[2], sbu[2];
#pragma unroll
        for (int bj = 0; bj < 2; ++bj) { const u32x4 c0 = *(const u32x4*)(colmax + e * 768 + gcol0 + bj * HALF), c1 = *(const u32x4*)(colmax + e * 768 + gcol0 + bj * HALF + 4);
            sbg[bj] = (f32x4){__uint_as_float(c0.x), __uint_as_float(c0.y), __uint_as_float(c0.z), __uint_as_float(c0.w)} * (1.f / 127.f);
            sbu[bj] = (f32x4){__uint_as_float(c1.x), __uint_as_float(c1.y), __uint_as_float(c1.z), __uint_as_float(c1.w)} * (1.f / 127.f); }
#pragma unroll
        for (int ai = 0; ai < 2; ++ai)
#pragma unroll
            for (int m = 0; m < 4; ++m) { const int rl = rl0 + ai * HALF + m * 16, slot = u.slot0 + rl;
                float sa = 0.f; if (slot < u.cnt) sa = (u.ex >= 0) ? sal[(size_t)u.ex * NT + slot] : satok[slot];
                unsigned char* rowp = act + (size_t)(u.pm * BM + rl) * 512 + (gcol0 >> 1);
#pragma unroll
                for (int bj = 0; bj < 2; ++bj) { const i32x4 ig = __builtin_bit_cast(i32x4, acc[ai][bj][m][0]), iu = __builtin_bit_cast(i32x4, acc[ai][bj][m][1]);
                    const f32x4 g = (f32x4){(float)ig.x, (float)ig.y, (float)ig.z, (float)ig.w} * sbg[bj] * sa, uu = (f32x4){(float)iu.x, (float)iu.y, (float)iu.z, (float)iu.w} * sbu[bj] * sa;
                    const float a0 = __builtin_amdgcn_fmed3f(siluf(g[0]) * uu[0], -448.f, 448.f), a1 = __builtin_amdgcn_fmed3f(siluf(g[1]) * uu[1], -448.f, 448.f);
                    const float a2 = __builtin_amdgcn_fmed3f(siluf(g[2]) * uu[2], -448.f, 448.f), a3 = __builtin_amdgcn_fmed3f(siluf(g[3]) * uu[3], -448.f, 448.f);
                    unsigned w = 0u; w = __builtin_amdgcn_cvt_pk_fp8_f32(a0, a1, w, false); w = __builtin_amdgcn_cvt_pk_fp8_f32(a2, a3, w, true);
                    *(unsigned*)(rowp + bj * (HALF / 2)) = w; } }
    }
};
}
constexpr size_t MiB = 1u << 20;
constexpr size_t WS_CTL = 0, CTL_ZERO_BYTES = 1 * MiB;
constexpr size_t WS_TAB = 1 * MiB;
constexpr size_t WS_WIN = 2 * MiB, WIN_L = (size_t)NP * DM * 2;
constexpr size_t WS_WOUT = 16 * MiB, WOUT_L = (size_t)DM * DM * 2;
constexpr size_t WS_WR = 20 * MiB, WR_L = (size_t)256 * DM * 2;
constexpr size_t WS_WGU = 22 * MiB, WGU_E = (size_t)768 * DM * 2, WGU_L = 65 * WGU_E;
constexpr size_t WGU8_E = (size_t)768 * DM, WGU8_L = 65 * WGU8_E;
constexpr size_t WS_H8 = WS_WGU + 98 * MiB;
constexpr size_t WS_SA = WS_WGU + 132 * MiB;
constexpr size_t WS_SAL = WS_WGU + 133 * MiB;
constexpr size_t WS_WD = 217 * MiB, WD_E = (size_t)DM * 512, WD_L = 65 * WD_E;
constexpr size_t WS_SD = WS_WGU + 142 * MiB;
constexpr size_t WS_H = 315 * MiB;
constexpr size_t WS_X = 382 * MiB;
constexpr size_t WS_MIX = 514 * MiB;
constexpr size_t WS_LOG = 580 * MiB;
constexpr size_t WS_LIST = 589 * MiB;
constexpr size_t WS_GLIST = 598 * MiB;
constexpr size_t WS_POS = 607 * MiB;
constexpr int MAXTILES = 988;
constexpr size_t WS_ACT = 609 * MiB;
constexpr size_t WS_BIG = 795 * MiB;
constexpr size_t B_P = WS_BIG, B_QS = WS_BIG + 231 * MiB, B_QD = WS_BIG + 248 * MiB, B_QM = WS_BIG + 265 * MiB,
                 B_KS = WS_BIG + 290 * MiB, B_VS = WS_BIG + 299 * MiB, B_KD = WS_BIG + 308 * MiB, B_VD = WS_BIG + 317 * MiB, B_KM = WS_BIG + 326 * MiB, B_VM = WS_BIG + 360 * MiB,
                 B_GQ = WS_BIG + 377 * MiB, B_GK = WS_BIG + 394 * MiB, B_GV = WS_BIG + 411 * MiB, B_LA = WS_BIG + 428 * MiB, B_BE = WS_BIG + 430 * MiB,
                 B_G2 = WS_BIG + 432 * MiB, B_DEC = WS_BIG + 598 * MiB, B_OF = WS_BIG + 599 * MiB;
constexpr size_t WS_END = WS_BIG + 666 * MiB;
constexpr size_t WIN8_L = (size_t)NP * DM;
constexpr size_t WS_FT = WS_BIG;
constexpr size_t IMG64 = 8192, IMGM = 16384;
constexpr int CW_BAR = 4096, CW_QUEUE = 8192, CW_ECNT = 8448, CW_QUEUE2 = 12288, CW_MOD = 16384, CW_CMAX = 81920, CW_CMAXW = 184320, CW_CMAXO = 192512;
constexpr int RING_BYTES = 131072, MISC_OFF = RING_BYTES, LDS_BYTES = 147456;

struct Args { const float* in[28]; float* out; unsigned char* ws; int ph_lo, ph_hi; };

typedef const __attribute__((address_space(4))) Args* KArgs;
struct Frame {
    LAS unsigned char* lds; volatile LAS unsigned* MISC;
    unsigned* ctl; unsigned char* ws;
    int tid, lane, wave, vcu, G, bx;
};

template <class F>
DI void transpose_item(const float* W, int ldw, int K, bf16_t* WT, LAS float* scr, int kb, int n0, int lane, F srccol) {
    const int k0 = 64 * kb; const int sc = srccol(n0 + (lane & 31));
    float tv[32];
#pragma unroll
    for (int i = 0; i < 32; ++i) { const int kk = 2 * i + (lane >> 5); tv[i] = (sc >= 0) ? W[(size_t)(k0 + kk) * ldw + sc] : 0.f; }
#pragma unroll
    for (int i = 0; i < 32; ++i) { const int kk = 2 * i + (lane >> 5); scr[kk * 33 + (lane & 31)] = tv[i]; }
    LDS_WAIT(); asm volatile("" ::: "memory");
    const int c = lane & 7;
#pragma unroll
    for (int j = 0; j < 4; ++j) { const int n = (lane >> 3) + 8 * j; const LAS float* s = scr + (8 * c) * 33 + n;
        u32x4 o; o.x = pk2(s[0 * 33], s[1 * 33]); o.y = pk2(s[2 * 33], s[3 * 33]); o.z = pk2(s[4 * 33], s[5 * 33]); o.w = pk2(s[6 * 33], s[7 * 33]);
        *(u32x4*)(WT + (size_t)(n0 + n) * K + k0 + 8 * c) = o; }
    LDS_WAIT(); asm volatile("" ::: "memory");
}
DI int win_srccol(int n) {
    if (n < 1024) return n;
    if (n < 1536) return n - 1024 + R_SQ;
    if (n < 2048) return n - 1536 + R_DQ;
    if (n < C_CQ) return -1;
    if (n < C_CKV) return n - C_CQ + R_CQ;
    if (n < C_KR) return n - C_CKV + R_CKV;
    if (n < C_GA) return n - C_KR + R_KR;
    if (n < C_GB) return n - C_GA + R_GA;
    if (n < C_END) return n - C_GB + R_GB;
    return -1;
}
DI int gu_srccol(int n) { return (n & 4) ? 384 + 4 * (n >> 3) + (n & 3) : 4 * (n >> 3) + (n & 3); }

constexpr int I_WR = 16 * 8, I_L = I_WR, I_CONV = I_L + 128 * 14;
DI void convert_items(unsigned char* ws, KArgs a, LAS float* scr, int l, int it0, int it1, int step, int lane) {
    for (int it = it0; it < it1; it += step) {
        int r = it;
        if (r < I_WR) { transpose_item(a->in[22] + (size_t)l * DM * 64, 64, DM, (bf16_t*)(ws + WS_WR + l * WR_L), scr, r / 8, (r % 8) * 32, lane, [](int n) { return n < 64 ? n : -1; }); continue; }
        r -= I_WR;
        {
          const int kb = r / 112, nb = r % 112, np0 = 2048 + 8 * nb; const bool isq = nb < 48;
          int sc0; const float* U; const float* gn; int J, ldu, coff;
          if (isq) { J = 256; ldu = 384; U = a->in[15] + (size_t)l * 256 * 384; gn = a->in[13] + l * 256; coff = R_CQ;
              if (np0 < C_MQP) { const int h = (np0 - C_MQN) >> 6, d = (np0 - C_MQN) & 63; sc0 = h * 96 + d; } else { const int h = (np0 - C_MQP) >> 5, d = (np0 - C_MQP) & 31; sc0 = h * 96 + 64 + d; } }
          else { J = 128; ldu = 512; U = a->in[16] + (size_t)l * 128 * 512; gn = a->in[14] + l * 128; coff = R_CKV;
              if (np0 < C_MV) { const int h = (np0 - C_MKN) >> 6, d = (np0 - C_MKN) & 63; sc0 = h * 128 + d; } else { const int h = (np0 - C_MV) >> 6, d = (np0 - C_MV) & 63; sc0 = h * 128 + 64 + d; } }
          const float* wrow = a->in[8] + (size_t)l * DM * DIN + (size_t)(64 * kb + lane) * DIN + coff;
          float acc[8];
#pragma unroll
          for (int q = 0; q < 8; ++q) acc[q] = 0.f;
#pragma unroll 2
          for (int j = 0; j < J; j += 4) { const f32x4 w4 = *(const f32x4*)(wrow + j) * *(const f32x4*)(gn + j);
#pragma unroll
              for (int e = 0; e < 4; ++e) { const float w = w4[e]; const f32x4 u0 = *(const f32x4*)(U + (size_t)(j + e) * ldu + sc0), u1 = *(const f32x4*)(U + (size_t)(j + e) * ldu + sc0 + 4);
                  acc[0] += w * u0.x; acc[1] += w * u0.y; acc[2] += w * u0.z; acc[3] += w * u0.w; acc[4] += w * u1.x; acc[5] += w * u1.y; acc[6] += w * u1.z; acc[7] += w * u1.w; } }
          float* op = (float*)(ws + WS_FT) + ((size_t)l * 896 + (np0 - 2048)) * DM + 64 * kb + lane;
#pragma unroll
          for (int q = 0; q < 8; ++q) op[(size_t)q * DM] = acc[q]; }
    }
}
DI float wave_max(float v) { v = fmaxf(v, dpp_x1(v)); v = fmaxf(v, dpp_x2(v)); v = fmaxf(v, dpp_m8(v)); v = fmaxf(v, dpp_m16(v)); v = fmaxf(v, __shfl_xor(v, 16)); return fmaxf(v, __shfl_xor(v, 32)); }
DI unsigned q8pack(float a, float b, float c, float d, float inv) {
    const int qa = (int)rintf(a * inv), qb = (int)rintf(b * inv), qc = (int)rintf(c * inv), qd = (int)rintf(d * inv);
    return (unsigned)(qa & 255) | ((unsigned)(qb & 255) << 8) | ((unsigned)(qc & 255) << 16) | ((unsigned)qd << 24);
}
DI void wgu_quant_items(const Frame& F, KArgs a) {
    int tid_ = F.tid; asm volatile("" : "+v"(tid_)); const int tid = tid_, lane = tid & 63, wave = tid >> 6, c = tid & 31, kr = tid >> 5;
    LAS float* tile = (LAS float*)F.lds; unsigned char* ws = F.ws;
    constexpr int NWGU = 2 * 65 * 24, NWIN = NWGU + 2 * 84, NIT = NWIN + 2 * 32;
    float v[64];
#define WQ_ISSUE(it_) do { const float* src_; size_t st_; bool ok_ = true; \
        if ((it_) < NWGU) { const int le_ = (it_) / 24, q_ = (it_) % 24, l_ = le_ / 65, e_ = le_ % 65; st_ = 16 * 768; \
            src_ = ((e_ < 64) ? a->in[24] + ((size_t)l_ * 64 + e_) * DM * 768 : a->in[26] + (size_t)l_ * DM * 768) + 16 * q_ + gu_srccol(c) + (size_t)kr * 768; } \
        else if ((it_) < NWIN) { const int j_ = (it_) - NWGU, l_ = j_ / 84, k_ = j_ % 84, q_ = k_ < 64 ? k_ : k_ + 28, sc_ = win_srccol(32 * q_ + c); ok_ = sc_ >= 0; st_ = 16 * DIN; \
            src_ = a->in[8] + (size_t)l_ * DM * DIN + (ok_ ? sc_ : 0) + (size_t)kr * DIN; } \
        else { const int j_ = (it_) - NWIN, l_ = j_ / 32, q_ = j_ % 32; st_ = 16 * DM; src_ = a->in[21] + (size_t)l_ * DM * DM + 32 * q_ + c + (size_t)kr * DM; } \
        _Pragma("unroll") for (int i = 0; i < 64; ++i) v[i] = ok_ ? __builtin_nontemporal_load(src_ + (size_t)i * st_) : 0.f; } while (0)
    int it = F.vcu;
    if (it < NIT) WQ_ISSUE(it);
    for (; it < NIT; it += F.G) {
#pragma unroll
        for (int i = 0; i < 64; ++i) tile[(16 * i + kr) * 32 + (c ^ (i & 31))] = v[i];
        LDS_WAIT(); __syncthreads();
        const int nx = it + F.G; if (nx < NIT) WQ_ISSUE(nx);
        unsigned char* obase; float* cbase;
        if (it < NWGU) { const int r0 = (it / 24) * 768 + 32 * (it % 24); obase = ws + WS_WGU + (size_t)r0 * 1024; cbase = (float*)(F.ctl + CW_CMAX) + r0; }
        else if (it < NWIN) { const int j = it - NWGU, l = j / 84, k = j % 84, r0 = l * NP + 32 * (k < 64 ? k : k + 28); obase = ws + WS_WIN + (size_t)r0 * 1024; cbase = (float*)(F.ctl + CW_CMAXW) + r0; }
        else { const int r0 = (it - NWIN) * 32; obase = ws + WS_WOUT + (size_t)r0 * 1024; cbase = (float*)(F.ctl + CW_CMAXO) + r0; }
        const bool f8 = it >= NWIN;
#pragma unroll
        for (int cc = 0; cc < 4; ++cc) { const int col = 4 * wave + cc; float x[16]; float mx = 0.f;
#pragma unroll
            for (int j = 0; j < 16; ++j) { x[j] = tile[(16 * lane + j) * 32 + (col ^ (lane & 31))]; mx = fmaxf(mx, fabsf(x[j])); }
            mx = wave_max(mx); const float inv = mx > 0.f ? (f8 ? 448.f : 127.f) / mx : 0.f;
            u32x4 o;
            if (f8) { o.x = f8pack(x[0] * inv, x[1] * inv, x[2] * inv, x[3] * inv); o.y = f8pack(x[4] * inv, x[5] * inv, x[6] * inv, x[7] * inv); o.z = f8pack(x[8] * inv, x[9] * inv, x[10] * inv, x[11] * inv); o.w = f8pack(x[12] * inv, x[13] * inv, x[14] * inv, x[15] * inv); }
            else { o.x = q8pack(x[0], x[1], x[2], x[3], inv); o.y = q8pack(x[4], x[5], x[6], x[7], inv); o.z = q8pack(x[8], x[9], x[10], x[11], inv); o.w = q8pack(x[12], x[13], x[14], x[15], inv); }
            ((u32x4*)(obase + (size_t)col * 1024))[lane] = o;
            if (lane == 0) cbase[col] = mx; }
        LDS_WAIT(); __syncthreads();
    }
#undef WQ_ISSUE
}
DI void wd_quant_items(const Frame& F, KArgs a) {
    int tid_ = F.tid; asm volatile("" : "+v"(tid_)); const int tid = tid_, lane = tid & 63, wave = tid >> 6, c = tid & 31, kr = tid >> 5;
    LAS float* tile = (LAS float*)F.lds; unsigned char* ws = F.ws;
    constexpr int NIT = 2 * 65 * 32;
    float v[24];
#define WD_ISSUE(it_) do { const int le_ = (it_) / 32, q_ = (it_) % 32, l_ = le_ / 65, e_ = le_ % 65; \
        const float* src_ = ((e_ < 64) ? a->in[25] + ((size_t)l_ * 64 + e_) * DEXP * DM : a->in[27] + (size_t)l_ * DEXP * DM) + 32 * q_ + c + (size_t)kr * DM; \
        _Pragma("unroll") for (int i = 0; i < 24; ++i) v[i] = __builtin_nontemporal_load(src_ + (size_t)i * 16 * DM); } while (0)
    int it = F.vcu;
    if (it < NIT) WD_ISSUE(it);
    for (; it < NIT; it += F.G) {
#pragma unroll
        for (int i = 0; i < 24; ++i) tile[(16 * i + kr) * 32 + (c ^ ((2 * i + (kr >> 3)) & 31))] = v[i];
        LDS_WAIT(); __syncthreads();
        const int nx = it + F.G; if (nx < NIT) WD_ISSUE(nx);
        const int le = it / 32, q = it % 32;
#pragma unroll
        for (int cc = 0; cc < 4; ++cc) { const int col = 4 * wave + cc; float x[8]; float mx = 0.f; const int kl = lane < 48 ? lane : 0;
#pragma unroll
            for (int j = 0; j < 8; ++j) { x[j] = tile[(8 * kl + j) * 32 + (col ^ (kl & 31))]; mx = fmaxf(mx, fabsf(x[j])); }
            mx = wave_max(mx); const float inv = mx > 0.f ? 448.f / mx : 0.f;
            u32x2 o = {0u, 0u};
            if (lane < 48) {
                o.x = __builtin_amdgcn_cvt_pk_fp8_f32(__builtin_amdgcn_fmed3f(x[0] * inv, -448.f, 448.f), __builtin_amdgcn_fmed3f(x[1] * inv, -448.f, 448.f), o.x, false);
                o.x = __builtin_amdgcn_cvt_pk_fp8_f32(__builtin_amdgcn_fmed3f(x[2] * inv, -448.f, 448.f), __builtin_amdgcn_fmed3f(x[3] * inv, -448.f, 448.f), o.x, true);
                o.y = __builtin_amdgcn_cvt_pk_fp8_f32(__builtin_amdgcn_fmed3f(x[4] * inv, -448.f, 448.f), __builtin_amdgcn_fmed3f(x[5] * inv, -448.f, 448.f), o.y, false);
                o.y = __builtin_amdgcn_cvt_pk_fp8_f32(__builtin_amdgcn_fmed3f(x[6] * inv, -448.f, 448.f), __builtin_amdgcn_fmed3f(x[7] * inv, -448.f, 448.f), o.y, true); }
            const int n = 32 * q + col;
            ((u32x2*)(ws + WS_WD + (size_t)le * WD_E + (size_t)n * 512))[lane] = o;
            if (lane == 0) ((float*)(ws + WS_SD))[le * DM + n] = mx; }
        LDS_WAIT(); __syncthreads();
    }
#undef WD_ISSUE
}
DI void fold_quant_row(unsigned char* ws, unsigned* ctl, int r, int lane) {
    const int l = r / 896, n = r % 896; const f32x4* src = (const f32x4*)(ws + WS_FT + (size_t)r * 4096) + lane;
    f32x4 x[4]; float mx = 0.f;
#pragma unroll
    for (int j = 0; j < 4; ++j) { x[j] = src[64 * j]; mx = fmaxf(fmaxf(mx, fmaxf(fabsf(x[j].x), fabsf(x[j].y))), fmaxf(fabsf(x[j].z), fabsf(x[j].w))); }
    mx = wave_max(mx); const float inv = mx > 0.f ? 127.f / mx : 0.f;
    unsigned* dst = (unsigned*)(ws + WS_WIN + ((size_t)l * NP + 2048 + n) * 1024) + lane;
#pragma unroll
    for (int j = 0; j < 4; ++j) dst[64 * j] = q8pack(x[j].x, x[j].y, x[j].z, x[j].w, inv);
    if (lane == 0) ((float*)(ctl + CW_CMAXW))[l * NP + 2048 + n] = mx;
}
#ifndef CONV_BG
#define CONV_BG 0
#endif
DI void p0_prologue(const Frame& F, KArgs a) {
    LAS float* scr = (LAS float*)(F.lds + F.wave * 16384);
    int lane_ = F.lane; asm volatile("" : "+v"(lane_)); const int gw = F.vcu * 8 + F.wave, NGW = F.G * 8, lane = lane_;
    unsigned char* ws = F.ws;
#ifndef P0_DUP
#define P0_DUP 0
#endif
    for (int rp = 0; rp < ((P0_DUP & 1) ? 2 : 1); ++rp) { wgu_quant_items(F, a); wd_quant_items(F, a); }
    for (int rp = 0; rp < ((P0_DUP & 4) ? 2 : 1); ++rp)
    if (F.vcu < 2 * 96) {
        LAS float* sct = (LAS float*)F.lds; LAS float* red = (LAS float*)(F.lds + 32768); float* modacc = (float*)(F.ctl + CW_MOD);
        for (int i = F.tid; i < 5 * DM; i += 512) { const int bb = i / DM, k = i % DM; const float cv = (bb < 4) ? a->in[1][bb * DM + k] : a->in[3][k]; sct[k * 8 + bb] = siluf(cv); }
        LDS_WAIT(); __syncthreads();
        for (int it = F.vcu; it < 2 * 96; it += F.G) {
            const int l = it / 96, n = (it % 96) * 64 + lane, k0 = F.wave * 128;
            const float* W = a->in[4] + (size_t)l * DM * 6144 + (size_t)k0 * 6144 + n;
            float acc[5] = {0.f, 0.f, 0.f, 0.f, 0.f};
#pragma unroll 1
            for (int kb = 0; kb < 128; kb += 16) { float w[16];
#pragma unroll
                for (int j = 0; j < 16; ++j) w[j] = __builtin_nontemporal_load(W + (size_t)(kb + j) * 6144);
#pragma unroll
                for (int j = 0; j < 16; ++j) { const f32x4 s4 = *(const LAS f32x4*)(sct + (k0 + kb + j) * 8); const float s5 = sct[(k0 + kb + j) * 8 + 4];
                    acc[0] += s4.x * w[j]; acc[1] += s4.y * w[j]; acc[2] += s4.z * w[j]; acc[3] += s4.w * w[j]; acc[4] += s5 * w[j]; } }
#pragma unroll
            for (int bb = 0; bb < 5; ++bb) red[(F.wave * 5 + bb) * 64 + lane] = acc[bb];
            LDS_WAIT(); __syncthreads();
            if (F.tid < 320) { const int bb = F.tid >> 6, c = F.tid & 63; float sum = red[bb * 64 + c];
#pragma unroll
                for (int w8 = 1; w8 < 8; ++w8) sum += red[(w8 * 5 + bb) * 64 + c];
                const int nn = (it % 96) * 64 + c; modacc[((size_t)l * 5 + bb) * 6144 + nn] = sum + a->in[5][l * 6144 + nn]; }
            LDS_WAIT(); __syncthreads();
        }
    }
    __syncthreads();
    for (int rp = 0; rp < ((P0_DUP & 2) ? 2 : 1); ++rp) {
    convert_items(ws, a, scr, 0, gw, I_CONV, NGW, lane);
    if (!CONV_BG) convert_items(ws, a, scr, 1, gw, I_CONV, NGW, lane); }
    { float* tab = (float*)(ws + WS_TAB);
      for (int i = gw * 64 + lane; i < 3072; i += NGW * 64) {
          if (i < 2048) { const int pos = i >> 4, fi = i & 15; const float inv = powf(10000.f, -(float)(2 * fi) / 32.f), ang = (float)pos * inv; tab[i] = cosf(ang); tab[2048 + i] = sinf(ang); }
          else { const int q = i - 2048, pos = q >> 3, fi = q & 7; const float inv = powf(10000.f, -(float)(2 * fi) / 16.f), ang = (float)pos * inv; tab[4096 + q] = cosf(ang); tab[5120 + q] = sinf(ang); } } }
    if (gw == 0) { ((u32x4*)((bf16_t*)(ws + WS_H) + (size_t)NT * DM))[lane] = (u32x4){0u, 0u, 0u, 0u}; ((u32x4*)((bf16_t*)(ws + WS_H) + (size_t)NT * DM))[64 + lane] = (u32x4){0u, 0u, 0u, 0u};
                   ((u32x4*)(ws + WS_H8 + (size_t)NT * DM))[lane] = (u32x4){0u, 0u, 0u, 0u}; }
}

DI void norm_row(const float* xrow, const float* g, const float* shift, const float* scale, unsigned* qrow, float* sa, int lane) {
    const f32x4* xr = (const f32x4*)xrow + lane;
    f32x4 v[4]; float s = 0.f;
#pragma unroll
    for (int j = 0; j < 4; ++j) { v[j] = xr[64 * j]; s += (v[j].x * v[j].x + v[j].y * v[j].y) + (v[j].z * v[j].z + v[j].w * v[j].w); }
    const float r = rsqrtf(wave_sum(s) * (1.f / DM) + EPS);
    float mx = 0.f;
#pragma unroll
    for (int j = 0; j < 4; ++j) { const f32x4 gg = ((const f32x4*)g)[lane + 64 * j], sc = ((const f32x4*)scale)[lane + 64 * j], sh = ((const f32x4*)shift)[lane + 64 * j];
        const f32x4 o = v[j] * r * gg * (sc + 1.f) + sh; v[j] = o;
        mx = fmaxf(fmaxf(mx, fmaxf(fabsf(o.x), fabsf(o.y))), fmaxf(fabsf(o.z), fabsf(o.w))); }
    mx = wave_max(mx);
    const float inv = mx > 0.f ? 127.f / mx : 0.f;
#pragma unroll
    for (int j = 0; j < 4; ++j) qrow[lane + 64 * j] = q8pack(v[j].x, v[j].y, v[j].z, v[j].w, inv);
    if (lane == 0) *sa = mx * (1.f / 127.f);
}
DI void norm_row_b(const bf16_t* xrow, const float* g, const float* shift, const float* scale, bf16_t* orow, int lane) {
    const u32x2* xr = (const u32x2*)xrow + lane;
    f32x4 v[4]; float s = 0.f;
#pragma unroll
    for (int j = 0; j < 4; ++j) { const u32x2 w = __builtin_nontemporal_load(xr + 64 * j); v[j] = (f32x4){bflo(w.x), bfhi(w.x), bflo(w.y), bfhi(w.y)}; s += (v[j].x * v[j].x + v[j].y * v[j].y) + (v[j].z * v[j].z + v[j].w * v[j].w); }
    const float r = rsqrtf(wave_sum(s) * (1.f / DM) + EPS);
#pragma unroll
    for (int j = 0; j < 4; ++j) { const f32x4 gg = ((const f32x4*)g)[lane + 64 * j], sc = ((const f32x4*)scale)[lane + 64 * j], sh = ((const f32x4*)shift)[lane + 64 * j];
        const f32x4 o = v[j] * r * gg * (sc + 1.f) + sh;
        u32x2 w; w.x = pk2(o.x, o.y); w.y = pk2(o.z, o.w); ((u32x2*)orow)[lane + 64 * j] = w; }
}
DI void norm_row_q(const bf16_t* xrow, const float* g, const float* shift, const float* scale, bf16_t* orow, unsigned* qrow, float* sa, int lane) {
    const u32x2* xr = (const u32x2*)xrow + lane;
    f32x4 v[4]; float s = 0.f;
#pragma unroll
    for (int j = 0; j < 4; ++j) { const u32x2 w = __builtin_nontemporal_load(xr + 64 * j); v[j] = (f32x4){bflo(w.x), bfhi(w.x), bflo(w.y), bfhi(w.y)}; s += (v[j].x * v[j].x + v[j].y * v[j].y) + (v[j].z * v[j].z + v[j].w * v[j].w); }
    const float r = rsqrtf(wave_sum(s) * (1.f / DM) + EPS);
    float mx = 0.f;
#pragma unroll
    for (int j = 0; j < 4; ++j) { const f32x4 gg = ((const f32x4*)g)[lane + 64 * j], sc = ((const f32x4*)scale)[lane + 64 * j], sh = ((const f32x4*)shift)[lane + 64 * j];
        const f32x4 o = v[j] * r * gg * (sc + 1.f) + sh; v[j] = o;
        mx = fmaxf(fmaxf(mx, fmaxf(fabsf(o.x), fabsf(o.y))), fmaxf(fabsf(o.z), fabsf(o.w)));
        u32x2 w; w.x = pk2(o.x, o.y); w.y = pk2(o.z, o.w); ((u32x2*)orow)[lane + 64 * j] = w; }
    mx = wave_max(mx);
    const float inv = mx > 0.f ? 127.f / mx : 0.f;
#pragma unroll
    for (int j = 0; j < 4; ++j) qrow[lane + 64 * j] = q8pack(v[j].x, v[j].y, v[j].z, v[j].w, inv);
    if (lane == 0) *sa = mx * (1.f / 127.f);
}
DI const float* resid_row_l0(KArgs a, int row) { const int b = row / TPB, i = row % TPB; return (i < CTXL) ? a->in[2] + (size_t)(b * CTXL + i) * DM : a->in[0] + (size_t)(b * SEQ + i - CTXL) * DM; }

DI void load8(const bf16_t* p, float (&x)[8]) { const u32x4 w = *(const u32x4*)p; x[0] = bflo(w.x); x[1] = bfhi(w.x); x[2] = bflo(w.y); x[3] = bfhi(w.y); x[4] = bflo(w.z); x[5] = bfhi(w.z); x[6] = bflo(w.w); x[7] = bfhi(w.w); }
DI void unpack8(const u32x4 w, float (&x)[8]) { x[0] = bflo(w.x); x[1] = bfhi(w.x); x[2] = bflo(w.y); x[3] = bfhi(w.y); x[4] = bflo(w.z); x[5] = bfhi(w.z); x[6] = bflo(w.w); x[7] = bfhi(w.w); }
DI void store8(bf16_t* p, const float (&y)[8]) { u32x4 w; w.x = pk2(y[0], y[1]); w.y = pk2(y[2], y[3]); w.z = pk2(y[4], y[5]); w.w = pk2(y[6], y[7]); *(u32x4*)p = w; }
DI void loadf8(const float* p, float (&x)[8]) { const f32x4 a = ((const f32x4*)p)[0], b = ((const f32x4*)p)[1]; x[0] = a.x; x[1] = a.y; x[2] = a.z; x[3] = a.w; x[4] = b.x; x[5] = b.y; x[6] = b.z; x[7] = b.w; }
DI void loadl8(const LAS float* p, float (&x)[8]) { const f32x4 a = ((const LAS f32x4*)p)[0], b = ((const LAS f32x4*)p)[1]; x[0] = a.x; x[1] = a.y; x[2] = a.z; x[3] = a.w; x[4] = b.x; x[5] = b.y; x[6] = b.z; x[7] = b.w; }
template <int XM> DI void rope8(float (&y)[8], const LAS float* cs, const LAS float* sn, bool first, bool apply) {
    float c8[8], s8[8];
    if (apply) { loadl8(cs, c8); loadl8(sn, s8); } else {
#pragma unroll
        for (int j = 0; j < 8; ++j) { c8[j] = 1.f; s8[j] = 0.f; } }
#pragma unroll
    for (int j = 0; j < 8; ++j) { const float p = (XM == 1) ? dpp_x1(y[j]) : dpp_x2(y[j]); y[j] = first ? y[j] * c8[j] - p * s8[j] : y[j] * c8[j] + p * s8[j]; }
}
constexpr float LOG2E = 1.4426950408889634f;
constexpr float QSCALE64 = 0.125f * LOG2E;
constexpr float QSCALEM = 0.10206207261596575f * LOG2E;

DI void vstage8(LAS bf16_t* stage, int slot, int d0, int tau, const float (&y)[8]) {
    const int hi = (tau >> 2) & 1, jj = (tau & 3) + 4 * (tau >> 3);
#pragma unroll
    for (int j = 0; j < 8; ++j) stage[slot * 1024 + (d0 + j) * 16 + hi * 8 + jj] = (bf16_t)f2bf(y[j]);
}

template <int XM> DI void rope8l(float (&y)[8], const LAS float* cs, const LAS float* sn, bool first) {
    float c8[8], s8[8]; loadl8(cs, c8); loadl8(sn, s8);
#pragma unroll
    for (int j = 0; j < 8; ++j) { const float p = (XM == 1) ? dpp_x1(y[j]) : dpp_x2(y[j]); y[j] = first ? y[j] * c8[j] - p * s8[j] : y[j] * c8[j] + p * s8[j]; }
}
DI void prep_phase(const Frame& F, KArgs a, int l, int rep) {
    unsigned char* ws = F.ws; int lane_ = F.lane; const int wave = F.wave;
    const bf16_t* P = (const bf16_t*)(ws + B_P);
    const float* tab = (const float*)(ws + WS_TAB);
    LAS float* tl = (LAS float*)F.lds;
    const LAS float* cos64 = tl, *sin64 = tl + 2048, *cos32 = tl + 4096, *sin32 = tl + 5120;
    const LAS float* convw = tl + 6144;
    const LAS float* swa_q = tl + 9984, *swa_k = tl + 10048, *gqa_q = tl + 10112, *gqa_k = tl + 10176, *mla_q = tl + 10240  , *mla_k = tl + 10336  , *ones8 = tl + 10432, *zeros8 = tl + 10440;
    { const float* cwg = a->in[9] + (size_t)l * 5 * 768; const float* sg = a->in[18] + l * 128; const float* gg = a->in[20] + l * 128; const float* mg = a->in[17] + l * 192;
      for (int i = F.tid; i < 10448; i += 512) { float v;
          if (i < 6144) v = tab[i]; else if (i < 9984) v = cwg[i - 6144];
          else if (i < 10048) v = sg[i - 9984] * QSCALE64; else if (i < 10112) v = sg[i - 9984];
          else if (i < 10176) v = gg[i - 10112] * QSCALE64; else if (i < 10240) v = gg[i - 10112];
          else if (i < 10336) v = mg[i - 10240] * QSCALEM; else if (i < 10432) v = mg[i - 10240];
          else v = (i < 10440) ? 1.f : 0.f;
          tl[i] = v; }
      LDS_WAIT(); __syncthreads(); }
    const int gwv = F.vcu * 8 + wave, NGWV = F.G * 8;
    for (int g = gwv; g < NT / 2; g += NGWV) {
        const int row0 = g * 2, b = row0 / TPB, i0 = row0 % TPB; const bool isctx = i0 < CTXL; const bool lat = !isctx;
        asm volatile("" : "+v"(lane_)); const int lane = lane_, L = lane;
        float vt[3][8];
        unsigned vp[3][8];
        u32x4 RAW[2][5], CQ[6], CV[6];
        { const u32x4 z4 = (u32x4){0u, 0u, 0u, 0u}; const int seglo = isctx ? 0 : CTXL, seghi = isctx ? CTXL : TPB;
          const bf16_t* pA = P + (size_t)row0 * NP;
#define PREP_RAW(tk) do { const bf16_t* pr = pA + (size_t)(tk) * NP; \
              RAW[tk][0] = (L < 54) ? __builtin_nontemporal_load((const u32x4*)(pr + C_CQ + 8 * L)) : z4; RAW[tk][1] = __builtin_nontemporal_load((const u32x4*)(pr + C_SQ + 8 * L)); RAW[tk][2] = __builtin_nontemporal_load((const u32x4*)(pr + C_DQ + 8 * L)); \
              RAW[tk][3] = __builtin_nontemporal_load((const u32x4*)(pr + C_MQN + 8 * L)); RAW[tk][4] = (L < 48) ? __builtin_nontemporal_load((const u32x4*)(pr + 2560 + 8 * L)) : z4; } while (0)
          PREP_RAW(0);
#pragma unroll
          for (int jj = 0; jj < 6; ++jj) { const int ii = i0 + jj - 2; const bool ok = (ii >= seglo && ii < seghi);
              CQ[jj] = ok ? *(const u32x4*)(pA + (ptrdiff_t)(jj - 2) * NP + 8 * L) : z4; CV[jj] = (ok && L < 32) ? *(const u32x4*)(pA + (ptrdiff_t)(jj - 2) * NP + 512 + 8 * L) : z4; } }
        __builtin_amdgcn_sched_barrier(0);
#pragma unroll
        for (int tk = 0; tk < 2; ++tk) {
            const int row = row0 + tk, i = i0 + tk, kt = i >> 6, kv = i & 63;
            const int t = i - CTXL, rpos = lat ? (t >> 6) : 0, cpos = lat ? (t & 63) : 0;
            float x[8], y[8];
#pragma unroll
            for (int s = 0; s < 2; ++s) {
                const int c = (s == 0) ? 8 * L : 512 + 8 * (L & 31);
                float accv[8];
#pragma unroll
                for (int j = 0; j < 8; ++j) accv[j] = 0.f;
#pragma unroll
                for (int jj = 0; jj < 5; ++jj) { unpack8(s ? CV[tk + jj] : CQ[tk + jj], x); float w8[8]; loadl8(convw + jj * 768 + c, w8);
#pragma unroll
                    for (int j = 0; j < 8; ++j) accv[j] += x[j] * w8[j]; }
                float ss = 0.f;
#pragma unroll
                for (int j = 0; j < 8; ++j) { accv[j] = siluf(accv[j]); ss += accv[j] * accv[j]; }
                ss += dpp_x1(ss); ss += dpp_x2(ss); ss += dpp_m8(ss);
                if (s == 0) { const float nr = __builtin_amdgcn_rsqf(ss + EPS) * ((L < 32) ? 0.125f : 1.f);
#pragma unroll
                    for (int j = 0; j < 8; ++j) y[j] = accv[j] * nr;
                    store8((bf16_t*)(ws + (L < 32 ? B_GQ : B_GK)) + (size_t)row * 256 + 8 * (L & 31), y); }
                else if (L < 32) store8((bf16_t*)(ws + B_GV) + (size_t)row * 256 + 8 * L, accv);
            }
            if (tk == 0) { const u32x4 z4 = (u32x4){0u, 0u, 0u, 0u}; const bf16_t* pA = P + (size_t)row0 * NP; PREP_RAW(1); }
            float r_q, r_kv;
            {
                float ss = 0.f;
                unpack8(RAW[tk][0], x);
#pragma unroll
                for (int j = 0; j < 8; ++j) ss += x[j] * x[j];
                const float p1 = ss + dpp_x1(ss), p2 = p1 + dpp_x2(p1), p3 = p2 + dpp_m8(p2), p4 = p3 + dpp_m16(p3), p5 = p4 + __shfl_xor(p4, 16);
                r_q = __builtin_amdgcn_rsqf(__shfl(p5, 0) * (1.f / 256.f) + EPS); r_kv = __builtin_amdgcn_rsqf(__shfl(p4, 32) * (1.f / 128.f) + EPS);
                const int q = (L - 48) & 3; const float nr = __builtin_amdgcn_rsqf(p2 * (1.f / 32.f) + EPS);
                float g8[8]; loadl8(mla_k + 64 + 8 * q, g8);
#pragma unroll
                for (int j = 0; j < 8; ++j) y[j] = x[j] * nr * g8[j];
                { const int pos = (q & 2) ? cpos : rpos; rope8l<1>(y, lat ? cos32 + pos * 8 : ones8, lat ? sin32 + pos * 8 : zeros8, (q & 1) == 0); }
                if (L >= 48 && L < 52) {
#pragma unroll
                    for (int h = 0; h < 4; ++h) { bf16_t* img = (bf16_t*)(ws + B_KM + ((size_t)((b * 4 + h) * KT_PER_B + kt)) * IMGM); store8(img + 4096 + kv * 32 + ((q ^ ((kv >> 2) & 3)) << 3), y); } }
                { const int gsel = L & 15; const float gv = bf2f(P[(size_t)row * NP + C_GA + gsel]);
                  const float z = gv + a->in[11][l * 8 + (gsel & 7)]; const float sp = (z > 20.f) ? z : __logf(1.f + __expf(z));
                  const float la = -__expf(a->in[10][l * 8 + (gsel & 7)]) * sp, be = sigmoidf(gv);
                  if (L < 16) ((float*)(ws + (gsel < 8 ? B_LA : B_BE)))[((size_t)((gsel >> 2) & 1) * NT + row) * 4 + (gsel & 3)] = (gsel < 8) ? la : be; }
            }
#pragma unroll
            for (int s = 0; s < 2; ++s) {
                unpack8(RAW[tk][1 + s], x);
                float ss = 0.f;
#pragma unroll
                for (int j = 0; j < 8; ++j) ss += x[j] * x[j];
                ss += dpp_x1(ss); ss += dpp_x2(ss); ss += dpp_m8(ss);
                const bool isq = L < 32, isv = L >= 48;
                const float nr = isv ? 1.f : __builtin_amdgcn_rsqf(ss * (1.f / 64.f) + EPS);
                const LAS float* gp = isv ? ones8 : (isq ? (s ? gqa_q : swa_q) : (s ? gqa_k : swa_k)) + 8 * (L & 7);
                float g8[8]; loadl8(gp, g8);
#pragma unroll
                for (int j = 0; j < 8; ++j) y[j] = x[j] * nr * g8[j];
                { const int pos = (L & 4) ? cpos : rpos; const bool rp = lat && !isv;
                  rope8l<2>(y, rp ? cos64 + pos * 16 + 8 * (L & 1) : ones8, rp ? sin64 + pos * 16 + 8 * (L & 1) : zeros8, (L & 2) == 0); }
                const int hk = (L - 32) >> 3;
                bf16_t* qd = (bf16_t*)(ws + (s ? B_QD : B_QS)) + (size_t)row * 256 + 8 * L;
                bf16_t* kd = (bf16_t*)(ws + (s ? B_KD : B_KS) + ((size_t)((b * 2 + (hk & 1)) * KT_PER_B + kt)) * IMG64) + kv * 64 + (((L & 7) ^ ((kv >> 1) & 7)) << 3);
                if (!isv) store8(isq ? qd : kd, y);
#pragma unroll
                for (int j = 0; j < 8; ++j) { if (tk == 0) vt[s][j] = y[j]; else vp[s][j] = pk2(vt[s][j], y[j]); }
            }
            {
                unpack8(RAW[tk][3], x);
                const float pre = (L < 48) ? r_q : r_kv; float ss = 0.f;
#pragma unroll
                for (int j = 0; j < 8; ++j) { x[j] *= pre; ss += x[j] * x[j]; }
                const float p1 = ss + dpp_x1(ss), p2 = p1 + dpp_x2(p1), p3 = p2 + dpp_m8(p2);
                const bool ispe = (L >= 32 && L < 48);
                const float nr = ispe ? __builtin_amdgcn_rsqf(p2 * (1.f / 32.f) + EPS) : __builtin_amdgcn_rsqf(p3 * (1.f / 64.f) + EPS);
                const LAS float* gp = (L < 32) ? mla_q + 8 * (L & 7) : ispe ? mla_q + 64 + 8 * (L & 3) : mla_k + 8 * (L & 7);
                float g8[8]; loadl8(gp, g8);
#pragma unroll
                for (int j = 0; j < 8; ++j) y[j] = x[j] * nr * g8[j];
                { const int pos = (L & 2) ? cpos : rpos; const bool rp = lat && ispe; rope8l<1>(y, rp ? cos32 + pos * 8 : ones8, rp ? sin32 + pos * 8 : zeros8, (L & 1) == 0); }
                const int qoff = (L < 32) ? (L >> 3) * 96 + 8 * (L & 7) : ((L - 32) >> 2) * 96 + 64 + 8 * (L & 3);
                bf16_t* qd = (bf16_t*)(ws + B_QM) + (size_t)row * 384 + qoff;
                bf16_t* kd = (bf16_t*)(ws + B_KM + ((size_t)((b * 4 + (((L - 48) >> 3) & 1)) * KT_PER_B + kt)) * IMGM) + kv * 64 + (((L & 7) ^ ((kv >> 1) & 7)) << 3);
                store8((L < 48) ? qd : kd, y);
            }
            {
                unpack8(RAW[tk][4], x);
                float ss = 0.f;
#pragma unroll
                for (int j = 0; j < 8; ++j) { x[j] *= r_kv; ss += x[j] * x[j]; }
                ss += dpp_x1(ss); ss += dpp_x2(ss); ss += dpp_m8(ss);
                const bool isk = L < 16;
                const float nr = isk ? __builtin_amdgcn_rsqf(ss * (1.f / 64.f) + EPS) : 1.f;
                float g8[8]; loadl8(isk ? mla_k + 8 * (L & 7) : ones8, g8);
#pragma unroll
                for (int j = 0; j < 8; ++j) y[j] = x[j] * nr * g8[j];
                bf16_t* kd = (bf16_t*)(ws + B_KM + ((size_t)((b * 4 + 2 + ((L >> 3) & 1)) * KT_PER_B + kt)) * IMGM) + kv * 64 + (((L & 7) ^ ((kv >> 1) & 7)) << 3);
                if (isk) store8(kd, y);
#pragma unroll
                for (int j = 0; j < 8; ++j) { if (tk == 0) vt[2][j] = y[j]; else vp[2][j] = pk2(vt[2][j], y[j]); }
            }
        }
        { const int kt = i0 >> 6, kv0 = i0 & 63, G = (kv0 >> 4) & 3, hq = (kv0 >> 2) & 1, b4 = ((kv0 & 3) + 4 * ((kv0 & 15) >> 3)) * 2;
          if (L >= 48) { const int hv = (L - 48) >> 3;
#pragma unroll
              for (int s = 0; s < 2; ++s) { unsigned char* img = ws + (s ? B_VD : B_VS) + ((size_t)((b * 2 + hv) * KT_PER_B + kt)) * IMG64;
#pragma unroll
                  for (int j = 0; j < 8; ++j) { const int d = 8 * (L & 7) + j; *(unsigned*)(img + d * 128 + (((2 * G + hq) ^ ((d >> 1) & 7)) << 4) + b4) = vp[s][j]; } } }
          if (L >= 16 && L < 48) { const int h = (L - 16) >> 3; unsigned char* img = ws + B_VM + ((size_t)((b * 4 + h) * KT_PER_B + kt)) * IMG64;
#pragma unroll
              for (int j = 0; j < 8; ++j) { const int d = 8 * (L & 7) + j; *(unsigned*)(img + d * 128 + (((2 * G + hq) ^ ((d >> 1) & 7)) << 4) + b4) = vp[2][j]; } } }
    }
}
constexpr int ATT_SLOT = 24576, ATT_VOFF = 16384;
#define MFMA32(a, b, c) __builtin_amdgcn_mfma_f32_32x32x16_bf16((a), (b), (c), 0, 0, 0)
DI int crow(int r, int hi) { return (r & 3) + 8 * (r >> 2) + 4 * hi; }

constexpr size_t G2_ITEM = 40960;
DI int permpos(int x) { return (2 * (x >> 4) + ((x >> 2) & 1)) * 8 + (x & 3) + 4 * ((x & 15) >> 3); }
DI int fragoff(int row, int ch) { return (((row >> 5) * 4 + (ch >> 1)) * 64 + (ch & 1) * 32 + (row & 31)) * 8; }
DI size_t g2_index(int b, int h, int dir, int c) { return (size_t)(((b * 4 + h) * 2 + dir) * KT_PER_B + c); }

DI void gdn_chunk_phase(const Frame& F, KArgs a, int l) {
    unsigned char* ws = F.ws; int tid_ = F.tid; const int wave = F.wave;
    constexpr int LP = 68;
    LAS float* qs = (LAS float*)F.lds; LAS float* ks = qs + 64 * LP; LAS float* vs = ks + 64 * LP;
    LAS float* KK = vs + 64 * LP; LAS float* QK = KK + 64 * LP; LAS float* AT = QK + 64 * LP;
    LAS float* gl = AT + 2 * 64 * LP; LAS float* bl = gl + 128;
    LAS bf16_t* WS_ = (LAS bf16_t*)KK; LAS bf16_t* US_ = WS_ + 2 * 64 * 64;
    const float* LA = (const float*)(ws + B_LA); const float* BE = (const float*)(ws + B_BE);
    u32x4 pq = {0u, 0u, 0u, 0u}, pk = pq, pv = pq; bf16x8 fa[4], fb[4]; float pla = 0.f, pbe = 0.f;
#pragma unroll
    for (int q = 0; q < 4; ++q) { fa[q] = (bf16x8){0, 0, 0, 0, 0, 0, 0, 0}; fb[q] = fa[q]; }
#define G2_FETCH(it) do { if ((it) < NB * 4 * KT_PER_B) { const int _t = tid_, _ln = _t & 63; const int _b = (it) / (4 * KT_PER_B), _r0 = (it) % (4 * KT_PER_B), _h = _r0 / KT_PER_B, _c = _r0 % KT_PER_B; const int _row0 = _b * TPB + 64 * _c; \
        const size_t _o = (size_t)(_row0 + (_t >> 3)) * 256 + _h * 64 + 8 * (_t & 7); \
        pq = *(const u32x4*)((const bf16_t*)(ws + B_GQ) + _o); pk = *(const u32x4*)((const bf16_t*)(ws + B_GK) + _o); pv = *(const u32x4*)((const bf16_t*)(ws + B_GV) + _o); \
        if (wave < 2) { const int _tok = wave ? 63 - _ln : _ln; pla = LA[((size_t)wave * NT + _row0 + _tok) * 4 + _h]; pbe = BE[((size_t)wave * NT + _row0 + _tok) * 4 + _h]; } \
        { const int _mat = wave >> 2, _mi = (wave >> 1) & 1, _nj = wave & 1, _n = _ln & 31, _hi = _ln >> 5; \
          const bf16_t* _ar = (const bf16_t*)(ws + (_mat ? B_GQ : B_GK)) + (size_t)(_row0 + 32 * _mi + _n) * 256 + _h * 64 + 8 * _hi; \
          const bf16_t* _br = (const bf16_t*)(ws + B_GK) + (size_t)(_row0 + 32 * _nj + _n) * 256 + _h * 64 + 8 * _hi; \
          _Pragma("unroll") for (int _q = 0; _q < 4; ++_q) { fa[_q] = *(const bf16x8*)(_ar + 16 * _q); fb[_q] = *(const bf16x8*)(_br + 16 * _q); } } } } while (0)
    asm volatile("" : "+v"(tid_));
    G2_FETCH(F.vcu);
    for (int item = F.vcu; item < NB * 4 * KT_PER_B; item += F.G) {
        asm volatile("" : "+v"(tid_));
        const int tid = tid_, lane = tid & 63;
        const int b = item / (4 * KT_PER_B), r0 = item % (4 * KT_PER_B), h = r0 / KT_PER_B, c = r0 % KT_PER_B;
        { const int i = tid >> 3, ch = tid & 7;
          float x[8];
          unpack8(pq, x);
#pragma unroll
          for (int j = 0; j < 8; ++j) qs[i * LP + 8 * ch + j] = x[j];
          unpack8(pk, x);
#pragma unroll
          for (int j = 0; j < 8; ++j) ks[i * LP + 8 * ch + j] = x[j];
          unpack8(pv, x);
#pragma unroll
          for (int j = 0; j < 8; ++j) vs[i * LP + 8 * ch + j] = x[j]; }
        if (wave < 2) { const int d = wave;
            float g = pla;
#pragma unroll
            for (int o = 1; o < 64; o <<= 1) { const float t = __shfl_up(g, o); if (lane >= o) g += t; }
            gl[d * 64 + lane] = g; bl[d * 64 + lane] = pbe; }
        {
          const int mat = wave >> 2, mi = (wave >> 1) & 1, nj = wave & 1, n = lane & 31, hi = lane >> 5;
          f32x16 acc;
#pragma unroll
          for (int r = 0; r < 16; ++r) acc[r] = 0.f;
#pragma unroll
          for (int ks4 = 0; ks4 < 4; ++ks4) acc = MFMA32(fa[ks4], fb[ks4], acc);
          LAS float* M = mat ? QK : KK;
#pragma unroll
          for (int r = 0; r < 16; ++r) M[(32 * mi + crow(r, hi)) * LP + 32 * nj + n] = acc[r]; }
        G2_FETCH(item + F.G);
        LDS_WAIT(); __syncthreads();
        { const int d = tid >> 8, t2 = tid & 255, i = t2 >> 2, jq = (t2 & 3) * 16;
          const float gi = gl[d * 64 + i], bi = bl[d * 64 + i];
          const int ti = d ? 63 - i : i;
          bf16_t* qkm = (bf16_t*)(ws + B_G2 + g2_index(b, h, d, c) * G2_ITEM + 2 * 8192);
          float qv[16];
#pragma unroll
          for (int jj = 0; jj < 16; ++jj) { const int j = jq + jj, tj = d ? 63 - j : j;
              const float e = (i >= j) ? __expf(gi - gl[d * 64 + j]) : 0.f;
              AT[(d * 64 + j) * LP + (i & 1) * 32 + (i >> 1)] = (i > j) ? bi * KK[ti * LP + tj] * e : 0.f;
              qv[jj] = QK[ti * LP + tj] * e; }
          { float y0[8] = {qv[0], qv[1], qv[2], qv[3], qv[8], qv[9], qv[10], qv[11]}, y1[8] = {qv[4], qv[5], qv[6], qv[7], qv[12], qv[13], qv[14], qv[15]};
            store8(qkm + fragoff(i, 2 * (jq >> 4)), y0); store8(qkm + fragoff(i, 2 * (jq >> 4) + 1), y1); } }
        LDS_WAIT(); __syncthreads();
        { const int par = tid & 1, col = tid >> 1, d = col >> 7, cc2 = col & 127; const bool isu = cc2 < 64; const int cc = cc2 & 63;
          float r[32];
#pragma unroll
          for (int i2 = 0; i2 < 32; ++i2) { const int i = 2 * i2 + par; const int ti = d ? 63 - i : i; const float bi = bl[d * 64 + i];
              r[i2] = isu ? bi * vs[ti * LP + cc] : bi * __expf(gl[d * 64 + i]) * ks[ti * LP + cc]; }
#pragma clang loop unroll(full)
          for (int j = 0; j < 63; ++j) { const float mine = r[j >> 1], other = dpp_x1(mine); const float xj = ((j & 1) == par) ? mine : other;
              const LAS f32x4* ap = (const LAS f32x4*)(AT + (d * 64 + j) * LP + par * 32);
              const int ib = (j >> 1) >> 2;
#pragma clang loop unroll(full)
              for (int g4 = ib; g4 < 8; ++g4) { const f32x4 av = ap[g4];
#pragma clang loop unroll(full)
                  for (int e4 = 0; e4 < 4; ++e4) { const int i2 = 4 * g4 + e4;
                      if (i2 > (j >> 1)) r[i2] -= av[e4] * xj;
                      else if (i2 == (j >> 1)) { const float a0 = (2 * i2 + par > j) ? av[e4] : 0.f; r[i2] -= a0 * xj; } } }
              if ((j & 3) == 3) asm volatile("" ::: "memory"); }
          LAS bf16_t* dst = (isu ? US_ : WS_) + d * 4096 + cc;
#pragma unroll
          for (int i2 = 0; i2 < 32; ++i2) dst[(2 * i2 + par) * 64] = (bf16_t)f2bf(isu ? r[i2] : -r[i2]); }
#pragma unroll
        for (int q = 0; q < 4; ++q) { const int id = tid + 512 * q, d = id >> 10, mat = (id >> 9) & 1, rowm = (id >> 3) & 63, ch = id & 7;
            float y[8];
            const float glast = gl[d * 64 + 63];
#pragma unroll
            for (int e = 0; e < 8; ++e) { const int x = 16 * (ch >> 1) + 8 * (e >> 2) + 4 * (ch & 1) + (e & 3);
                if (mat == 0) { const int ti = d ? 63 - rowm : rowm; y[e] = qs[ti * LP + x] * __expf(gl[d * 64 + rowm]); }
                else { const int tj = d ? 63 - x : x; y[e] = ks[tj * LP + rowm] * __expf(glast - gl[d * 64 + x]); } }
            store8((bf16_t*)(ws + B_G2 + g2_index(b, h, d, c) * G2_ITEM + (mat ? 3 : 1) * 8192) + fragoff(rowm, ch), y); }
        if (tid < 2) ((float*)(ws + B_DEC))[g2_index(b, h, tid, c)] = __expf(gl[tid * 64 + 63]);
        LDS_WAIT(); __syncthreads();
#pragma unroll
        for (int q = 0; q < 2; ++q) { const int id = tid + 512 * q, d = id >> 9, i = (id >> 3) & 63, ch = id & 7; u32x4 w;
            unsigned hv[8];
#pragma unroll
            for (int e = 0; e < 8; ++e) { const int x = 16 * (ch >> 1) + 8 * (e >> 2) + 4 * (ch & 1) + (e & 3); hv[e] = WS_[d * 4096 + i * 64 + x]; }
            w.x = hv[0] | (hv[1] << 16); w.y = hv[2] | (hv[3] << 16); w.z = hv[4] | (hv[5] << 16); w.w = hv[6] | (hv[7] << 16);
            *(u32x4*)((bf16_t*)(ws + B_G2 + g2_index(b, h, d, c) * G2_ITEM) + fragoff(i, ch)) = w; }
#pragma unroll
        for (int q = 0; q < 2; ++q) { const int id = tid + 512 * q, d = id >> 9, dv = (id >> 3) & 63, qq = id & 7; u32x4 w;
            unsigned hv[8];
#pragma unroll
            for (int e = 0; e < 8; ++e) { const int rr = 8 * (qq & 1) + e, i = 32 * (qq >> 2) + (rr & 3) + 8 * (rr >> 2) + 4 * ((qq >> 1) & 1); hv[e] = US_[d * 4096 + i * 64 + dv]; }
            w.x = hv[0] | (hv[1] << 16); w.y = hv[2] | (hv[3] << 16); w.z = hv[4] | (hv[5] << 16); w.w = hv[6] | (hv[7] << 16);
            *(u32x4*)((bf16_t*)(ws + B_G2 + g2_index(b, h, d, c) * G2_ITEM + 4 * 8192) + (dv >> 5) * 2048 + ((((qq >> 2) * 2 + (qq & 1)) * 64 + ((qq >> 1) & 1) * 32 + (dv & 31)) * 8)) = w; }
        LDS_WAIT(); __syncthreads();
    }
}

#undef G2_FETCH
DI bf16x8 pack8(const f32x16& v, int s8) {
    u32x4 w; w.x = pk2(v[s8 + 0], v[s8 + 1]); w.y = pk2(v[s8 + 2], v[s8 + 3]); w.z = pk2(v[s8 + 4], v[s8 + 5]); w.w = pk2(v[s8 + 6], v[s8 + 7]); return __builtin_bit_cast(bf16x8, w);
}
DI void gdn_scan_wave(unsigned char* ws, int chain, int lane_in) {
    int lane = lane_in; asm volatile("" : "+v"(lane));
    const int hh = chain & 1, dir = (chain >> 1) & 1, h = (chain >> 2) & 3, b = chain >> 4;
    const int n = lane & 31, hi = lane >> 5;
    f32x16 S0, S1;
#pragma unroll
    for (int r = 0; r < 16; ++r) { S0[r] = 0.f; S1[r] = 0.f; }
    float* OD = (float*)(ws + B_OF) + (size_t)dir * NT * 256;
#pragma unroll 1
    for (int s = 0; s < KT_PER_B; ++s) {
        const int c = dir ? (s < 4 ? 3 - s : 135 - s) : s;
        const unsigned char* base = ws + B_G2 + g2_index(b, h, dir, c) * G2_ITEM;
        const float dl = ((const float*)(ws + B_DEC))[g2_index(b, h, dir, c)];
        const unsigned char* ap = base + lane * 16;
        bf16x8 fa[2][8]; u32x4 ut[4];
        { const u32x4* up = (const u32x4*)(base + 4 * 8192 + hh * 4096) + lane;
#pragma unroll
          for (int q = 0; q < 4; ++q) ut[q] = up[q * 64]; }
#pragma unroll
        for (int X = 0; X < 2; ++X)
#pragma unroll
            for (int f = 0; f < 8; ++f) fa[X][f] = *(const bf16x8*)(ap + X * 8192 + f * 1024);
        __builtin_amdgcn_sched_barrier(0);
        bf16x8 sb[4]; sb[0] = pack8(S0, 0); sb[1] = pack8(S0, 8); sb[2] = pack8(S1, 0); sb[3] = pack8(S1, 8);
        f32x16 vn0, vn1, o0, o1;
#pragma unroll
        for (int q = 0; q < 2; ++q) { const u32x4 w = ut[q];
            vn0[8 * q + 0] = bflo(w.x); vn0[8 * q + 1] = bfhi(w.x); vn0[8 * q + 2] = bflo(w.y); vn0[8 * q + 3] = bfhi(w.y); vn0[8 * q + 4] = bflo(w.z); vn0[8 * q + 5] = bfhi(w.z); vn0[8 * q + 6] = bflo(w.w); vn0[8 * q + 7] = bfhi(w.w);
            const u32x4 w1 = ut[2 + q];
            vn1[8 * q + 0] = bflo(w1.x); vn1[8 * q + 1] = bfhi(w1.x); vn1[8 * q + 2] = bflo(w1.y); vn1[8 * q + 3] = bfhi(w1.y); vn1[8 * q + 4] = bflo(w1.z); vn1[8 * q + 5] = bfhi(w1.z); vn1[8 * q + 6] = bflo(w1.w); vn1[8 * q + 7] = bfhi(w1.w); }
#pragma unroll
        for (int r = 0; r < 16; ++r) { o0[r] = 0.f; o1[r] = 0.f; }
#pragma unroll
        for (int G = 0; G < 4; ++G) {
            vn0 = MFMA32(fa[0][G], sb[G], vn0); vn1 = MFMA32(fa[0][4 + G], sb[G], vn1);
            o0 = MFMA32(fa[1][G], sb[G], o0);   o1 = MFMA32(fa[1][4 + G], sb[G], o1); }
        __builtin_amdgcn_sched_barrier(0);
        bf16x8 fb[2][8];
#pragma unroll
        for (int X = 0; X < 2; ++X)
#pragma unroll
            for (int f = 0; f < 8; ++f) fb[X][f] = *(const bf16x8*)(ap + (2 + X) * 8192 + f * 1024);
        __builtin_amdgcn_sched_barrier(0);
        bf16x8 vb[4]; vb[0] = pack8(vn0, 0); vb[1] = pack8(vn0, 8); vb[2] = pack8(vn1, 0); vb[3] = pack8(vn1, 8);
#pragma unroll
        for (int r = 0; r < 16; ++r) { S0[r] *= dl; S1[r] *= dl; }
#pragma unroll
        for (int G = 0; G < 4; ++G) {
            o0 = MFMA32(fb[0][G], vb[G], o0);   o1 = MFMA32(fb[0][4 + G], vb[G], o1);
            S0 = MFMA32(fb[1][G], vb[G], S0);   S1 = MFMA32(fb[1][4 + G], vb[G], S1); }
        { const int rowc = b * TPB + 64 * c; const long sd = dir ? -256 : 256;
          float* p = OD + (size_t)(rowc + (dir ? 63 : 0)) * 256 + h * 64 + 32 * hh + n + sd * 4 * hi;
#pragma unroll
          for (int r = 0; r < 16; ++r) { const int i0 = (r & 3) + 8 * (r >> 2); p[sd * i0] = o0[r]; p[sd * (32 + i0)] = o1[r]; } }
    }
}

DI void gdn_out_bh(unsigned char* ws, KArgs a, int l, int b, int h, int wave, int lane_in) {
    int lane = lane_in; asm volatile("" : "+v"(lane));
    unsigned char* mix = ws + WS_MIX; const bf16_t* P = (const bf16_t*)(ws + B_P); const float* OF = (const float*)(ws + B_OF);
    const int sub = lane >> 4, c4 = h * 64 + 4 * (lane & 15);
    const f32x4 g4 = *(const f32x4*)(a->in[12] + l * 64 + 4 * (lane & 15));
    const int r0 = b * TPB + wave * 4 + sub;
    for (int k = 0; k < TPB / 32; k += 4) {
        f32x4 of[4], ob[4]; u32x2 zw[4];
#pragma unroll
        for (int q = 0; q < 4; ++q) { const size_t row = (size_t)(r0 + 32 * (k + q));
            of[q] = __builtin_nontemporal_load((const f32x4*)(OF + row * 256 + c4)); ob[q] = __builtin_nontemporal_load((const f32x4*)(OF + (size_t)NT * 256 + row * 256 + c4)); zw[q] = __builtin_nontemporal_load((const u32x2*)(P + row * NP + C_GZ + c4)); }
#pragma unroll
        for (int q = 0; q < 4; ++q) { const size_t row = (size_t)(r0 + 32 * (k + q)); const f32x4 o = of[q] + ob[q];
            float ss = o.x * o.x + o.y * o.y + o.z * o.z + o.w * o.w;
            ss += dpp_x1(ss); ss += dpp_x2(ss); ss += dpp_m8(ss); ss += dpp_m16(ss);
            const float r = rsqrtf(ss * (1.f / 64.f) + EPS);
            const float z0 = bflo(zw[q].x), z1 = bfhi(zw[q].x), z2 = bflo(zw[q].y), z3 = bfhi(zw[q].y);
            *(unsigned*)(mix + row * DM + c4) = f8pack(o.x * r * g4.x * siluf(z0), o.y * r * g4.y * siluf(z1), o.z * r * g4.z * siluf(z2), o.w * r * g4.w * siluf(z3)); }
    }
}
DI void gdn_out_phase(const Frame& F, KArgs a, int l) {
    unsigned char* ws = F.ws; int lane_ = F.lane; asm volatile("" : "+v"(lane_)); const int lane = lane_;
    unsigned char* mix = ws + WS_MIX; const bf16_t* P = (const bf16_t*)(ws + B_P);
    const float* OF = (const float*)(ws + B_OF); const float* gg = a->in[12] + l * 64;
    const int gw = F.vcu * 8 + F.wave, NGW = F.G * 8;
    const f32x4 g4 = *(const f32x4*)(gg + 4 * (lane & 15));
    f32x4 nof, nob; u32x2 nz;
#define G4_FETCH(r) do { const int _r = ((r) < NT) ? (r) : gw; nof = *(const f32x4*)(OF + (size_t)_r * 256 + 4 * lane); nob = *(const f32x4*)(OF + (size_t)NT * 256 + (size_t)_r * 256 + 4 * lane); \
        nz = *(const u32x2*)(P + (size_t)_r * NP + C_GZ + 4 * lane); } while (0)
    G4_FETCH(gw);
    for (int row = gw; row < NT; row += NGW) {
        const f32x4 o = nof + nob; const u32x2 zw = nz;
        G4_FETCH(row + NGW);
        float ss = o.x * o.x + o.y * o.y + o.z * o.z + o.w * o.w;
        ss += dpp_x1(ss); ss += dpp_x2(ss); ss += dpp_m8(ss); ss += dpp_m16(ss);
        const float r = rsqrtf(ss * (1.f / 64.f) + EPS);
        const float z0 = bflo(zw.x), z1 = bfhi(zw.x), z2 = bflo(zw.y), z3 = bfhi(zw.y);
        *(unsigned*)(mix + (size_t)row * DM + 4 * lane) = f8pack(o.x * r * g4.x * siluf(z0), o.y * r * g4.y * siluf(z1), o.z * r * g4.z * siluf(z2), o.w * r * g4.w * siluf(z3));
    }
#undef G4_FETCH
}
#ifndef SCAN_REPS
#define SCAN_REPS 1
#endif
struct AttnDesc {
    const bf16_t* Q; int qpitch;
    const unsigned char* Kimg; const unsigned char* Vimg; int kstride;
    int ntiles, nA, base2;
    int mask; int qpos0;
    int has_sink; float sink;
    unsigned char* O;
};

template <int DK, bool NOMAX>
DI void attn_unit(LAS unsigned char* lds, const AttnDesc& D) {
    constexpr int NKS = DK / 16, KP = (DK == 96) ? 2 : 1;
    int tid_ = tidx(); asm volatile("" : "+v"(tid_));
    const int tid = tid_, lane = tid & 63, r32 = lane & 31, hi = lane >> 5; const int wid = __builtin_amdgcn_readfirstlane(tid >> 6);
    bf16x8 qf[NKS];
    { const bf16_t* qp = D.Q + (size_t)(wid * 32 + r32) * D.qpitch + 8 * hi;
#pragma unroll
      for (int ks = 0; ks < NKS; ++ks) qf[ks] = *(const bf16x8*)(qp + 16 * ks); }
    const unsigned lane16 = (unsigned)lane * 16u;
#define ATT_TILE(t) ((t) < D.nA ? (t) : D.base2 + ((t) - D.nA))
#define ATT_DMA_K(t, ksl) do { const unsigned char* _k = D.Kimg + (size_t)ATT_TILE(t) * D.kstride + wid * 1024 + lane16; \
        __builtin_amdgcn_global_load_lds((const unsigned*)_k, (LAS unsigned*)(lds + (ksl) * 16384 + wid * 1024), 16, 0, 0); \
        if (KP == 2) __builtin_amdgcn_global_load_lds((const unsigned*)(_k + 8192), (LAS unsigned*)(lds + (ksl) * 16384 + 8192 + wid * 1024), 16, 0, 0); } while (0)
#define ATT_DMA_V(t, vsl) do { const unsigned char* _v = D.Vimg + (size_t)ATT_TILE(t) * 8192 + wid * 1024 + lane16; \
        __builtin_amdgcn_global_load_lds((const unsigned*)_v, (LAS unsigned*)(lds + 32768 + (vsl) * 8192 + wid * 1024), 16, 0, 0); } while (0)
    const int NTL = D.ntiles;
    const int kswz = (r32 >> 1) & 7, pswz = (r32 >> 2) & 3;
    const int koff0 = r32 * 128, koffp = 8192 + r32 * 64;
    const int qpos = D.qpos0 + wid * 32 + r32;
    f32x16 o0, o1, zero16, S0, S1, N0, N1;
#pragma unroll
    for (int r = 0; r < 16; ++r) { o0[r] = 0.f; o1[r] = 0.f; zero16[r] = 0.f; }
    float m_used = 0.f, lsum = 0.f;
    bf16x8 pf[4];
#pragma unroll
    for (int G = 0; G < 4; ++G) pf[G] = (bf16x8){0, 0, 0, 0, 0, 0, 0, 0};
#define ATT_QK(X0, X1, ksl) do { const LAS unsigned char* _kb = lds + (ksl) * 16384; bf16x8 _a0[NKS], _a1[NKS]; \
        _Pragma("unroll") for (int ks = 0; ks < 4; ++ks) { _a0[ks] = *(const LAS bf16x8*)(_kb + koff0 + (((2 * ks + hi) ^ kswz) << 4)); _a1[ks] = *(const LAS bf16x8*)(_kb + 4096 + koff0 + (((2 * ks + hi) ^ kswz) << 4)); } \
        if (DK == 96) { _Pragma("unroll") for (int ks = 0; ks < 2; ++ks) { _a0[NKS - 2 + ks] = *(const LAS bf16x8*)(_kb + koffp + (((2 * ks + hi) ^ pswz) << 4)); _a1[NKS - 2 + ks] = *(const LAS bf16x8*)(_kb + 2048 + koffp + (((2 * ks + hi) ^ pswz) << 4)); } } \
        if (ATT_PROBE & 1) { _Pragma("unroll") for (int ks = 0; ks < 4; ++ks) { const bf16x8 _e0 = *(const volatile LAS bf16x8*)(_kb + koff0 + (((2 * ks + hi) ^ kswz) << 4)), _e1 = *(const volatile LAS bf16x8*)(_kb + 4096 + koff0 + (((2 * ks + hi) ^ kswz) << 4)); asm volatile("" :: "v"(_e0), "v"(_e1)); } } \
        X0 = MFMA32(_a0[0], qf[0], zero16); X1 = MFMA32(_a1[0], qf[0], zero16); \
        _Pragma("unroll") for (int ks = 1; ks < NKS; ++ks) { X0 = MFMA32(_a0[ks], qf[ks], X0); X1 = MFMA32(_a1[ks], qf[ks], X1); } } while (0)
#define ATT_PV(vsl) do { const LAS unsigned char* _vb = lds + 32768 + (vsl) * 8192; \
        _Pragma("unroll") for (int G = 0; G < 4; ++G) { const bf16x8 _v0 = *(const LAS bf16x8*)(_vb + koff0 + (((2 * G + hi) ^ kswz) << 4)); const bf16x8 _v1 = *(const LAS bf16x8*)(_vb + 4096 + koff0 + (((2 * G + hi) ^ kswz) << 4)); \
            if (ATT_PROBE & 1) { const bf16x8 _e0 = *(const volatile LAS bf16x8*)(_vb + koff0 + (((2 * G + hi) ^ kswz) << 4)), _e1 = *(const volatile LAS bf16x8*)(_vb + 4096 + koff0 + (((2 * G + hi) ^ kswz) << 4)); asm volatile("" :: "v"(_e0), "v"(_e1)); } \
            o0 = MFMA32(_v0, pf[G], o0); o1 = MFMA32(_v1, pf[G], o1); } } while (0)
#define ATT_MAX(t, S0, S1) do { \
        if (D.mask && (t) >= D.nA) { const int _kv0 = (ATT_TILE(t) - 4) * 64; \
            _Pragma("unroll") for (int r = 0; r < 16; ++r) { const int _d0 = qpos - (_kv0 + crow(r, hi)); const int _d1 = _d0 - 32; \
                if (_d0 > 128 || _d0 < -128) S0[r] = -INFINITY; if (_d1 > 128 || _d1 < -128) S1[r] = -INFINITY; } } \
        if constexpr (!NOMAX) { \
        float _mt = fmaxf(S0[0], S1[0]); \
        _Pragma("unroll") for (int r = 1; r < 16; ++r) _mt = fmaxf(_mt, fmaxf(S0[r], S1[r])); \
        { auto _rr = __builtin_amdgcn_permlane32_swap(__float_as_uint(_mt), __float_as_uint(_mt), false, false); _mt = fmaxf(__uint_as_float(_rr[0]), __uint_as_float(_rr[1])); } \
        _mt -= m_used; \
        if (__builtin_expect(__any(_mt > 8.f || m_used != 0.f), 0)) { const float _d = (_mt > 8.f) ? _mt : 0.f; const float _al = __builtin_amdgcn_exp2f(-_d); m_used += _d; lsum *= _al; \
            _Pragma("unroll") for (int r = 0; r < 16; ++r) { S0[r] -= m_used; S1[r] -= m_used; o0[r] *= _al; o1[r] *= _al; } \
            _Pragma("unroll") for (int G = 0; G < 4; ++G) { u32x4 _w = __builtin_bit_cast(u32x4, pf[G]); \
                _w.x = pk2(bflo(_w.x) * _al, bfhi(_w.x) * _al); _w.y = pk2(bflo(_w.y) * _al, bfhi(_w.y) * _al); _w.z = pk2(bflo(_w.z) * _al, bfhi(_w.z) * _al); _w.w = pk2(bflo(_w.w) * _al, bfhi(_w.w) * _al); \
                pf[G] = __builtin_bit_cast(bf16x8, _w); } } } } while (0)
#ifndef ATT_PROBE
#define ATT_PROBE 0
#endif
#define ATT_EXP(S0, S1) do { float _ps = 0.f; \
        if (ATT_PROBE & 2) { _Pragma("unroll") for (int r = 0; r < 16; ++r) { float _d0, _d1; asm volatile("v_exp_f32 %0, %2\n\tv_exp_f32 %1, %3" : "=v"(_d0), "=v"(_d1) : "v"(S0[r]), "v"(S1[r])); } } \
        _Pragma("unroll") for (int r = 0; r < 16; ++r) { S0[r] = __builtin_amdgcn_exp2f(S0[r]); S1[r] = __builtin_amdgcn_exp2f(S1[r]); _ps += S0[r] + S1[r]; } \
        lsum += _ps; pf[0] = pack8(S0, 0); pf[1] = pack8(S0, 8); pf[2] = pack8(S1, 0); pf[3] = pack8(S1, 8); } while (0)
    ATT_DMA_K(0, 0); ATT_DMA_V(0, 0); ATT_DMA_K(1, 1);
    if (KP == 2) asm volatile("s_waitcnt vmcnt(3)\n\ts_barrier" ::: "memory"); else asm volatile("s_waitcnt vmcnt(2)\n\ts_barrier" ::: "memory");
    ATT_QK(S0, S1, 0);
    asm volatile("s_waitcnt vmcnt(0)\n\ts_barrier" ::: "memory");
    ATT_DMA_K(2, 0); ATT_DMA_V(1, 1);
    if constexpr (NOMAX) ATT_DMA_V(2, 2);
    ATT_MAX(0, S0, S1);
    ATT_QK(N0, N1, 1);
    ATT_EXP(S0, S1);
    S0 = N0; S1 = N1;
    constexpr int VR = NOMAX ? 4 : 3;
    int vprev = 0, vnext = VR - 1;
#define ATT_BODY(t, C0, C1, X0, X1) do { \
        if (ATT_PROBE & 4) asm volatile("s_barrier" ::: "memory"); \
        asm volatile("s_waitcnt vmcnt(1)\n\ts_barrier" ::: "memory"); \
        if ((t) + 2 < NTL) ATT_DMA_K((t) + 2, (t) & 1); \
        ATT_DMA_V((t) + 1, vnext); \
        ATT_MAX(t, C0, C1); \
        ATT_PV(vprev); \
        ATT_QK(X0, X1, ((t) + 1) & 1); \
        ATT_EXP(C0, C1); \
        vprev = (vprev == 2) ? 0 : vprev + 1; vnext = (vnext == 2) ? 0 : vnext + 1; } while (0)
    constexpr int MF = 8 + 2 * NKS;
    const unsigned lbase = (unsigned)(size_t)lds;
    unsigned xo[4], xp[2];
#pragma unroll
    for (int G = 0; G < 4; ++G) xo[G] = lbase + koff0 + (((2 * G + hi) ^ kswz) << 4);
#pragma unroll
    for (int ks = 0; ks < 2; ++ks) xp[ks] = lbase + koffp + (((2 * ks + hi) ^ pswz) << 4);
#define ATT_RD(i, KSL, VSL) do { if ((i) < 8) asm volatile("ds_read_b128 %0, %1 offset:%2" : "=v"(_f[(i) < MF ? (i) : 0]) : "v"(xo[((i) >> 1) & 3]), "n"(32768 + (VSL) * 8192 + ((i) & 1) * 4096)); \
        else if ((i) < 16) asm volatile("ds_read_b128 %0, %1 offset:%2" : "=v"(_f[(i) < MF ? (i) : 0]) : "v"(xo[(((i) - 8) >> 1) & 3]), "n"((KSL) * 16384 + ((i) & 1) * 4096)); \
        else if ((i) < MF) asm volatile("ds_read_b128 %0, %1 offset:%2" : "=v"(_f[(i) < MF ? (i) : 0]) : "v"(xp[(((i) - 16) >> 1) & 1]), "n"((KSL) * 16384 + ((i) & 1) * 2048)); } while (0)
#define ATT_CVT(c_, C0, C1) do { const int _G = (c_) >> 2, _p = (c_) & 3, _b = 8 * (_G & 1) + 2 * _p; \
        unsigned _w = (_G < 2) ? pk2(C0[_b], C0[_b + 1]) : pk2(C1[_b], C1[_b + 1]); asm volatile("" : "+v"(_w)); \
        u32x4 _q = __builtin_bit_cast(u32x4, pf[_G]); _q[_p] = _w; pf[_G] = __builtin_bit_cast(bf16x8, _q); } while (0)
#define ATT_G(i, KSL, VP, C0, C1, X0, X1) do { if ((i) < MF) { \
            if ((i) + 3 < MF) ATT_RD((i) + 3, KSL, VP); \
            asm volatile("s_waitcnt lgkmcnt(%1)" : "+v"(_f[(i) < MF ? (i) : 0]) : "n"(((i) + 3 < MF) ? 3 : ((MF - 1 - (i)) > 0 ? (MF - 1 - (i)) : 0))); \
            if ((i) < 8) { if ((i) & 1) { o1 = MFMA32(_f[(i) < MF ? (i) : 0], pf[((i) >> 1) & 3], o1); asm volatile("" : "+v"(o1)); } else { o0 = MFMA32(_f[(i) < MF ? (i) : 0], pf[((i) >> 1) & 3], o0); asm volatile("" : "+v"(o0)); } } \
            else { constexpr int _ks = ((i) - 8) >> 1; if ((i) & 1) { X1 = MFMA32(_f[(i) < MF ? (i) : 0], qf[(_ks >= 0 && _ks < NKS) ? _ks : 0], _ks == 0 ? zero16 : X1); asm volatile("" : "+v"(X1)); } \
                   else { X0 = MFMA32(_f[(i) < MF ? (i) : 0], qf[(_ks >= 0 && _ks < NKS) ? _ks : 0], _ks == 0 ? zero16 : X0); asm volatile("" : "+v"(X0)); } } } \
        if ((i) < 16) { float _e0 = __builtin_amdgcn_exp2f((i) < 8 ? C0[(2 * (i)) & 15] : C1[(2 * (i)) & 15]), _e1 = __builtin_amdgcn_exp2f((i) < 8 ? C0[(2 * (i) + 1) & 15] : C1[(2 * (i) + 1) & 15]); \
            asm volatile("" : "+v"(_e0), "+v"(_e1)); \
            if ((i) < 8) { C0[(2 * (i)) & 15] = _e0; C0[(2 * (i) + 1) & 15] = _e1; } else { C1[(2 * (i)) & 15] = _e0; C1[(2 * (i) + 1) & 15] = _e1; } \
            } \
        if ((i) >= 1 && (i) <= 16) { constexpr int _j = (i) - 1;        \
            _ps0 += (_j < 8 ? C0[(2 * _j) & 15] : C1[(2 * _j) & 15]); _ps1 += (_j < 8 ? C0[(2 * _j + 1) & 15] : C1[(2 * _j + 1) & 15]); asm volatile("" : "+v"(_ps0), "+v"(_ps1)); } \
        if ((i) >= 4) ATT_CVT((i) - 4, C0, C1); \
        __builtin_amdgcn_sched_barrier(0); } while (0)
#define ATT_BODY_F(t, KSL, VP, C0, C1, X0, X1) do {        \
        asm volatile("s_waitcnt vmcnt(1)\n\ts_barrier" ::: "memory"); \
        if ((t) + 2 < NTL) { ATT_DMA_K((t) + 2, (t) & 1); ATT_DMA_V((t) + 2, ((VP) + 3) & 3); } \
        if (D.mask && (t) >= D.nA) { const int _kv0 = (ATT_TILE(t) - 4) * 64; \
            _Pragma("unroll") for (int r = 0; r < 16; ++r) { const int _d0 = qpos - (_kv0 + crow(r, hi)); const int _d1 = _d0 - 32; \
                if (_d0 > 128 || _d0 < -128) C0[r] = -INFINITY; if (_d1 > 128 || _d1 < -128) C1[r] = -INFINITY; } } \
        float _ps0 = 0.f, _ps1 = 0.f; \
        __builtin_amdgcn_sched_barrier(0); \
        ATT_G(0, KSL, VP, C0, C1, X0, X1); ATT_G(1, KSL, VP, C0, C1, X0, X1); ATT_G(2, KSL, VP, C0, C1, X0, X1); ATT_G(3, KSL, VP, C0, C1, X0, X1); ATT_G(4, KSL, VP, C0, C1, X0, X1); \
        ATT_G(5, KSL, VP, C0, C1, X0, X1); ATT_G(6, KSL, VP, C0, C1, X0, X1); ATT_G(7, KSL, VP, C0, C1, X0, X1); ATT_G(8, KSL, VP, C0, C1, X0, X1); ATT_G(9, KSL, VP, C0, C1, X0, X1); \
        ATT_G(10, KSL, VP, C0, C1, X0, X1); ATT_G(11, KSL, VP, C0, C1, X0, X1); ATT_G(12, KSL, VP, C0, C1, X0, X1); ATT_G(13, KSL, VP, C0, C1, X0, X1); ATT_G(14, KSL, VP, C0, C1, X0, X1); \
        ATT_G(15, KSL, VP, C0, C1, X0, X1); ATT_G(16, KSL, VP, C0, C1, X0, X1); ATT_G(17, KSL, VP, C0, C1, X0, X1); ATT_G(18, KSL, VP, C0, C1, X0, X1); ATT_G(19, KSL, VP, C0, C1, X0, X1); \
        lsum += _ps0 + _ps1; \
        ATT_RD(0, KSL, ((VP) + 1) & 3); ATT_RD(1, KSL, ((VP) + 1) & 3); ATT_RD(2, KSL, ((VP) + 1) & 3);        \
        __builtin_amdgcn_sched_barrier(0); } while (0)
    int t = 1;
    bf16x8 _f[MF];
    if constexpr (NOMAX) {
        ATT_RD(0, 0, 0); ATT_RD(1, 0, 0); ATT_RD(2, 0, 0);
        __builtin_amdgcn_sched_barrier(0);
#pragma unroll 1
        for (; t + 3 < NTL - 1; t += 4) { ATT_BODY_F(t, 0, 0, S0, S1, N0, N1); ATT_BODY_F(t + 1, 1, 1, N0, N1, S0, S1); ATT_BODY_F(t + 2, 0, 2, S0, S1, N0, N1); ATT_BODY_F(t + 3, 1, 3, N0, N1, S0, S1); }
        if (t < NTL - 1) { ATT_BODY_F(t, 0, 0, S0, S1, N0, N1); ++t;
            if (t < NTL - 1) { ATT_BODY_F(t, 1, 1, N0, N1, S0, S1); ++t;
                if (t < NTL - 1) { ATT_BODY_F(t, 0, 2, S0, S1, N0, N1); ++t; S0 = N0; S1 = N1; } }
            else { S0 = N0; S1 = N1; } }
        vprev = (NTL - 2) & 3;
        asm volatile("s_waitcnt lgkmcnt(0)" : "+v"(_f[0]), "+v"(_f[1]), "+v"(_f[2]));
    } else {
#pragma unroll 1
        for (; t + 1 < NTL - 1; t += 2) { ATT_BODY(t, S0, S1, N0, N1); ATT_BODY(t + 1, N0, N1, S0, S1); }
        if (t < NTL - 1) { ATT_BODY(t, S0, S1, N0, N1); S0 = N0; S1 = N1; }
    }
    asm volatile("s_waitcnt vmcnt(1)\n\ts_barrier" ::: "memory");
    ATT_MAX(NTL - 1, S0, S1);
    ATT_PV(vprev);
    ATT_EXP(S0, S1);
    vprev = (vprev == VR - 1) ? 0 : vprev + 1;
    asm volatile("s_waitcnt vmcnt(0)\n\ts_barrier" ::: "memory");
    ATT_PV(vprev);
    float lt = lsum;
    { auto rr = __builtin_amdgcn_permlane32_swap(__float_as_uint(lt), __float_as_uint(lt), false, false); lt = __uint_as_float(rr[0]) + __uint_as_float(rr[1]); }
    if (D.has_sink) lt += __builtin_amdgcn_exp2f(D.sink * LOG2E - m_used);
    const float inv = 1.f / lt;
    unsigned char* op = D.O + (size_t)(wid * 32 + r32) * DM + 32 * hi;
    unsigned ow[8];
#pragma unroll
    for (int rr = 0; rr < 4; ++rr) {
        const unsigned wa = f8pack(o0[4 * rr] * inv, o0[4 * rr + 1] * inv, o0[4 * rr + 2] * inv, o0[4 * rr + 3] * inv);
        const unsigned wb = f8pack(o1[4 * rr] * inv, o1[4 * rr + 1] * inv, o1[4 * rr + 2] * inv, o1[4 * rr + 3] * inv);
        auto sw = __builtin_amdgcn_permlane32_swap(wa, wb, false, false); ow[2 * rr] = sw[0]; ow[2 * rr + 1] = sw[1]; }
    ((u32x4*)op)[0] = (u32x4){ow[0], ow[1], ow[2], ow[3]}; ((u32x4*)op)[1] = (u32x4){ow[4], ow[5], ow[6], ow[7]};
    asm volatile("s_waitcnt lgkmcnt(0)\n\ts_barrier" ::: "memory");
#undef ATT_TILE
#undef ATT_DMA_K
#undef ATT_DMA_V
#undef ATT_QK
#undef ATT_PV
#undef ATT_MAX
#undef ATT_EXP
#undef ATT_BODY
#undef ATT_BODY_F
#undef ATT_RD
#undef ATT_G
#undef ATT_CVT
}

DI void attn_phase(const Frame& F, KArgs a, int l, int rep) {
    unsigned char* ws = F.ws; LAS unsigned char* lds = F.lds;
    const int NUNITS = 16 + ((l == 0) ? 1584 : 1536);
    unsigned* queue = F.ctl + CW_QUEUE + 64 * l + 32 * rep;
    unsigned char* mix = ws + WS_MIX;
    if (F.wave == 0) { const float* sg = a->in[18] + l * 128; const float* gg = a->in[20] + l * 128; const float* mg = a->in[17] + l * 192; const int ln = F.lane;
        const float sq = wave_max(fabsf(sg[ln])), sk = wave_max(fabsf(sg[64 + ln])), gq = wave_max(fabsf(gg[ln])), gk = wave_max(fabsf(gg[64 + ln]));
        const float mqn = wave_max(fabsf(mg[ln])), mqp = wave_max(fabsf(mg[64 + (ln & 31)])), mkn = wave_max(fabsf(mg[96 + ln])), mkp = wave_max(fabsf(mg[160 + (ln & 31)]));
        const float bs = 65.f * sq * sk * QSCALE64, bg = 65.f * gq * gk * QSCALE64, bm = 1.02f * sqrtf(64.f * mqn * mqn + 32.f * mqp * mqp) * sqrtf(64.f * mkn * mkn + 32.f * mkp * mkp) * QSCALEM;
        const float smax = fmaxf(fmaxf(fabsf(a->in[19][l * 4 + 0]), fabsf(a->in[19][l * 4 + 1])), fmaxf(fabsf(a->in[19][l * 4 + 2]), fabsf(a->in[19][l * 4 + 3]))) * LOG2E;
        if (ln == 0) F.MISC[193] = ((bs <= 64.f && smax <= 64.f) ? 1u : 0u) | ((bg <= 64.f) ? 2u : 0u) | ((bm <= 64.f) ? 4u : 0u); }
    __syncthreads();
    const unsigned fastf = (unsigned)__builtin_amdgcn_readfirstlane((int)F.MISC[193]);
    for (;;) {
        if (F.tid == 0) F.MISC[192] = __hip_atomic_fetch_add(queue, 1u, __ATOMIC_RELAXED, __HIP_MEMORY_SCOPE_AGENT);
        __syncthreads();
        int u = __builtin_amdgcn_readfirstlane((int)F.MISC[192]);
        __syncthreads();
        if (u >= NUNITS) break;
        if (u < 16) { if (F.wave < 4) { for (int rp = 0; rp < SCAN_REPS; ++rp) gdn_scan_wave(ws, u * 4 + F.wave, F.lane); }
            __threadfence(); __syncthreads(); __threadfence();
            gdn_out_bh(ws, a, l, u >> 2, u & 3, F.wave, F.lane); continue; }
        u -= 16;
        int type, b, h, qt; bool ctxq = false;
        if (u < 1536) { type = u >> 9; const int v = u & 511; b = v >> 7; h = (v >> 5) & 3; qt = v & 31; if (type == 1) type = 2; else if (type == 2) type = 1; }
        else { const int v = u - 1536; type = v >> 4; b = (v >> 2) & 3; h = v & 3; qt = 0; ctxq = true; }
        const int row0 = b * TPB + (ctxq ? 0 : CTXL + qt * 256);
        AttnDesc D;
        D.ntiles = ctxq ? 4 : KT_PER_B; D.nA = D.ntiles; D.base2 = 0; D.mask = 0; D.qpos0 = qt * 256; D.has_sink = 0; D.sink = 0.f;
        if (type == 0) {
            D.Q = (const bf16_t*)(ws + B_QM) + (size_t)row0 * 384 + h * 96; D.qpitch = 384;
            D.Kimg = ws + B_KM + (size_t)((b * 4 + h) * KT_PER_B) * IMGM; D.kstride = (int)IMGM; D.Vimg = ws + B_VM + (size_t)((b * 4 + h) * KT_PER_B) * IMG64;
            D.O = mix + (size_t)row0 * DM + 256 + h * 64;
            if (fastf & 4u) attn_unit<96, true>(lds, D); else attn_unit<96, false>(lds, D);
        } else {
            const int hk = h >> 1;
            D.Q = (const bf16_t*)(ws + (type == 1 ? B_QS : B_QD)) + (size_t)row0 * 256 + h * 64; D.qpitch = 256;
            D.Kimg = ws + (type == 1 ? B_KS : B_KD) + (size_t)((b * 2 + hk) * KT_PER_B) * IMG64; D.kstride = (int)IMG64;
            D.Vimg = ws + (type == 1 ? B_VS : B_VD) + (size_t)((b * 2 + hk) * KT_PER_B) * IMG64;
            D.O = mix + (size_t)row0 * DM + (type == 1 ? 512 : 768) + h * 64;
            if (type == 1) { D.has_sink = 1; D.sink = a->in[19][l * 4 + h];
                if (!ctxq) { const int lo = (qt * 256 - 128 < 0) ? 0 : qt * 256 - 128, hiq = (qt * 256 + 383 > SEQ - 1) ? SEQ - 1 : qt * 256 + 383;
                    D.nA = 4; D.base2 = 4 + (lo >> 6); D.ntiles = 4 + ((hiq >> 6) - (lo >> 6) + 1); D.mask = 1; } }
            if (fastf & (type == 1 ? 1u : 2u)) attn_unit<64, true>(lds, D); else attn_unit<64, false>(lds, D);
        }
    }
}
DI void moe_tables(const Frame& F, int l) {
    LAS int* tstart = (LAS int*)(F.MISC + 16); LAS int* ecnt = (LAS int*)(F.MISC + 96);
    if (F.tid < 64) ecnt[F.tid] = (int)__hip_atomic_load(F.ctl + CW_ECNT + l * 64 + F.tid, __ATOMIC_RELAXED, __HIP_MEMORY_SCOPE_AGENT);
    LDS_WAIT(); __syncthreads();
    if (F.tid < 64) {
        const int tiles = (ecnt[F.tid] + 255) >> 8; int incl = tiles;
#pragma unroll
        for (int o = 1; o < 64; o <<= 1) { const int t = __shfl_up(incl, o); if ((int)F.tid >= o) incl += t; }
        tstart[F.tid] = incl - tiles;
        if (F.tid == 63) { tstart[64] = incl; tstart[65] = incl + NT / 256; } }
    LDS_WAIT(); __syncthreads();
}

DI void topk_phase(const Frame& F, KArgs a, int l) {
    unsigned char* ws = F.ws; int tid_ = F.tid; asm volatile("" : "+v"(tid_)); const int tid = tid_, lane = tid & 63, wave = F.wave;
    constexpr int TPI = 132;
    LAS int* hist = (LAS int*)F.lds; LAS int* base = hist + 64; LAS int* selL = hist + 128; LAS float* gateL = (LAS float*)(hist + 128 + TPI * 6);
    const float* LOGI = (const float*)(ws + WS_LOG); const float bias = a->in[23][l * 64 + lane];
    int* LIST = (int*)(ws + WS_LIST); float* GATES = (float*)(ws + WS_GLIST); int* POS = (int*)(ws + WS_POS);
    unsigned* ecnt = F.ctl + CW_ECNT + l * 64;
    for (int item = F.vcu; item < NT / TPI; item += F.G) {
        if (tid < 64) hist[tid] = 0;
        LDS_WAIT(); __syncthreads();
        const int t0 = (wave < 4) ? wave * 17 : 68 + (wave - 4) * 16, nt = (wave < 4) ? 17 : 16;
        float lg[17];
#pragma unroll
        for (int tl = 0; tl < 17; ++tl) { const int tokl = t0 + ((tl < nt) ? tl : 0); lg[tl] = LOGI[(size_t)(item * TPI + tokl) * 64 + lane]; }
#pragma unroll
        for (int tl = 0; tl < 17; ++tl) {
            if (tl < nt) {
            const int tokl = t0 + tl;
            const float score = sigmoidf(lg[tl]);
            float val = score + bias; int mye = 0; float mys = 0.f, ssum = 0.f;
#pragma unroll
            for (int k = 0; k < TOPK; ++k) {
                float v = val; int i = lane;
#pragma unroll
                for (int st = 0; st < 6; ++st) { float ov; int oi;
                    if (st == 0) { ov = dpp_x1(v); oi = dpp_x1i(i); } else if (st == 1) { ov = dpp_x2(v); oi = dpp_x2i(i); } else if (st == 2) { ov = dpp_m8(v); oi = dpp_m8i(i); }
                    else if (st == 3) { ov = dpp_m16(v); oi = dpp_m16i(i); } else if (st == 4) { ov = __shfl_xor(v, 16); oi = __shfl_xor(i, 16); } else { ov = __shfl_xor(v, 32); oi = __shfl_xor(i, 32); }
                    if (ov > v || (ov == v && oi < i)) { v = ov; i = oi; } }
                const float sk = __shfl(score, i); ssum += sk;
                if (lane == k) { mye = i; mys = sk; }
                if (lane == i) val = -INFINITY;
            }
            if (lane < TOPK) { const int rank = __hip_atomic_fetch_add(&hist[mye], 1, __ATOMIC_RELAXED, __HIP_MEMORY_SCOPE_WORKGROUP); selL[tokl * 6 + lane] = mye | (rank << 8); gateL[tokl * 6 + lane] = mys / ssum * 2.5f; }
            }
        }
        LDS_WAIT(); __syncthreads();
        if (tid < 64) { const int hcnt = hist[tid]; base[tid] = hcnt ? (int)__hip_atomic_fetch_add(ecnt + tid, (unsigned)hcnt, __ATOMIC_RELAXED, __HIP_MEMORY_SCOPE_AGENT) : 0; }
        LDS_WAIT(); __syncthreads();
        for (int idx = tid; idx < TPI * 6; idx += 512) { const int tokl = idx / 6, k = idx % 6, sv = selL[idx], e = sv & 0xff, slot = base[e] + (sv >> 8), row = item * TPI + tokl;
            LIST[(size_t)e * NT + slot] = row; ((float*)(ws + WS_SAL))[(size_t)e * NT + slot] = ((const float*)(ws + WS_SA))[row]; GATES[(size_t)row * 8 + k] = gateL[idx]; POS[(size_t)row * 8 + k] = (e << 16) | slot; }
        LDS_WAIT(); __syncthreads();
    }
}

DI void combine_phase(const Frame& F, KArgs a, int l) {
    unsigned char* ws = F.ws; int lane_ = F.lane; asm volatile("" : "+v"(lane_)); const int lane = lane_;
    const LAS int* tstart = (const LAS int*)(F.MISC + 16);
    const bf16_t* Y = (const bf16_t*)(ws + WS_BIG); const int* POS = (const int*)(ws + WS_POS); const float* GATES = (const float*)(ws + WS_GLIST);
    bf16_t* X = (bf16_t*)(ws + WS_X); const float* mod = (const float*)(F.ctl + CW_MOD) + (size_t)l * 5 * 6144;
    const int gw = F.vcu * 8 + F.wave, NGW = F.G * 8;
    const int sbase = tstart[64] * 256;
    u32x4 pw0, pw1, gw0, gw1;
    if (gw < NT) { pw0 = *(const u32x4*)(POS + (size_t)gw * 8); pw1 = *(const u32x4*)(POS + (size_t)gw * 8 + 4); gw0 = *(const u32x4*)(GATES + (size_t)gw * 8); gw1 = *(const u32x4*)(GATES + (size_t)gw * 8 + 4); }
    for (int row = gw; row < NT; row += NGW) {
        const int b = row / TPB, i = row % TPB; const bool isctx = i < CTXL;
        const u32x4 cp0 = pw0, cp1 = pw1, cg0 = gw0, cg1 = gw1;
        { const int nrow = (row + NGW < NT) ? row + NGW : row;
          pw0 = *(const u32x4*)(POS + (size_t)nrow * 8); pw1 = *(const u32x4*)(POS + (size_t)nrow * 8 + 4); gw0 = *(const u32x4*)(GATES + (size_t)nrow * 8); gw1 = *(const u32x4*)(GATES + (size_t)nrow * 8 + 4); }
        if (l == 1 && isctx) continue;
        const float* md = mod + (size_t)(isctx ? 4 : b) * 6144;
        int pr[7]; float gt[7];
        { const unsigned pv[6] = {cp0.x, cp0.y, cp0.z, cp0.w, cp1.x, cp1.y}; const unsigned gvv[6] = {cg0.x, cg0.y, cg0.z, cg0.w, cg1.x, cg1.y};
#pragma unroll
          for (int k = 0; k < 6; ++k) { const int p = (int)pv[k]; pr[k] = tstart[p >> 16] * 256 + (p & 0xffff); gt[k] = __builtin_bit_cast(float, gvv[k]); } }
        pr[6] = sbase + row; gt[6] = 1.f;
        float xo[2][8];
#pragma unroll
        for (int j = 0; j < 2; ++j) { const int col = 8 * lane + 512 * j; float acc[8];
#pragma unroll
            for (int q = 0; q < 8; ++q) acc[q] = 0.f;
#pragma unroll
            for (int k = 0; k < 7; ++k) { float y[8]; unpack8(__builtin_nontemporal_load((const u32x4*)(Y + (size_t)pr[k] * DM + col)), y);
#pragma unroll
                for (int q = 0; q < 8; ++q) acc[q] += gt[k] * y[q]; }
            float xr[8], g5[8]; unpack8(__builtin_nontemporal_load((const u32x4*)(X + (size_t)row * DM + col)), xr); loadf8(md + 5 * DM + col, g5);
#pragma unroll
            for (int q = 0; q < 8; ++q) xo[j][q] = xr[q] + g5[q] * acc[q]; }
        if (l == 0) {
            float ss = 0.f;
#pragma unroll
            for (int j = 0; j < 2; ++j) { store8(X + (size_t)row * DM + 8 * lane + 512 * j, xo[j]);
#pragma unroll
                for (int q = 0; q < 8; ++q) ss += xo[j][q] * xo[j][q]; }
            const float r = rsqrtf(wave_sum(ss) * (1.f / DM) + EPS);
            const float* md1 = (const float*)(F.ctl + CW_MOD) + (size_t)5 * 6144 + (size_t)(isctx ? 4 : b) * 6144; const float* g1 = a->in[6] + DM;
            float mxo = 0.f;
#pragma unroll
            for (int j = 0; j < 2; ++j) { const int col = 8 * lane + 512 * j; float gg[8], sh[8], sc[8]; loadf8(g1 + col, gg); loadf8(md1 + col, sh); loadf8(md1 + DM + col, sc);
#pragma unroll
                for (int q = 0; q < 8; ++q) { xo[j][q] = xo[j][q] * r * gg[q] * (1.f + sc[q]) + sh[q]; mxo = fmaxf(mxo, fabsf(xo[j][q])); } }
            mxo = wave_max(mxo); const float inv = mxo > 0.f ? 127.f / mxo : 0.f;
#pragma unroll
            for (int j = 0; j < 2; ++j) { u32x2 w; w.x = q8pack(xo[j][0], xo[j][1], xo[j][2], xo[j][3], inv); w.y = q8pack(xo[j][4], xo[j][5], xo[j][6], xo[j][7], inv);
                *(u32x2*)(ws + WS_H8 + (size_t)row * DM + 8 * lane + 512 * j) = w; }
            if (lane == 0) ((float*)(ws + WS_SA))[row] = mxo * (1.f / 127.f);
        } else {
            float* op = a->out + ((size_t)b * SEQ + (i - CTXL)) * DM;
#pragma unroll
            for (int j = 0; j < 2; ++j) { f32x4* xp = (f32x4*)(op + 8 * lane + 512 * j); xp[0] = (f32x4){xo[j][0], xo[j][1], xo[j][2], xo[j][3]}; xp[1] = (f32x4){xo[j][4], xo[j][5], xo[j][6], xo[j][7]}; }
        }
    }
}
#ifndef DBG_PHASES
#define DBG_PHASES 0
#endif
constexpr int NPHASES = 2 + 24;
DI KArgs kargs() { KArgs ap = (KArgs)__builtin_amdgcn_kernarg_segment_ptr(); asm volatile("" : "+s"(ap)); return ap; }
DI Frame make_frame() {
    Frame F; int tid = tidx(); asm volatile("" : "+v"(tid)); int bx = blockIdx.x, G = gridDim.x; asm volatile("" : "+s"(bx), "+s"(G));
    F.lds = (LAS unsigned char*)lds_raw; F.MISC = (volatile LAS unsigned*)(F.lds + MISC_OFF);
    F.tid = tid; F.lane = tid & 63; F.wave = __builtin_amdgcn_readfirstlane(tid >> 6);
    F.G = G; F.vcu = (G % 8 == 0) ? (bx % 8) * (G / 8) + bx / 8 : bx; F.bx = bx;
    F.ws = kargs()->ws; F.ctl = (unsigned*)(F.ws + WS_CTL);
    return F;
}
#ifndef PH_MASK
#define PH_MASK 0xFFFFFFFFu
#endif
#define PHON(j) (((PH_MASK) >> (j)) & 1u)
#ifndef DUP_MASK
#define DUP_MASK 0u
#endif
#ifndef DUP_L
#define DUP_L 0
#endif
#define NREP(j) ((((DUP_MASK) >> (j)) & 1u) && l == DUP_L ? 2 : 1)
__global__ void __launch_bounds__(512, 2) mega_fwd(Args args) {
    { LAS unsigned* m = (LAS unsigned*)(lds_raw + MISC_OFF); for (int u = threadIdx.x; u < (LDS_BYTES - MISC_OFF) / 4; u += 512) m[u] = 0u; }
    __syncthreads();
    if ((threadIdx.x & 63) == 0) *(volatile LAS int*)(lds_raw + TIDTAB_OFF + 4 * hw_wave_slot()) = (int)(threadIdx.x >> 6);
    __syncthreads();
    const int lo = args.ph_lo, hi = args.ph_hi;
    if (hi - lo > 1) { const Frame F = make_frame(); (void)xcd_barrier_post(F.ctl + CW_BAR, F.MISC); }
#define IN(k) (lo <= (k) && (k) < hi)
#define SEAM(k) do { if (IN(k) && IN((k) + 1)) { const Frame Fb = make_frame(); XcdBarrier bar; bar.bar = Fb.ctl + CW_BAR; bar.x = xb_xcc_id(); bar.st = Fb.MISC; xcd_barrier(bar); } } while (0)
#define SEAMX() do { const Frame Fb = make_frame(); XcdBarrier bar; bar.bar = Fb.ctl + CW_BAR; bar.x = xb_xcc_id(); bar.st = Fb.MISC; xcd_barrier(bar); } while (0)
    if (PHON(0) && IN(0)) { for (int rep = 0; rep < ((DUP_MASK & 1u) ? 2 : 1); ++rep) { if (rep) SEAMX(); const Frame F = make_frame(); p0_prologue(F, kargs()); } } SEAM(0);
    if (PHON(1) && IN(1)) {
        const Frame F = make_frame(); KArgs A_ = kargs(); const int gw = F.vcu * 8 + F.wave, NGW = F.G * 8; bf16_t* H = (bf16_t*)(F.ws + WS_H); const float* modall = (const float*)(F.ctl + CW_MOD);
        for (int row = gw; row < NT; row += NGW) { const int b = row / TPB, i = row % TPB; const float* md = modall + (size_t)(i < CTXL ? 4 : b) * 6144;
            norm_row(resid_row_l0(A_, row), A_->in[6], md, md + DM, (unsigned*)(F.ws + WS_H8 + (size_t)row * DM), (float*)(F.ws + WS_SA) + row, F.lane); }
        for (int r = gw; r < 2 * 896; r += NGW) fold_quant_row(F.ws, F.ctl, r, F.lane);
    } SEAM(1);
#pragma unroll
    for (int l = 0; l < 2; ++l) {
        const int pb = 2 + 12 * l;
        if (PHON(2) && IN(pb + 0)) { for (int rep = 0; rep < NREP(2); ++rep) { if (rep) SEAMX();
            const Frame F = make_frame(); unsigned char* ws = F.ws;
            pg8::SchedDense S{(const char*)(ws + WS_H8), (const char*)(ws + WS_WIN + l * WIN8_L), DM / 2, NT / 256, NP / 256, F.G, F.bx, false};
            pg8::EpiPI8 E{(bf16_t*)(ws + B_P), NP, (const float*)(ws + WS_SA), (const unsigned*)(F.ctl + CW_CMAXW) + l * NP};
            pg8::gemm_phase<pg8::EpiPI8, pg8::SchedDense, false, 0, true>(F.lds, DM / 2, S, E);
        } } SEAM(pb + 0);
        if (PHON(3) && IN(pb + 1)) { for (int rep = 0; rep < NREP(3); ++rep) { if (rep) SEAMX(); const Frame F = make_frame(); prep_phase(F, kargs(), l, rep); } } SEAM(pb + 1);
        if (PHON(4) && IN(pb + 2)) { for (int rep = 0; rep < NREP(4); ++rep) { if (rep) SEAMX(); const Frame F = make_frame(); gdn_chunk_phase(F, kargs(), l); } } SEAM(pb + 2);
        if (PHON(5) && IN(pb + 3)) { for (int rep = 0; rep < NREP(5); ++rep) { if (rep) SEAMX(); const Frame F = make_frame(); attn_phase(F, kargs(), l, rep); } } SEAM(pb + 3);
#ifdef EXTRA_BARS
        if (l == 0 && IN(pb + 5)) { for (int xb = 0; xb < EXTRA_BARS; ++xb) SEAMX(); }
#endif
        if (PHON(7) && IN(pb + 5)) { for (int rep = 0; rep < NREP(7); ++rep) { if (rep) SEAMX();
            const Frame F = make_frame(); unsigned char* ws = F.ws; KArgs A_ = kargs();
            pg8::SchedDense S{(const char*)(ws + WS_MIX), (const char*)(ws + WS_WOUT + l * (size_t)DM * DM), DM / 2, (l == 0) ? NT / 256 : 128, 4, F.G, F.bx, l == 1};
            pg8::EpiResidF8 E{A_->in[0], A_->in[2], (bf16_t*)(ws + WS_X), (const float*)(F.ctl + CW_MOD) + (size_t)l * 5 * 6144, l == 0 ? 1 : 0, (const float*)(F.ctl + CW_CMAXO) + l * DM};
            pg8::gemm_phase<pg8::EpiResidF8, pg8::SchedDense, false, 0, 2>(F.lds, DM / 2, S, E);
        } } SEAM(pb + 5);
        if (PHON(8) && IN(pb + 6)) { for (int rep = 0; rep < NREP(8); ++rep) { if (rep) SEAMX();
            const Frame F = make_frame(); const int gw = F.vcu * 8 + F.wave, NGW = F.G * 8; const float* g2 = kargs()->in[7] + l * DM;
            const bf16_t* X = (const bf16_t*)(F.ws + WS_X); bf16_t* H = (bf16_t*)(F.ws + WS_H); const float* mod = (const float*)(F.ctl + CW_MOD) + (size_t)l * 5 * 6144;
            for (int row = gw; row < NT; row += NGW) { const int b = row / TPB, i = row % TPB; const float* md = mod + (size_t)(i < CTXL ? 4 : b) * 6144;
                norm_row_q(X + (size_t)row * DM, g2, md + 3 * DM, md + 4 * DM, H + (size_t)row * DM, (unsigned*)(F.ws + WS_H8 + (size_t)row * DM), (float*)(F.ws + WS_SA) + row, F.lane); }
        } } SEAM(pb + 6);
        if (PHON(9) && IN(pb + 7)) { for (int rep = 0; rep < NREP(9); ++rep) { if (rep) SEAMX();
            const Frame F = make_frame(); unsigned char* ws = F.ws;
            pg8::SchedDense S{(const char*)(ws + WS_H), (const char*)(ws + WS_WR + l * WR_L), DM, NT / 256, 1, F.G, F.bx, false};
            pg8::EpiRouter E{(float*)(ws + WS_LOG)};
            pg8::gemm_phase<pg8::EpiRouter, pg8::SchedDense, false, 0>(F.lds, DM, S, E);
        } } SEAM(pb + 7);
        if (PHON(10) && IN(pb + 8)) { for (int rep = 0; rep < NREP(10); ++rep) { if (rep) SEAMX(); const Frame F = make_frame(); topk_phase(F, kargs(), l); } } SEAM(pb + 8);
        if (PHON(11) && IN(pb + 9)) { for (int rep = 0; rep < NREP(11); ++rep) { if (rep) SEAMX();
            const Frame F = make_frame(); unsigned char* ws = F.ws;
            moe_tables(F, l);
            pg8::SchedMoE<3> S{(const LAS int*)(F.MISC + 16), (const LAS int*)(F.MISC + 96), (const char*)(ws + WS_H8), (const char*)(ws + WS_WGU + l * WGU8_L), DM / 2, F.G, F.vcu, (int)WGU8_E, true};
            pg8::EpiSwigluI8F8 E{(unsigned char*)(ws + WS_ACT), (const float*)(ws + WS_SAL), (const float*)(ws + WS_SA), (const unsigned*)(F.ctl + CW_CMAX) + l * 65 * 768};
            pg8::gemm_phase<pg8::EpiSwigluI8F8, pg8::SchedMoE<3>, true, NT, 1>(F.lds, DM / 2, S, E, (const int*)(ws + WS_LIST), NT);
        } } SEAM(pb + 9);
        if (PHON(12) && IN(pb + 10)) { for (int rep = 0; rep < NREP(12); ++rep) { if (rep) SEAMX();
            const Frame F = make_frame(); unsigned char* ws = F.ws;
            moe_tables(F, l);
            pg8::SchedMoE<4> S{(const LAS int*)(F.MISC + 16), (const LAS int*)(F.MISC + 96), (const char*)(ws + WS_ACT), (const char*)(ws + WS_WD + l * WD_L), 256, F.G, F.vcu, (int)WD_E, false};
            pg8::EpiPF8 E{(bf16_t*)(ws + WS_BIG), DM, (const float*)(ws + WS_SD) + (size_t)l * 65 * DM};
            pg8::gemm_phase<pg8::EpiPF8, pg8::SchedMoE<4>, false, 0, 2>(F.lds, 256, S, E);
        } } SEAM(pb + 10);
        if (PHON(13) && IN(pb + 11)) { for (int rep = 0; rep < NREP(13); ++rep) { if (rep) SEAMX(); const Frame F = make_frame(); moe_tables(F, l); combine_phase(F, kargs(), l); } } SEAM(pb + 11);
    }
    if (IN(NPHASES)) {
        const Frame F = make_frame(); const int gw = F.vcu * 8 + F.wave, NGW = F.G * 8; const bf16_t* X = (const bf16_t*)(F.ws + WS_X); float* out = kargs()->out;
        for (int row = gw; row < NT; row += NGW) { const int b = row / TPB, i = row % TPB; if (i < CTXL) continue;
            const u32x2* s = (const u32x2*)(X + (size_t)row * DM); f32x4* d = (f32x4*)(out + ((size_t)b * SEQ + i - CTXL) * DM);
#pragma unroll
            for (int j = 0; j < 4; ++j) { const u32x2 w = s[F.lane + 64 * j]; d[F.lane + 64 * j] = (f32x4){bflo(w.x), bfhi(w.x), bflo(w.y), bfhi(w.y)}; } }
    }
#undef IN
#undef SEAM
}

#ifndef N_LAUNCH_MODE
#define N_LAUNCH_MODE 0
#endif
extern "C" void kernel_launch(void* const* d_in, const int* in_sizes, int n_in, void* d_out, int out_size, void* d_ws, size_t ws_size, hipStream_t stream) {
    static int grid = 0;
    if (grid == 0) {
        if (n_in != 28 || ws_size < WS_END) { fprintf(stderr, "kernel_launch: need 28 inputs and %zu bytes of workspace (got %d, %zu)\n", (size_t)WS_END, n_in, ws_size); grid = -1; return; }
        int dev = 0, cus = 0, per_cu = 0;
        if (hipGetDevice(&dev) != hipSuccess || hipDeviceGetAttribute(&cus, hipDeviceAttributeMultiprocessorCount, dev) != hipSuccess) { grid = -1; return; }
        if (hipFuncSetAttribute((const void*)mega_fwd, hipFuncAttributeMaxDynamicSharedMemorySize, LDS_BYTES) != hipSuccess) { fprintf(stderr, "kernel_launch: hipFuncSetAttribute failed\n"); grid = -1; return; }
        if (hipOccupancyMaxActiveBlocksPerMultiprocessor(&per_cu, (const void*)mega_fwd, 512, LDS_BYTES) != hipSuccess || per_cu < 1) { fprintf(stderr, "kernel_launch: occupancy query says %d\n", per_cu); }
        (void)hipGetLastError();
        grid = cus;
    }
    if (grid < 0) return;
    (void)hipMemsetAsync((char*)d_ws + WS_CTL, 0, CTL_ZERO_BYTES, stream);
    Args a{};
    for (int i = 0; i < 28; ++i) a.in[i] = (const float*)d_in[i];
    a.out = (float*)d_out; a.ws = (unsigned char*)d_ws;
#if N_LAUNCH_MODE == 0
    a.ph_lo = 0; a.ph_hi = NPHASES;
    hipLaunchKernelGGL(mega_fwd, dim3(grid), dim3(512), LDS_BYTES, stream, a);
#else
    const int np = DBG_PHASES > 0 ? DBG_PHASES : NPHASES;
    for (int p = 0; p < np; ++p) { a.ph_lo = p; a.ph_hi = p + 1; hipLaunchKernelGGL(mega_fwd, dim3(grid), dim3(512), LDS_BYTES, stream, a); }
    if (DBG_PHASES > 0) { a.ph_lo = NPHASES; a.ph_hi = NPHASES + 1; hipLaunchKernelGGL(mega_fwd, dim3(grid), dim3(512), LDS_BYTES, stream, a); }
#endif
}
```
